# Optimizing an MI355X kernel written in HIP

```python
import math, functools
import jax, jax.numpy as jnp
from jax import lax
import numpy as np

D_MODEL = 1024
BATCH = 8
SEQ = 8192
DEPTH = 2

GRID_W = 64
CTX_LEN = 256
N_EVEN = (DEPTH + 1) // 2
N_ODD = DEPTH // 2
N_MOD = 6
NORM_EPS = 1e-6

RWKV_HEADS = 8
RWKV_HEAD_DIM = 64
RWKV_WIDTH = RWKV_HEADS * RWKV_HEAD_DIM
DECAY_LORA = 64
ICLR_LORA = 64
GATE_LORA = 128
RWKV_GN_EPS = 64e-5
RWKV_SPLITS = (RWKV_WIDTH, RWKV_WIDTH, RWKV_WIDTH, DECAY_LORA, DECAY_LORA, ICLR_LORA, ICLR_LORA, GATE_LORA)
RWKV_COLS = sum(RWKV_SPLITS)

SSD_HEADS = 8
SSD_HEAD_DIM = 64
SSD_WIDTH = SSD_HEADS * SSD_HEAD_DIM
SSD_GROUPS = 2
SSD_STATE = 128
SSD_CONV = 3
SSD_CHUNK = 128
SSD_XBC = SSD_WIDTH + 2 * SSD_GROUPS * SSD_STATE
SSD_SPLITS = (SSD_WIDTH, SSD_XBC, SSD_HEADS, SSD_HEADS)
SSD_COLS = sum(SSD_SPLITS)

EVEN_IN = RWKV_COLS + SSD_COLS
MIX_WIDTH = RWKV_WIDTH + SSD_WIDTH

RET_HEADS = 8
RET_QK_DIM = 128
RET_V_DIM = 256
RET_CHUNK = 128
RET_V = RET_HEADS * RET_V_DIM
RET_SPLITS = (RET_HEADS * RET_QK_DIM, RET_HEADS * RET_QK_DIM, RET_V, RET_V)
RET_IN = sum(RET_SPLITS)
ROPE_BASE = 10000.0

D_FF = 2816
FFN_CONV = 3

kernel_name = 'hybrid_rwkv7_ssd_retention_dit'


def split_last(x, sizes):
    return jnp.split(x, np.cumsum(sizes)[:-1].tolist(), axis=-1)


def to_heads(t, n_heads):
    return t.reshape(t.shape[:-1] + (n_heads, t.shape[-1] // n_heads))


def rms_norm(x, g=None, eps=NORM_EPS):
    xf = x.astype(jnp.float32)
    y = xf * lax.rsqrt(jnp.mean(xf * xf, axis=-1, keepdims=True) + eps)
    if g is not None:
        y = y * g.astype(jnp.float32)
    return y.astype(x.dtype)


def modulate(h, shift, scale):
    return h * (1 + scale) + shift


def depthwise_conv_seq(x, w, b):
    k = w.shape[0]
    y = lax.conv_general_dilated(x, w[:, None, :], (1,), [(k // 2, k // 2)],
                                 dimension_numbers=('NWC', 'WIO', 'NWC'), feature_group_count=x.shape[-1])
    return y + b


def depthwise_conv_grid(x, w, b):
    bsz, t, ch = x.shape
    rows = t // GRID_W
    k = w.shape[0]
    y = lax.conv_general_dilated(x.reshape(bsz, rows, GRID_W, ch), w[:, :, None, :], (1, 1),
                                 [(k // 2, k // 2), (k // 2, k // 2)],
                                 dimension_numbers=('NHWC', 'HWIO', 'NHWC'), feature_group_count=ch)
    return y.reshape(bsz, t, ch) + b


def token_shift_bidir(u, mu_prev, mu_next):
    prev = jnp.pad(u, ((0, 0), (1, 0), (0, 0)))[:, :-1]
    nxt = jnp.pad(u, ((0, 0), (0, 1), (0, 0)))[:, 1:]
    return u + mu_prev * (prev - u) + mu_next * (nxt - u)


def rope_2d(x):
    t, dk = x.shape[1], x.shape[-1]
    n = dk // 4
    pos = jnp.arange(t)
    row = (pos // GRID_W).astype(jnp.float32)
    col = (pos % GRID_W).astype(jnp.float32)
    inv = ROPE_BASE ** (-jnp.arange(n, dtype=jnp.float32) / n)
    ang = jnp.concatenate([row[:, None] * inv, col[:, None] * inv], axis=-1)[:, None, :]
    cos, sin = jnp.cos(ang).astype(x.dtype), jnp.sin(ang).astype(x.dtype)
    x1, x2 = jnp.split(x, 2, axis=-1)
    return jnp.concatenate([x1 * cos - x2 * sin, x2 * cos + x1 * sin], axis=-1)


def run_bidirectional(scan_f, scan_b, ctx_f, ctx_b, lat_f, lat_b, state0):
    flip = lambda ts: tuple(jnp.flip(t, 1) for t in ts)
    yc_f, sc_f = scan_f(*ctx_f, state0)
    yl_f, _ = scan_f(*lat_f, sc_f)
    yc_b, sc_b = scan_b(*flip(ctx_b), state0)
    yl_b, _ = scan_b(*flip(lat_b), sc_b)
    return yc_f + jnp.flip(yc_b, 1), yl_f + jnp.flip(yl_b, 1)


def rwkv7_scan(r, decay, k, v, a, b, s0):
    def step(s, inp):
        r_t, w_t, k_t, v_t, a_t, b_t = inp
        sa = jnp.einsum('bhvk,bhk->bhv', s, a_t)
        s = s * w_t[:, :, None, :] + sa[..., None] * b_t[:, :, None, :] + v_t[..., None] * k_t[:, :, None, :]
        return s, jnp.einsum('bhvk,bhk->bhv', s, r_t)
    xs = tuple(jnp.moveaxis(t.astype(jnp.float32), 1, 0) for t in (r, decay, k, v, a, b))
    s, ys = lax.scan(step, s0.astype(jnp.float32), xs)
    return jnp.moveaxis(ys, 0, 1), s


def ssd_scan(x, dt, bm, cm, h0, A):
    f32 = jnp.float32
    bsz, t, nh, hp = x.shape
    ng, ns = bm.shape[2], bm.shape[3]
    hg = nh // ng
    L = SSD_CHUNK
    nc = t // L
    x = x.astype(f32).reshape(bsz, nc, L, ng, hg, hp)
    dt = dt.astype(f32).reshape(bsz, nc, L, ng, hg)
    bm = bm.astype(f32).reshape(bsz, nc, L, ng, ns)
    cm = cm.astype(f32).reshape(bsz, nc, L, ng, ns)
    cs = jnp.cumsum(dt * A.astype(f32).reshape(ng, hg), axis=2)
    xdt = x * dt[..., None]
    causal = jnp.tril(jnp.ones((L, L), bool))[:, :, None, None]
    seg = cs[:, :, :, None] - cs[:, :, None, :]
    decay = jnp.exp(jnp.where(causal, seg, -jnp.inf))
    cb = jnp.einsum('bclgn,bcsgn->bclsg', cm, bm)
    y = jnp.einsum('bclsg,bclsgh,bcsghp->bclghp', cb, decay, xdt)
    states = jnp.einsum('bcsgn,bcsgh,bcsghp->bcghpn', bm, jnp.exp(cs[:, :, -1:] - cs), xdt)
    def step(h, inp):
        s_c, a_c = inp
        return a_c[..., None, None] * h + s_c, h
    h_t, h_prev = lax.scan(step, h0.astype(f32).reshape(bsz, ng, hg, hp, ns),
                           (jnp.moveaxis(states, 1, 0), jnp.moveaxis(jnp.exp(cs[:, :, -1]), 1, 0)))
    h_prev = jnp.moveaxis(h_prev, 0, 1)
    y = y + jnp.einsum('bclgn,bcghpn,bclgh->bclghp', cm, h_prev, jnp.exp(cs))
    return y.reshape(bsz, t, nh, hp), h_t.reshape(bsz, nh, hp, ns)


def retention_scan(q, k, v, s0, log_gamma):
    f32 = jnp.float32
    bsz, t, nh, dk = q.shape
    dv = v.shape[-1]
    L = RET_CHUNK
    nc = t // L
    q = q.astype(f32).reshape(bsz, nc, L, nh, dk)
    k = k.astype(f32).reshape(bsz, nc, L, nh, dk)
    v = v.astype(f32).reshape(bsz, nc, L, nh, dv)
    lg = log_gamma.astype(f32)
    pos = jnp.arange(L, dtype=f32)
    rel = pos[:, None] - pos[None, :]
    inner = jnp.where(rel[..., None] >= 0, jnp.exp(jnp.maximum(rel, 0.0)[..., None] * lg), 0.0)
    scores = jnp.einsum('bclhd,bcshd->bclsh', q, k) * inner
    y = jnp.einsum('bclsh,bcshe->bclhe', scores, v)
    k_end = k * jnp.exp((L - 1 - pos)[:, None] * lg)[:, :, None]
    states = jnp.einsum('bcshd,bcshe->bchde', k_end, v)
    chunk_decay = jnp.exp(L * lg)[:, None, None]
    def step(s, s_c):
        return chunk_decay * s + s_c, s
    s_t, s_prev = lax.scan(step, s0.astype(f32), jnp.moveaxis(states, 1, 0))
    s_prev = jnp.moveaxis(s_prev, 0, 1)
    q_dec = q * jnp.exp((pos + 1)[:, None] * lg)[:, :, None]
    y = y + jnp.einsum('bclhd,bchde->bclhe', q_dec, s_prev)
    return y.reshape(bsz, t, nh, dv), s_t


def even_features(h, p):
    f32 = jnp.float32
    proj = h @ p['w_in']
    rw = token_shift_bidir(proj[..., :RWKV_COLS], p['mu_prev'], p['mu_next'])
    r, k, v, wd_f, wd_b, ad_f, ad_b, gd = split_last(rw, RWKV_SPLITS)
    rh, vh, kh = to_heads(r, RWKV_HEADS), to_heads(v, RWKV_HEADS), to_heads(k, RWKV_HEADS)
    kk = to_heads(k * p['k_k'], RWKV_HEADS).astype(f32)
    kk = kk / jnp.maximum(jnp.sqrt(jnp.sum(kk * kk, axis=-1, keepdims=True)), 1e-12)
    def direction(wd, ad, w0, w2, a0, a2):
        logw = (-jax.nn.softplus(-(w0 + jnp.tanh(wd) @ w2)) - 0.5).astype(f32)
        iclr = jax.nn.sigmoid(a0 + ad @ a2)
        k_dir = to_heads(k * (1 + (iclr - 1) * p['k_a']), RWKV_HEADS)
        iclr = to_heads(iclr, RWKV_HEADS)
        return (rh, to_heads(jnp.exp(-jnp.exp(logw)), RWKV_HEADS), k_dir, vh, -kk, kk * iclr)
    rw_f = direction(wd_f, ad_f, p['w0_f'], p['w2_f'], p['a0_f'], p['a2_f'])
    rw_b = direction(wd_b, ad_b, p['w0_b'], p['w2_b'], p['a0_b'], p['a2_b'])
    bonus = jnp.sum(rh * kh * p['r_k'], axis=-1, keepdims=True) * vh
    gate = jax.nn.sigmoid(gd) @ p['g2']
    z, xbc, dtr_f, dtr_b = split_last(proj[..., RWKV_COLS:], SSD_SPLITS)
    xbc = jax.nn.silu(depthwise_conv_seq(xbc, p['conv_w'], p['conv_b']))
    xs, bm, cm = split_last(xbc, (SSD_WIDTH, SSD_GROUPS * SSD_STATE, SSD_GROUPS * SSD_STATE))
    xs = to_heads(xs, SSD_HEADS)
    bm = to_heads(bm, SSD_GROUPS)
    cm = to_heads(cm, SSD_GROUPS)
    dt_f = jax.nn.softplus(dtr_f + p['dt_bias_f'])
    dt_b = jax.nn.softplus(dtr_b + p['dt_bias_b'])
    return {'rwkv_f': rw_f, 'rwkv_b': rw_b, 'bonus': bonus, 'gate': gate, 'z': z, 'xs': xs,
            'ssd_f': (xs, dt_f, bm, cm), 'ssd_b': (xs, dt_b, bm, cm)}


def even_mixer(hc, hx, p, need_ctx):
    f32 = jnp.float32
    fc, fx = even_features(hc, p), even_features(hx, p)
    bsz = hx.shape[0]
    s0 = jnp.zeros((bsz, RWKV_HEADS, RWKV_HEAD_DIM, RWKV_HEAD_DIM), f32)
    rk_c, rk_x = run_bidirectional(rwkv7_scan, rwkv7_scan, fc['rwkv_f'], fc['rwkv_b'],
                                   fx['rwkv_f'], fx['rwkv_b'], s0)
    h0 = jnp.zeros((bsz, SSD_HEADS, SSD_HEAD_DIM, SSD_STATE), f32)
    scan_f = functools.partial(ssd_scan, A=-jnp.exp(p['A_log_f'].astype(f32)))
    scan_b = functools.partial(ssd_scan, A=-jnp.exp(p['A_log_b'].astype(f32)))
    sd_c, sd_x = run_bidirectional(scan_f, scan_b, fc['ssd_f'], fc['ssd_b'], fx['ssd_f'], fx['ssd_b'], h0)

    def finish(f, y_rk, y_sd, dtype):
        mean = jnp.mean(y_rk, axis=-1, keepdims=True)
        var = jnp.var(y_rk, axis=-1, keepdims=True)
        y_rk = (y_rk - mean) * lax.rsqrt(var + RWKV_GN_EPS)
        y_rk = y_rk * p['ln_w'].reshape(RWKV_HEADS, RWKV_HEAD_DIM) + p['ln_b'].reshape(RWKV_HEADS, RWKV_HEAD_DIM)
        y_rk = (y_rk + f['bonus']).reshape(y_rk.shape[:-2] + (RWKV_WIDTH,)) * f['gate']
        y_sd = y_sd + p['D'][:, None] * f['xs']
        y_sd = rms_norm(y_sd.reshape(y_sd.shape[:-2] + (SSD_WIDTH,)) * jax.nn.silu(f['z']), p['norm_w'])
        return jnp.concatenate([y_rk, y_sd], axis=-1).astype(dtype) @ p['w_out']

    yx = finish(fx, rk_x, sd_x, hx.dtype)
    yc = finish(fc, rk_c, sd_c, hc.dtype) if need_ctx else None
    return yc, yx


def odd_features(h, p, on_grid):
    q, k, v, g = split_last(h @ p['w_in'], RET_SPLITS)
    q = to_heads(q, RET_HEADS)
    k = to_heads(k, RET_HEADS) * (RET_QK_DIM ** -0.5)
    if on_grid:
        q, k = rope_2d(q), rope_2d(k)
    return (q, k, to_heads(v, RET_HEADS)), g


def odd_mixer(hc, hx, p, need_ctx):
    f32 = jnp.float32
    (sc, gc), (sx, gx) = odd_features(hc, p, False), odd_features(hx, p, True)
    lg_f = jnp.log1p(-jnp.exp2(-p['log2_f'].astype(f32)))
    lg_b = jnp.log1p(-jnp.exp2(-p['log2_b'].astype(f32)))
    s0 = jnp.zeros((hx.shape[0], RET_HEADS, RET_QK_DIM, RET_V_DIM), f32)
    yc, yx = run_bidirectional(functools.partial(retention_scan, log_gamma=lg_f),
                               functools.partial(retention_scan, log_gamma=lg_b), sc, sc, sx, sx, s0)

    def finish(y, g, dtype):
        y = rms_norm(y).reshape(y.shape[:-2] + (RET_V,))
        return (jax.nn.silu(g) * y).astype(dtype) @ p['w_out']

    out_x = finish(yx, gx, hx.dtype)
    out_c = finish(yc, gc, hc.dtype) if need_ctx else None
    return out_c, out_x


def conv_ffn(h, w_up, conv_w, conv_b, w_down, on_grid):
    gate, val = jnp.split(h @ w_up, 2, axis=-1)
    if on_grid:
        gate = depthwise_conv_grid(gate, conv_w, conv_b)
    else:
        gate = depthwise_conv_seq(gate, conv_w[FFN_CONV // 2], conv_b)
    return (jax.nn.gelu(gate) * val) @ w_down


def setup_inputs(seed: int = 0) -> dict:
    key = jax.random.key(seed)
    keys = iter(jax.random.split(key, 64))
    f32 = jnp.float32
    def nrm(shape, scale):
        return scale * jax.random.normal(next(keys), shape, f32)
    def uni(shape, lo, hi):
        return jax.random.uniform(next(keys), shape, f32, lo, hi)
    def dt_bias(shape):
        dt = jnp.exp(uni(shape, math.log(1e-3), math.log(1e-1)))
        return dt + jnp.log(-jnp.expm1(-dt))
    D = D_MODEL
    E, O = N_EVEN, N_ODD
    ret_base = 5.0 + jnp.arange(RET_HEADS, dtype=f32)[None, :]
    return {
        'x': nrm((BATCH, SEQ, D), 1.0),
        'c': nrm((BATCH, D), 1.0),
        'ctx': nrm((BATCH, CTX_LEN, D), 1.0),
        'c_ctx': nrm((D,), 1.0),
        'mod_w': nrm((DEPTH, D, N_MOD * D), 0.3 * D ** -0.5),
        'mod_b': nrm((DEPTH, N_MOD * D), 0.02),
        'norm1_g': 1.0 + nrm((DEPTH, D), 0.02),
        'norm2_g': 1.0 + nrm((DEPTH, D), 0.02),
        'ffn_w_up': nrm((DEPTH, D, 2 * D_FF), D ** -0.5),
        'ffn_conv_w': nrm((DEPTH, FFN_CONV, FFN_CONV, D_FF), 1.0 / FFN_CONV),
        'ffn_conv_b': nrm((DEPTH, D_FF), 0.02),
        'ffn_w_down': nrm((DEPTH, D_FF, D), D_FF ** -0.5),
        'ev_w_in': nrm((E, D, EVEN_IN), D ** -0.5),
        'ev_mu_prev': uni((E, RWKV_COLS), 0.0, 0.5),
        'ev_mu_next': uni((E, RWKV_COLS), 0.0, 0.5),
        'rk_w0_f': uni((E, RWKV_WIDTH), -6.0, -1.0),
        'rk_w0_b': uni((E, RWKV_WIDTH), -6.0, -1.0),
        'rk_w2_f': nrm((E, DECAY_LORA, RWKV_WIDTH), 0.5 * DECAY_LORA ** -0.5),
        'rk_w2_b': nrm((E, DECAY_LORA, RWKV_WIDTH), 0.5 * DECAY_LORA ** -0.5),
        'rk_a0_f': nrm((E, RWKV_WIDTH), 0.1),
        'rk_a0_b': nrm((E, RWKV_WIDTH), 0.1),
        'rk_a2_f': nrm((E, ICLR_LORA, RWKV_WIDTH), 0.5 * ICLR_LORA ** -0.5),
        'rk_a2_b': nrm((E, ICLR_LORA, RWKV_WIDTH), 0.5 * ICLR_LORA ** -0.5),
        'rk_g2': nrm((E, GATE_LORA, RWKV_WIDTH), GATE_LORA ** -0.5),
        'rk_k_k': 0.85 + nrm((E, RWKV_WIDTH), 0.05),
        'rk_k_a': 1.0 + nrm((E, RWKV_WIDTH), 0.05),
        'rk_r_k': nrm((E, RWKV_HEADS, RWKV_HEAD_DIM), 0.1),
        'rk_ln_w': 1.0 + nrm((E, RWKV_WIDTH), 0.02),
        'rk_ln_b': nrm((E, RWKV_WIDTH), 0.02),
        'ssd_conv_w': nrm((E, SSD_CONV, SSD_XBC), SSD_CONV ** -0.5),
        'ssd_conv_b': nrm((E, SSD_XBC), 0.02),
        'ssd_dt_bias_f': dt_bias((E, SSD_HEADS)),
        'ssd_dt_bias_b': dt_bias((E, SSD_HEADS)),
        'ssd_a_log_f': jnp.log(uni((E, SSD_HEADS), 1.0, 16.0)),
        'ssd_a_log_b': jnp.log(uni((E, SSD_HEADS), 1.0, 16.0)),
        'ssd_d': 1.0 + nrm((E, SSD_HEADS), 0.1),
        'ssd_norm_w': 1.0 + nrm((E, SSD_WIDTH), 0.02),
        'ev_w_out': nrm((E, MIX_WIDTH, D), MIX_WIDTH ** -0.5),
        'ret_w_in': nrm((O, D, RET_IN), D ** -0.5),
        'ret_log2_f': ret_base + uni((O, RET_HEADS), -0.3, 0.3),
        'ret_log2_b': ret_base + uni((O, RET_HEADS), -0.3, 0.3),
        'ret_w_out': nrm((O, RET_V, D), RET_V ** -0.5),
        'final_norm_g': 1.0 + nrm((D,), 0.02),
    }


def reference(x, c, ctx, c_ctx, mod_w, mod_b, norm1_g, norm2_g, ffn_w_up, ffn_conv_w, ffn_conv_b,
              ffn_w_down, ev_w_in, ev_mu_prev, ev_mu_next, rk_w0_f, rk_w0_b, rk_w2_f, rk_w2_b, rk_a0_f,
              rk_a0_b, rk_a2_f, rk_a2_b, rk_g2, rk_k_k, rk_k_a, rk_r_k, rk_ln_w, rk_ln_b, ssd_conv_w,
              ssd_conv_b, ssd_dt_bias_f, ssd_dt_bias_b, ssd_a_log_f, ssd_a_log_b, ssd_d, ssd_norm_w,
              ev_w_out, ret_w_in, ret_log2_f, ret_log2_b, ret_w_out, final_norm_g):
    cond_x = jax.nn.silu(c)[:, None, :]
    cond_c = jax.nn.silu(c_ctx)[None, None, :]
    for i in range(DEPTH):
        need_ctx = i < DEPTH - 1
        mx = jnp.split(cond_x @ mod_w[i] + mod_b[i], N_MOD, axis=-1)
        mc = jnp.split(cond_c @ mod_w[i] + mod_b[i], N_MOD, axis=-1)
        hx = modulate(rms_norm(x, norm1_g[i]), mx[0], mx[1])
        hc = modulate(rms_norm(ctx, norm1_g[i]), mc[0], mc[1])
        j = i // 2
        if i % 2 == 0:
            p = {'w_in': ev_w_in[j], 'mu_prev': ev_mu_prev[j], 'mu_next': ev_mu_next[j],
                 'w0_f': rk_w0_f[j], 'w0_b': rk_w0_b[j], 'w2_f': rk_w2_f[j], 'w2_b': rk_w2_b[j],
                 'a0_f': rk_a0_f[j], 'a0_b': rk_a0_b[j], 'a2_f': rk_a2_f[j], 'a2_b': rk_a2_b[j],
                 'g2': rk_g2[j], 'k_k': rk_k_k[j], 'k_a': rk_k_a[j], 'r_k': rk_r_k[j],
                 'ln_w': rk_ln_w[j], 'ln_b': rk_ln_b[j], 'conv_w': ssd_conv_w[j], 'conv_b': ssd_conv_b[j],
                 'dt_bias_f': ssd_dt_bias_f[j], 'dt_bias_b': ssd_dt_bias_b[j],
                 'A_log_f': ssd_a_log_f[j], 'A_log_b': ssd_a_log_b[j], 'D': ssd_d[j],
                 'norm_w': ssd_norm_w[j], 'w_out': ev_w_out[j]}
            yc, yx = even_mixer(hc, hx, p, need_ctx)
        else:
            p = {'w_in': ret_w_in[j], 'log2_f': ret_log2_f[j], 'log2_b': ret_log2_b[j], 'w_out': ret_w_out[j]}
            yc, yx = odd_mixer(hc, hx, p, need_ctx)
        x = x + mx[2] * yx
        x = x + mx[5] * conv_ffn(modulate(rms_norm(x, norm2_g[i]), mx[3], mx[4]),
                                 ffn_w_up[i], ffn_conv_w[i], ffn_conv_b[i], ffn_w_down[i], True)
        if need_ctx:
            ctx = ctx + mc[2] * yc
            ctx = ctx + mc[5] * conv_ffn(modulate(rms_norm(ctx, norm2_g[i]), mc[3], mc[4]),
                                         ffn_w_up[i], ffn_conv_w[i], ffn_conv_b[i], ffn_w_down[i], False)
    return rms_norm(x, final_norm_g)
```

```cpp
#include <hip/hip_runtime.h>
#include <hip/hip_cooperative_groups.h>
#include <cstdio>
namespace cg = cooperative_groups;

typedef unsigned short u16;
using bf16x8 = __attribute__((ext_vector_type(8))) short;
using f32x4 = __attribute__((ext_vector_type(4))) float;
using u32x4 = __attribute__((ext_vector_type(4))) unsigned int;

#define NTOK 67584
#define NCTX 2048
#define NLAT 65536
#define PW 3472
#define LDS_BYTES 147456
#define HALF_LDS 73728
#define LTID ((int)(TT & 255))
#define VBID ((int)(blockIdx.x * 2 + (TT >> 8)))
__device__ __forceinline__ int opaque_tid() { int t = threadIdx.x; asm volatile("" : "+v"(t)); return t; }
#define VGRID ((int)(gridDim.x * 2))

enum { I_X = 0, I_C, I_CTX, I_CCTX, I_MODW, I_MODB, I_N1G, I_N2G, I_FUP, I_FCW, I_FCB, I_FDN,
       I_EVIN, I_MUP, I_MUN, I_W0F, I_W0B, I_W2F, I_W2B, I_A0F, I_A0B, I_A2F, I_A2B, I_G2, I_KK, I_KA, I_RK,
       I_LNW, I_LNB, I_SCW, I_SCB, I_DTBF, I_DTBB, I_ALF, I_ALB, I_SD, I_SNW, I_EVOUT, I_RIN, I_L2F, I_L2B, I_ROUT, I_FNG, N_IN };

struct Params { const float* in[N_IN]; float* out; char* ws; };

#define MiB (1024ull * 1024ull)
#define W_EVIN   0ull
#define W_EVOUT  (W_EVIN + 3472ull * 1024)
#define W_UP0    (W_EVOUT + 1024ull * 1024)
#define W_UP1    (W_UP0 + 5632ull * 1024)
#define W_DN0    (W_UP1 + 5632ull * 1024)
#define W_DN1    (W_DN0 + 1024ull * 2816)
#define W_RIN    (W_DN1 + 1024ull * 2816)
#define W_ROUT   (W_RIN + 6144ull * 1024)
#define W_W2F    (W_ROUT + 1024ull * 2048)
#define W_W2B    (W_W2F + 512ull * 64)
#define W_A2F    (W_W2B + 512ull * 64)
#define W_A2B    (W_A2F + 512ull * 64)
#define W_G2     (W_A2B + 512ull * 64)
#define O_SMALL  (64 * MiB)
#define O_MODV   (O_SMALL)
#define O_ROPE   (O_MODV + 2ull * 9 * 6144 * 4)
#define O_CTXR   (O_SMALL + 1 * MiB)
#define O_RN     (O_CTXR + 8 * MiB)
#define O_BONUS  (O_RN + 2162688ull)
#define O_DT     (O_BONUS + 2162688ull)
#define O_CS     (O_DT + 2 * 2162688ull)
#define O_RSTD   (O_CS + 2 * 2162688ull)
#define O_BAR    (O_RSTD + 2097152ull)
#define O_BIG    (96 * MiB)
#define SZ_TOK512 (69206016ull)
#define O_P      (O_BIG)
#define O_S      (544 * MiB)
#define O_SR     (O_S)
#define O_SK     (O_S + SZ_TOK512)
#define O_SV     (O_S + 2 * SZ_TOK512)
#define O_SEF    (O_S + 3 * SZ_TOK512)
#define O_SEB    (O_S + 4 * SZ_TOK512)
#define O_SIF    (O_S + 5 * SZ_TOK512)
#define O_SIB    (O_S + 6 * SZ_TOK512)
#define O_STATES (O_SEF)
#define O_MIXED  (O_SR)
#define O_HX     (O_BIG)
#define O_GV     (228 * MiB)
#define O_QKV    (228 * MiB)
#define O_Y      (756 * MiB)
#define DO_HX    0ull
#define DO_L     (138412032ull)
#define DO_G     (DO_L + 51904512ull)

__device__ __forceinline__ unsigned pack2(float a, float b) {
  unsigned r;
  asm("v_cvt_pk_bf16_f32 %0, %1, %2" : "=v"(r) : "v"(a), "v"(b));
  return r;
}
__device__ __forceinline__ u16 f2bf(float f) { return (u16)(pack2(f, f) & 0xffffu); }
__device__ __forceinline__ float bf2f(u16 h) { return __uint_as_float(((unsigned)h) << 16); }
__device__ __forceinline__ uint2 pack4(float a, float b, float c, float d) { return make_uint2(pack2(a, b), pack2(c, d)); }
__device__ __forceinline__ float sigmoidf_(float x) { return __builtin_amdgcn_rcpf(1.f + __expf(-x)); }
__device__ __forceinline__ float siluf_(float x) { return x * __builtin_amdgcn_rcpf(1.f + __expf(-x)); }
__device__ __forceinline__ float tanhf_(float x) { return 1.f - 2.f * __builtin_amdgcn_rcpf(__expf(2.f * x) + 1.f); }
__device__ __forceinline__ float softplusf_(float x) { return x > 20.f ? x : log1pf(__expf(x)); }
__device__ __forceinline__ float geluf_(float x) { return 0.5f * x * (1.f + tanhf_(0.7978845608028654f * (x + 0.044715f * x * x * x))); }
__device__ __forceinline__ float wave_sum(float v) {
#pragma unroll
  for (int o = 32; o; o >>= 1) v += __shfl_xor(v, o);
  return v;
}
template <int C> __device__ __forceinline__ float dppf(float v) {
  return __int_as_float(__builtin_amdgcn_update_dpp(0, __float_as_int(v), C, 0xF, 0xF, true));
}
__device__ __forceinline__ float red16(float v) {
  v += dppf<0xB1>(v);
  v += dppf<0x4E>(v);
  v += dppf<0x141>(v);
  v += dppf<0x140>(v);
  return v;
}
__device__ __forceinline__ bool has_prev(int m) { return m < NCTX ? (m & 255) != 0 : ((m - NCTX) & 8191) != 0; }
__device__ __forceinline__ bool has_next(int m) { return m < NCTX ? (m & 255) != 255 : ((m - NCTX) & 8191) != 8191; }
__device__ __forceinline__ int mod_row(int m) { return m < NCTX ? 8 : ((m - NCTX) >> 13); }
__device__ __forceinline__ int scan_tok(int dir, int b, int s) {
  if (s < 256) return b * 256 + (dir ? 255 - s : s);
  int t = s - 256;
  return NCTX + b * 8192 + (dir ? 8191 - t : t);
}
__device__ __forceinline__ bf16x8 ldfrag(const u16* base, int stride, int row0, int k0, int lane) {
  return *(const bf16x8*)(base + (row0 + (lane & 15)) * stride + k0 + (lane >> 4) * 8);
}
__device__ __forceinline__ f32x4 mma(bf16x8 afrag, bf16x8 bfrag, f32x4 acc) {
  return __builtin_amdgcn_mfma_f32_16x16x32_bf16(bfrag, afrag, acc, 0, 0, 0);
}

template <class Epi> __forceinline__
__device__ __forceinline__ void gemm_phase(const u16* __restrict__ A, int lda, const u16* __restrict__ Bt, int ldb, int M, int N, int K,
                           Epi epi, char* smem_) {
  const int TT = opaque_tid();
  u16* As = (u16*)smem_;
  u16* Bs = As + 128 * 72;
  const int tid = LTID, lane = tid & 63, wave = tid >> 6;
  const int wm = (wave >> 1) * 64, wn = (wave & 1) * 64;
  const int tiles_n = (N + 127) >> 7, tiles_m = (M + 127) >> 7;
  const int ntiles = tiles_m * tiles_n;
  const int lrow = tid >> 3, lkc = (tid & 7) * 8;
  for (int vb = VBID; vb < ntiles; vb += VGRID) {
    const int tm = vb / tiles_n, tn = vb - tm * tiles_n;
    const int m0 = tm * 128, n0 = tn * 128;
    f32x4 acc[4][4];
#pragma unroll
    for (int i = 0; i < 4; ++i)
#pragma unroll
      for (int j = 0; j < 4; ++j) acc[i][j] = (f32x4){0.f, 0.f, 0.f, 0.f};
    u32x4 ra[4], rb[4];
    const u16* ap[4];
    const u16* bp[4];
#pragma unroll
    for (int i = 0; i < 4; ++i) {
      int row = lrow + i * 32;
      int am = min(m0 + row, M - 1), bn = min(n0 + row, N - 1);
      ap[i] = A + (size_t)am * lda + lkc;
      bp[i] = Bt + (size_t)bn * ldb + lkc;
    }
#pragma unroll
    for (int i = 0; i < 4; ++i) { ra[i] = *(const u32x4*)(ap[i]); rb[i] = *(const u32x4*)(bp[i]); }
    for (int k0 = 0; k0 < K; k0 += 64) {
      __syncthreads();
#pragma unroll
      for (int i = 0; i < 4; ++i) {
        *(u32x4*)(As + (lrow + i * 32) * 72 + lkc) = ra[i];
        *(u32x4*)(Bs + (lrow + i * 32) * 72 + lkc) = rb[i];
      }
      __syncthreads();
      if (k0 + 64 < K) {
#pragma unroll
        for (int i = 0; i < 4; ++i) { ra[i] = *(const u32x4*)(ap[i] + k0 + 64); rb[i] = *(const u32x4*)(bp[i] + k0 + 64); }
      }
#pragma unroll
      for (int kk = 0; kk < 64; kk += 32) {
        bf16x8 af[4], bfr[4];
#pragma unroll
        for (int i = 0; i < 4; ++i) af[i] = ldfrag(As, 72, wm + i * 16, kk, lane);
#pragma unroll
        for (int j = 0; j < 4; ++j) bfr[j] = ldfrag(Bs, 72, wn + j * 16, kk, lane);
#pragma unroll
        for (int i = 0; i < 4; ++i)
#pragma unroll
          for (int j = 0; j < 4; ++j) acc[i][j] = mma(af[i], bfr[j], acc[i][j]);
      }
    }
#pragma unroll
    for (int i = 0; i < 4; ++i)
#pragma unroll
      for (int j = 0; j < 4; ++j) {
        int m = m0 + wm + i * 16 + (lane & 15);
        int n = n0 + wn + j * 16 + (lane >> 4) * 4;
        if (m < M && n < N) epi(m, n, acc[i][j]);
      }
  }
}

struct EpiStore { static constexpr bool PERM = true; u16* C; int ldc;
  __device__ void store8(int m, int n, f32x4 a, f32x4 b) const { u32x4 o = {pack2(a[0], a[1]), pack2(a[2], a[3]), pack2(b[0], b[1]), pack2(b[2], b[3])}; *(u32x4*)(C + (size_t)m * ldc + n) = o; }
  __device__ void operator()(int m, int n, f32x4 v) const { *(uint2*)(C + (size_t)m * ldc + n) = pack4(v[0], v[1], v[2], v[3]); } };
struct EpiE { static constexpr bool PERM = false; u16* C; const float* w0;
  __device__ void operator()(int m, int n, f32x4 v) const {
    float4 w = *(const float4*)(w0 + n);
    *(uint2*)(C + (size_t)m * 512 + n) = pack4(sigmoidf_(w.x + v[0]) * 0.6065306597126334f, sigmoidf_(w.y + v[1]) * 0.6065306597126334f,
                                              sigmoidf_(w.z + v[2]) * 0.6065306597126334f, sigmoidf_(w.w + v[3]) * 0.6065306597126334f); } };
struct EpiI { static constexpr bool PERM = false; u16* C; const float* a0;
  __device__ void operator()(int m, int n, f32x4 v) const {
    float4 w = *(const float4*)(a0 + n);
    *(uint2*)(C + (size_t)m * 512 + n) = pack4(sigmoidf_(w.x + v[0]), sigmoidf_(w.y + v[1]), sigmoidf_(w.z + v[2]), sigmoidf_(w.w + v[3])); } };
struct EpiRes { static constexpr bool PERM = false; const float* src_c; const float* src_l; float* dst_c; float* dst_l; const float* modv_l; int gi; int moff;
  __device__ void operator()(int m_, int n, f32x4 v) const {
    int m = m_ + moff;
    const float* g = modv_l + (mod_row(m) * 6 + gi) * 1024 + n;
    float4 gg = *(const float4*)g;
    const float* s; float* d;
    if (m < NCTX) { s = src_c + (size_t)m * 1024 + n; d = dst_c + (size_t)m * 1024 + n; }
    else { s = src_l + (size_t)(m - NCTX) * 1024 + n; d = dst_l + (size_t)(m - NCTX) * 1024 + n; }
    float4 x = *(const float4*)s;
    x.x += gg.x * v[0]; x.y += gg.y * v[1]; x.z += gg.z * v[2]; x.w += gg.w * v[3];
    *(float4*)d = x; } };
struct EpiQKV { static constexpr bool PERM = true; u16* C;
  __device__ void store8(int m, int n, f32x4 a, f32x4 b) const {
    float sc_ = (n >= 1024 && n < 2048) ? 0.08838834764831845f : 1.f;
    u32x4 o = {pack2(a[0] * sc_, a[1] * sc_), pack2(a[2] * sc_, a[3] * sc_), pack2(b[0] * sc_, b[1] * sc_), pack2(b[2] * sc_, b[3] * sc_)};
    *(u32x4*)(C + (size_t)m * 4096 + n) = o; }
  __device__ void operator()(int m, int n, f32x4 v) const {
    float s = (n >= 1024 && n < 2048) ? 0.08838834764831845f : 1.f;
    *(uint2*)(C + (size_t)m * 4096 + n) = pack4(v[0] * s, v[1] * s, v[2] * s, v[3] * s); } };
struct EpiGate { static constexpr bool PERM = true; u16* Y; const float* rstd;
  __device__ void store8(int m, int n, f32x4 a, f32x4 b) const {
    u16* yp = Y + (size_t)m * 2048 + n;
    u32x4 yy = *(const u32x4*)yp;
    float r = rstd[m * 8 + (n >> 8)];
    float g[8] = {a[0], a[1], a[2], a[3], b[0], b[1], b[2], b[3]};
    float o[8];
#pragma unroll
    for (int i = 0; i < 4; ++i) {
      o[2 * i] = siluf_(g[2 * i]) * bf2f((u16)(yy[i] & 0xffff)) * r;
      o[2 * i + 1] = siluf_(g[2 * i + 1]) * bf2f((u16)(yy[i] >> 16)) * r;
    }
    u32x4 ov = {pack2(o[0], o[1]), pack2(o[2], o[3]), pack2(o[4], o[5]), pack2(o[6], o[7])};
    *(u32x4*)yp = ov; }
  __device__ void operator()(int m, int n, f32x4 v) const {
    u16* yp = Y + (size_t)m * 2048 + n;
    uint2 yy = *(const uint2*)yp;
    float r = rstd[m * 8 + (n >> 8)];
    float y0 = bf2f((u16)(yy.x & 0xffff)), y1 = bf2f((u16)(yy.x >> 16)), y2 = bf2f((u16)(yy.y & 0xffff)), y3 = bf2f((u16)(yy.y >> 16));
    *(uint2*)yp = pack4(siluf_(v[0]) * y0 * r, siluf_(v[1]) * y1 * r, siluf_(v[2]) * y2 * r, siluf_(v[3]) * y3 * r); } };

__device__ __forceinline__ void transpose_job(const float* __restrict__ src, u16* __restrict__ dst, int K, int N, char* smem) {
  const int TT = opaque_tid();
  float* tile = (float*)smem;
  const int tid = LTID;
  const int tk = K >> 6, tn = (N + 63) >> 6;
  const int ntiles = tk * tn;
  for (int vb = VBID; vb < ntiles; vb += VGRID) {
    const int k0 = (vb / tn) * 64, n0 = (vb % tn) * 64;
    __syncthreads();
#pragma unroll
    for (int i = 0; i < 4; ++i) {
      int r = (tid >> 4) + i * 16, c4 = (tid & 15) * 4;
      float4 v = make_float4(0.f, 0.f, 0.f, 0.f);
      if (n0 + c4 < N) v = *(const float4*)(src + (size_t)(k0 + r) * N + n0 + c4);
      tile[r * 65 + c4] = v.x; tile[r * 65 + c4 + 1] = v.y; tile[r * 65 + c4 + 2] = v.z; tile[r * 65 + c4 + 3] = v.w;
    }
    __syncthreads();
#pragma unroll
    for (int i = 0; i < 2; ++i) {
      int item = tid + i * 256; int kc = item & 7, n = item >> 3;
      if (n0 + n < N) {
        float v[8];
#pragma unroll
        for (int j = 0; j < 8; ++j) v[j] = tile[(kc * 8 + j) * 65 + n];
        u32x4 o = {pack2(v[0], v[1]), pack2(v[2], v[3]), pack2(v[4], v[5]), pack2(v[6], v[7])};
        *(u32x4*)(dst + (size_t)(n0 + n) * K + k0 + kc * 8) = o;
      }
    }
  }
}

__device__ __forceinline__ void phase_prep(const Params& p, char* smem) {
  const int TT = opaque_tid();
  u16* W = (u16*)p.ws;
  transpose_job(p.in[I_EVIN], W + W_EVIN, 1024, 3472, smem);
  transpose_job(p.in[I_W2F], W + W_W2F, 64, 512, smem);
  transpose_job(p.in[I_W2B], W + W_W2B, 64, 512, smem);
  transpose_job(p.in[I_A2F], W + W_A2F, 64, 512, smem);
  transpose_job(p.in[I_A2B], W + W_A2B, 64, 512, smem);
  transpose_job(p.in[I_G2], W + W_G2, 128, 512, smem);
  {
    float* rope = (float*)(p.ws + O_ROPE);
    for (int idx = VBID * 256 + LTID; idx < (128 + 64) * 32; idx += VGRID * 256) {
      int j = idx & 31, pos = idx >> 5;
      bool isrow = pos < 128;
      int pp = isrow ? pos : pos - 128;
      float inv = powf(10000.f, -(float)j / 32.f);
      float ang = (float)pp * inv;
      double a = (double)ang;
      double kq = rint(a * 0.15915494309189535);
      double r = a - kq * 6.283185307179586476925;
      double r2 = r * r;
      double sn = r, cs = 1.0, ts = r, tc = 1.0;
#pragma unroll 1
      for (int it = 1; it <= 14; ++it) {
        tc = -tc * r2 / (double)((2 * it - 1) * (2 * it));
        ts = -ts * r2 / (double)((2 * it) * (2 * it + 1));
        cs += tc; sn += ts;
      }
      if (isrow) { rope[pp * 32 + j] = (float)cs; rope[4096 + pp * 32 + j] = (float)sn; }
      else { rope[8192 + pp * 32 + j] = (float)cs; rope[8192 + 2048 + pp * 32 + j] = (float)sn; }
    }
  }
  {
    float* sc = (float*)smem;
    float* red = sc + 9 * 1024;
    float* modv = (float*)(p.ws + O_MODV);
    bool loaded = false;
    __syncthreads();
    for (int vb = VBID; vb < 384; vb += VGRID) {
      if (!loaded) {
        for (int i = LTID; i < 9 * 1024; i += 256) {
          int r = i >> 10, k = i & 1023;
          float cv = r < 8 ? p.in[I_C][r * 1024 + k] : p.in[I_CCTX][k];
          sc[i] = cv / (1.f + expf(-cv));
        }
        loaded = true;
        __syncthreads();
      }
      int l = vb / 192, jb = vb % 192;
      int jj = LTID & 31, kc = LTID >> 5;
      int j = jb * 32 + jj;
      const float* w = p.in[I_MODW] + ((size_t)l * 1024 + kc * 128) * 6144 + j;
      float acc[9];
#pragma unroll
      for (int r = 0; r < 9; ++r) acc[r] = 0.f;
#pragma unroll 16
      for (int k = 0; k < 128; ++k) {
        float wv = w[(size_t)k * 6144];
#pragma unroll
        for (int r = 0; r < 9; ++r) acc[r] += sc[r * 1024 + kc * 128 + k] * wv;
      }
      __syncthreads();
#pragma unroll
      for (int r = 0; r < 9; ++r) red[(kc * 9 + r) * 32 + jj] = acc[r];
      __syncthreads();
      if (kc == 0) {
        float mb = p.in[I_MODB][l * 6144 + j];
#pragma unroll
        for (int r = 0; r < 9; ++r) {
          float sum = 0.f;
#pragma unroll
          for (int q = 0; q < 8; ++q) sum += red[(q * 9 + r) * 32 + jj];
          modv[((size_t)l * 9 + r) * 6144 + j] = sum + mb;
        }
      }
    }
    __syncthreads();
  }
}

__device__ __forceinline__ void phase_norm(const float* src_c, const float* src_l, const float* g, const float* modv_l, int si, int sci,
                           u16* hx, int r0, int r1) {
  const int TT = opaque_tid();
  const int lane = LTID & 63, wv = LTID >> 6;
  for (int m = r0 + (VBID * 4 + wv) * 2; m < r1; m += VGRID * 8) {
    float4 v[2][4];
    float ss[2] = {0.f, 0.f};
#pragma unroll
    for (int q = 0; q < 2; ++q) {
      const int mm = m + q;
      const float* src = mm < NCTX ? src_c + (size_t)mm * 1024 : src_l + (size_t)(mm - NCTX) * 1024;
#pragma unroll
      for (int i = 0; i < 4; ++i) v[q][i] = *(const float4*)(src + i * 256 + lane * 4);
    }
#pragma unroll
    for (int q = 0; q < 2; ++q) {
#pragma unroll
      for (int i = 0; i < 4; ++i) ss[q] += v[q][i].x * v[q][i].x + v[q][i].y * v[q][i].y + v[q][i].z * v[q][i].z + v[q][i].w * v[q][i].w;
      ss[q] = wave_sum(ss[q]);
    }
#pragma unroll
    for (int q = 0; q < 2; ++q) {
      const int mm = m + q;
      const int r = mod_row(mm);
      const float* sh = modv_l + (r * 6 + si) * 1024;
      const float* scl = modv_l + (r * 6 + sci) * 1024;
      const float rstd = rsqrtf(ss[q] * (1.f / 1024.f) + 1e-6f);
#pragma unroll
      for (int i = 0; i < 4; ++i) {
        int c = i * 256 + lane * 4;
        float4 gg = *(const float4*)(g + c), s1 = *(const float4*)(scl + c), s0 = *(const float4*)(sh + c);
        float y0 = v[q][i].x * rstd * gg.x * (1.f + s1.x) + s0.x;
        float y1 = v[q][i].y * rstd * gg.y * (1.f + s1.y) + s0.y;
        float y2 = v[q][i].z * rstd * gg.z * (1.f + s1.z) + s0.z;
        float y3 = v[q][i].w * rstd * gg.w * (1.f + s1.w) + s0.w;
        *(uint2*)(hx + (size_t)mm * 1024 + c) = pack4(y0, y1, y2, y3);
      }
    }
  }
}

__device__ __forceinline__ float red8(float v) {
  v += dppf<0xB1>(v);
  v += dppf<0x4E>(v);
  v += dppf<0x141>(v);
  return v;
}
__device__ __forceinline__ void unpack8(u32x4 q, float* o) {
#pragma unroll
  for (int e = 0; e < 4; ++e) { o[2 * e] = bf2f((u16)(q[e] & 0xffff)); o[2 * e + 1] = bf2f((u16)(q[e] >> 16)); }
}
__device__ __forceinline__ u32x4 pack8(const float* o) {
  u32x4 r = {pack2(o[0], o[1]), pack2(o[2], o[3]), pack2(o[4], o[5]), pack2(o[6], o[7])};
  return r;
}
__device__ __forceinline__ void load8f(const float* p, float* o) {
  float4 a = *(const float4*)p, b = *(const float4*)(p + 4);
  o[0] = a.x; o[1] = a.y; o[2] = a.z; o[3] = a.w; o[4] = b.x; o[5] = b.y; o[6] = b.z; o[7] = b.w;
}
__device__ __forceinline__ void shifted8(const u16* row, int col, bool hp, bool hn, const float* mup, const float* mun, float* o) {
  const u32x4 z4 = {0u, 0u, 0u, 0u};
  u32x4 cur = *(const u32x4*)(row + col);
  u32x4 prv = *(const u32x4*)(row + col - (hp ? PW : 0));
  u32x4 nxt = *(const u32x4*)(row + col + (hn ? PW : 0));
  prv = hp ? prv : z4; nxt = hn ? nxt : z4;
  float u[8], pv[8], nx[8], mp[8], mn[8];
  unpack8(cur, u); unpack8(prv, pv); unpack8(nxt, nx);
  load8f(mup + col, mp); load8f(mun + col, mn);
#pragma unroll
  for (int i = 0; i < 8; ++i) o[i] = u[i] + mp[i] * (pv[i] - u[i]) + mn[i] * (nx[i] - u[i]);
}
__device__ __forceinline__ void phase_feat(const Params& p) {
  const int TT = opaque_tid();
  const u16* __restrict__ P = (const u16*)(p.ws + O_P);
  u16* __restrict__ Sr = (u16*)(p.ws + O_SR); u16* __restrict__ Sk = (u16*)(p.ws + O_SK); u16* __restrict__ Sv = (u16*)(p.ws + O_SV);
  float* __restrict__ rn = (float*)(p.ws + O_RN); float* __restrict__ bonus = (float*)(p.ws + O_BONUS);
  u16* __restrict__ L = (u16*)((char*)p.out + DO_L);
  const float* __restrict__ mup = p.in[I_MUP]; const float* __restrict__ mun = p.in[I_MUN];
  const int lane = LTID & 63, wv = LTID >> 6;
  const int h = lane >> 3, c = h * 64 + (lane & 7) * 8;
  float kkw[8], rkw[8];
  load8f(p.in[I_KK] + c, kkw); load8f(p.in[I_RK] + c, rkw);
#pragma unroll 2
  for (int m = VBID * 4 + wv; m < NTOK; m += VGRID * 4) {
    const bool hp = has_prev(m), hn = has_next(m);
    const u16* row = P + (size_t)m * PW;
    float r[8], k[8], v[8];
    shifted8(row, c, hp, hn, mup, mun, r);
    shifted8(row, 512 + c, hp, hn, mup, mun, k);
    shifted8(row, 1024 + c, hp, hn, mup, mun, v);
    *(u32x4*)(Sr + (size_t)m * 512 + c) = pack8(r);
    *(u32x4*)(Sk + (size_t)m * 512 + c) = pack8(k);
    *(u32x4*)(Sv + (size_t)m * 512 + c) = pack8(v);
    float s1 = 0.f, s2 = 0.f;
#pragma unroll
    for (int i = 0; i < 8; ++i) { float kk = k[i] * kkw[i]; s1 += kk * kk; s2 += r[i] * k[i] * rkw[i]; }
    s1 = red8(s1); s2 = red8(s2);
    if ((lane & 7) == 0) {
      rn[m * 8 + h] = 1.f / fmaxf(sqrtf(s1), 1e-12f);
      bonus[m * 8 + h] = s2;
    }
    if (lane < 48) {
      float o[8];
      shifted8(row, 1536 + lane * 8, hp, hn, mup, mun, o);
      const int g = lane >> 3;
#pragma unroll
      for (int i = 0; i < 8; ++i) o[i] = g < 2 ? tanhf_(o[i]) : (g < 4 ? o[i] : sigmoidf_(o[i]));
      *(u32x4*)(L + (size_t)m * 384 + lane * 8) = pack8(o);
    }
  }
}

__device__ __forceinline__ void transpose_item(const float* __restrict__ src, u16* __restrict__ dst, int K, int N, int idx) {
  const int n = idx % N, kb = idx / N;
  const float* sp = src + (size_t)kb * 8 * N + n;
  float v[8];
#pragma unroll
  for (int i = 0; i < 8; ++i) v[i] = sp[(size_t)i * N];
  u32x4 o = {pack2(v[0], v[1]), pack2(v[2], v[3]), pack2(v[4], v[5]), pack2(v[6], v[7])};
  *(u32x4*)(dst + (size_t)n * K + kb * 8) = o;
}
#define LATE_ITEMS 3342336
__device__ __forceinline__ void late_weight_item(const Params& p, int idx) {
  u16* W = (u16*)p.ws;
  if (idx < 131072) { transpose_item(p.in[I_EVOUT], W + W_EVOUT, 1024, 1024, idx); return; }
  idx -= 131072;
  if (idx < 720896) { transpose_item(p.in[I_FUP], W + W_UP0, 1024, 5632, idx); return; }
  idx -= 720896;
  if (idx < 720896) { transpose_item(p.in[I_FUP] + 1024ull * 5632, W + W_UP1, 1024, 5632, idx); return; }
  idx -= 720896;
  if (idx < 360448) { transpose_item(p.in[I_FDN], W + W_DN0, 2816, 1024, idx); return; }
  idx -= 360448;
  if (idx < 360448) { transpose_item(p.in[I_FDN] + 2816ull * 1024, W + W_DN1, 2816, 1024, idx); return; }
  idx -= 360448;
  if (idx < 786432) { transpose_item(p.in[I_RIN], W + W_RIN, 1024, 6144, idx); return; }
  idx -= 786432;
  if (idx < 262144) { transpose_item(p.in[I_ROUT], W + W_ROUT, 2048, 1024, idx); return; }
}

using f32x2 = __attribute__((ext_vector_type(2))) float;
__device__ __forceinline__ void phase_rwkv(const Params& p, char* smem) {
  const u16* Sr = (const u16*)(p.ws + O_SR); const u16* Sk = (const u16*)(p.ws + O_SK); const u16* Sv = (const u16*)(p.ws + O_SV);
  const float* rn = (const float*)(p.ws + O_RN);
  u16* P = (u16*)(p.ws + O_P);
  constexpr int CH = 32;
  constexpr int NCH = 8448 / CH;
  float* buf = (float*)smem;
  float* vbuf = buf + 2 * 5 * CH * 64;
  const int tid = opaque_tid(), lane = tid & 63, wave = tid >> 6;
  const bool producer = tid >= 256;
  const int pt = tid & 255;
  const int ch = pt & 63, st0 = pt >> 6;
  const int rg = lane >> 4, ls = lane & 15;
  const int r0 = (wave & 3) * 8 + rg * 2;
  for (int vb = blockIdx.x; vb < 256; vb += gridDim.x) {
    const int seq = (vb & 7) * 16 + (vb >> 4), hh = (vb >> 3) & 1;
    const int dir = seq >> 6, b = (seq >> 3) & 7, h = seq & 7;
    const u16* Se = (const u16*)(p.ws + (dir ? O_SEB : O_SEF));
    const u16* Si = (const u16*)(p.ws + (dir ? O_SIB : O_SIF));
    const float kkc = p.in[I_KK][h * 64 + ch], kac = p.in[I_KA][h * 64 + ch];
    f32x2 s00 = {0.f, 0.f}, s01 = {0.f, 0.f}, s10 = {0.f, 0.f}, s11 = {0.f, 0.f};
    u16 gr[CH / 4], gk[CH / 4], ge[CH / 4], gi[CH / 4]; float grn[CH / 4]; u16 gv[CH / 8];
    auto gload = [&](int c) {
#pragma unroll
      for (int i = 0; i < CH / 4; ++i) {
        int m = scan_tok(dir, b, c * CH + st0 + i * 4);
        size_t o = (size_t)m * 512 + h * 64 + ch;
        gr[i] = Sr[o]; gk[i] = Sk[o]; ge[i] = Se[o]; gi[i] = Si[o]; grn[i] = rn[m * 8 + h];
      }
#pragma unroll
      for (int i = 0; i < CH / 8; ++i) {
        int item = pt + i * 256;
        int mv = scan_tok(dir, b, c * CH + (item >> 5));
        gv[i] = Sv[(size_t)mv * 512 + h * 64 + hh * 32 + (item & 31)];
      }
    };
    auto sstore = [&](int bi) {
      float* B = buf + bi * (5 * CH * 64);
#pragma unroll
      for (int i = 0; i < CH / 4; ++i) {
        int st = st0 + i * 4;
        float r = bf2f(gr[i]), k = bf2f(gk[i]), e = bf2f(ge[i]), ic = bf2f(gi[i]);
        float kk = k * kkc * grn[i];
        B[(0 * CH + st) * 64 + ch] = -kk;
        B[(1 * CH + st) * 64 + ch] = kk * ic;
        B[(2 * CH + st) * 64 + ch] = k * (1.f + (ic - 1.f) * kac);
        B[(3 * CH + st) * 64 + ch] = __expf(-e);
        B[(4 * CH + st) * 64 + ch] = r;
      }
#pragma unroll
      for (int i = 0; i < CH / 8; ++i) vbuf[bi * (CH * 32) + pt + i * 256] = bf2f(gv[i]);
    };
    __syncthreads();
    if (producer) { gload(0); sstore(0); gload(1); }
    __syncthreads();
    for (int c = 0; c < NCH; ++c) {
      if (producer) {
        if (c + 1 < NCH) { sstore((c + 1) & 1); if (c + 2 < NCH) gload(c + 2); }
        {
          const int li = c * ((int)gridDim.x * 256) + blockIdx.x * 256 + pt;
          if (li < LATE_ITEMS && vb == (int)blockIdx.x) late_weight_item(p, li);
        }
      } else {
        const float* B = buf + (c & 1) * (5 * CH * 64);
        const float* VB = vbuf + (c & 1) * (CH * 32);
        f32x2 ykeep = {0.f, 0.f}, ykeep2 = {0.f, 0.f};
#pragma unroll
        for (int st = 0; st < CH; ++st) {
          f32x4 a = *(const f32x4*)(B + (0 * CH + st) * 64 + ls * 4);
          f32x4 bb = *(const f32x4*)(B + (1 * CH + st) * 64 + ls * 4);
          f32x4 kd = *(const f32x4*)(B + (2 * CH + st) * 64 + ls * 4);
          f32x4 w = *(const f32x4*)(B + (3 * CH + st) * 64 + ls * 4);
          f32x4 r = *(const f32x4*)(B + (4 * CH + st) * 64 + ls * 4);
          f32x2 vv = *(const f32x2*)(VB + st * 32 + r0);
          f32x2 alo = {a[0], a[1]}, ahi = {a[2], a[3]}, blo = {bb[0], bb[1]}, bhi = {bb[2], bb[3]};
          f32x2 klo = {kd[0], kd[1]}, khi = {kd[2], kd[3]}, wlo = {w[0], w[1]}, whi = {w[2], w[3]};
          f32x2 rlo = {r[0], r[1]}, rhi = {r[2], r[3]};
          f32x2 t0 = s00 * alo + s01 * ahi;
          f32x2 t1 = s10 * alo + s11 * ahi;
          float sa0 = red16(t0[0] + t0[1]);
          float sa1 = red16(t1[0] + t1[1]);
          f32x2 sa0v = {sa0, sa0}, sa1v = {sa1, sa1}, v0v = {vv[0], vv[0]}, v1v = {vv[1], vv[1]};
          s00 = s00 * wlo + sa0v * blo + v0v * klo;
          s01 = s01 * whi + sa0v * bhi + v0v * khi;
          s10 = s10 * wlo + sa1v * blo + v1v * klo;
          s11 = s11 * whi + sa1v * bhi + v1v * khi;
          f32x2 u0 = s00 * rlo + s01 * rhi;
          f32x2 u1 = s10 * rlo + s11 * rhi;
          float y0 = red16(u0[0] + u0[1]);
          float y1 = red16(u1[0] + u1[1]);
          if (st < 16) { ykeep[0] = (ls == st) ? y0 : ykeep[0]; ykeep[1] = (ls == st) ? y1 : ykeep[1]; }
          else { ykeep2[0] = (ls == st - 16) ? y0 : ykeep2[0]; ykeep2[1] = (ls == st - 16) ? y1 : ykeep2[1]; }
        }
#pragma unroll
        for (int half_ = 0; half_ < 2; ++half_) {
          const int sidx = c * CH + half_ * 16 + ls;
          const int tt = sidx - 256;
          const int mctx = b * 256 + (dir ? 255 - sidx : sidx);
          const int mlat = NCTX + b * 8192 + (dir ? 8191 - tt : tt);
          const int m = sidx < 256 ? mctx : mlat;
          const f32x2 yk = half_ ? ykeep2 : ykeep;
          *(unsigned*)(P + (size_t)m * PW + dir * 512 + h * 64 + hh * 32 + r0) = pack2(yk[0], yk[1]);
        }
      }
      __syncthreads();
    }
  }
}

__device__ __forceinline__ float xbc_conv(const u16* P, int m, int cx, const float* cw, const float* cb, bool hp, bool hn) {
  const u16* q = P + (size_t)m * PW + 2432 + cx;
  float v = cb[cx] + cw[1024 + cx] * bf2f(q[0]);
  if (hp) v += cw[cx] * bf2f(q[-PW]);
  if (hn) v += cw[2048 + cx] * bf2f(q[PW]);
  return siluf_(v);
}

#define XLO(w) bf2f((u16)((w) & 0xffff))
#define XHI(w) bf2f((u16)((w) >> 16))
__device__ __forceinline__ void phase_xbc(const Params& p) {
  const int TT = opaque_tid();
  const u16* __restrict__ P = (const u16*)(p.ws + O_P);
  u16* __restrict__ X = (u16*)((char*)p.out + DO_HX);
  const float* __restrict__ cw = p.in[I_SCW]; const float* __restrict__ cb = p.in[I_SCB];
  const int total = NTOK * 128;
#pragma unroll 2
  for (int idx = VBID * 256 + LTID; idx < total; idx += VGRID * 256) {
    const int m = idx >> 7, c = (idx & 127) * 8;
    const u16* q = P + (size_t)m * PW + 2432 + c;
    const u32x4 z4 = {0u, 0u, 0u, 0u};
    const bool hp = has_prev(m), hn = has_next(m);
    u32x4 cur = *(const u32x4*)q;
    u32x4 prv = *(const u32x4*)(q - (hp ? PW : 0));
    u32x4 nxt = *(const u32x4*)(q + (hn ? PW : 0));
    prv = hp ? prv : z4; nxt = hn ? nxt : z4;
    float o[8];
#pragma unroll
    for (int e = 0; e < 4; ++e) {
      int c0 = c + 2 * e, c1 = c0 + 1;
      float v0 = cb[c0] + cw[c0] * XLO(prv[e]) + cw[1024 + c0] * XLO(cur[e]) + cw[2048 + c0] * XLO(nxt[e]);
      float v1 = cb[c1] + cw[c1] * XHI(prv[e]) + cw[1024 + c1] * XHI(cur[e]) + cw[2048 + c1] * XHI(nxt[e]);
      o[2 * e] = siluf_(v0); o[2 * e + 1] = siluf_(v1);
    }
    u32x4 ov = {pack2(o[0], o[1]), pack2(o[2], o[3]), pack2(o[4], o[5]), pack2(o[6], o[7])};
    *(u32x4*)(X + (size_t)m * 1024 + c) = ov;
  }
}

__device__ __forceinline__ void phase_ssd_prep(const Params& p) {
  const int TT = opaque_tid();
  const u16* __restrict__ P = (const u16*)(p.ws + O_P);
  float* __restrict__ dtb = (float*)(p.ws + O_DT); float* __restrict__ csb = (float*)(p.ws + O_CS);
  for (int idx = VBID * 256 + LTID; idx < 528 * 16; idx += VGRID * 256) {
    int cidx = idx >> 4, dir = (idx >> 3) & 1, h = idx & 7;
    float bias = dir ? p.in[I_DTBB][h] : p.in[I_DTBF][h];
    float A = -expf(dir ? p.in[I_ALB][h] : p.in[I_ALF][h]);
    float cs = 0.f;
#pragma unroll 16
    for (int i = 0; i < 128; ++i) {
      int l = dir ? 127 - i : i;
      int m = cidx * 128 + l;
      float dtr = bf2f(P[(size_t)m * PW + 3456 + dir * 8 + h]);
      float dt = softplusf_(dtr + bias);
      cs += dt * A;
      dtb[((size_t)dir * NTOK + m) * 8 + h] = dt;
      csb[((size_t)dir * NTOK + m) * 8 + h] = cs;
    }
  }
}

__device__ __forceinline__ void phase_ssd_states(const Params& p, char* smem) {
  const int TT = opaque_tid();
  const u16* P = (const u16*)(p.ws + O_P);
  const float* dtb = (const float*)(p.ws + O_DT); const float* csb = (const float*)(p.ws + O_CS);
  float* states = (float*)(p.ws + O_STATES);
  const float* cw = p.in[I_SCW]; const float* cb = p.in[I_SCB];
  const u16* X = (const u16*)((const char*)p.out + DO_HX);
  u16* XTf = (u16*)smem; u16* XTb = XTf + 64 * 136; u16* BT = XTb + 64 * 136;
  float* wf = (float*)(BT + 128 * 136);
  const int tid = LTID, lane = tid & 63, wave = tid >> 6;
  for (int vb = VBID; vb < 528 * 8; vb += VGRID) {
    const int cidx = vb >> 3, h = vb & 7, g = h >> 2;
    const int mb = cidx * 128;
    __syncthreads();
    {
      int d = tid >> 7, l = tid & 127;
      float tot = csb[((size_t)d * NTOK + mb + (d ? 0 : 127)) * 8 + h];
      size_t o = ((size_t)d * NTOK + mb + l) * 8 + h;
      wf[d * 128 + l] = dtb[o] * __expf(tot - csb[o]);
    }
    __syncthreads();
#pragma unroll
    for (int i = 0; i < 2; ++i) {
      int item = tid + i * 256; int lp = item & 63, cg = item >> 6;
      int l0 = 2 * lp;
      const u16* xp = X + (size_t)(mb + l0) * 1024 + h * 64 + cg * 8;
      u32x4 x0 = *(const u32x4*)xp, x1 = *(const u32x4*)(xp + 1024);
      float f0 = wf[l0], f1 = wf[l0 + 1], b0 = wf[128 + l0], b1 = wf[128 + l0 + 1];
#pragma unroll
      for (int e = 0; e < 4; ++e) {
        float a0 = XLO(x0[e]), a1 = XLO(x1[e]), c0 = XHI(x0[e]), c1 = XHI(x1[e]);
        *(unsigned*)(XTf + (cg * 8 + 2 * e) * 136 + l0) = pack2(a0 * f0, a1 * f1);
        *(unsigned*)(XTf + (cg * 8 + 2 * e + 1) * 136 + l0) = pack2(c0 * f0, c1 * f1);
        *(unsigned*)(XTb + (cg * 8 + 2 * e) * 136 + l0) = pack2(a0 * b0, a1 * b1);
        *(unsigned*)(XTb + (cg * 8 + 2 * e + 1) * 136 + l0) = pack2(c0 * b0, c1 * b1);
      }
    }
#pragma unroll
    for (int i = 0; i < 4; ++i) {
      int item = tid + i * 256; int lp = item & 63, cg = item >> 6;
      int l0 = 2 * lp;
      const u16* xp = X + (size_t)(mb + l0) * 1024 + 512 + g * 128 + cg * 8;
      u32x4 x0 = *(const u32x4*)xp, x1 = *(const u32x4*)(xp + 1024);
#pragma unroll
      for (int e = 0; e < 4; ++e) {
        *(unsigned*)(BT + (cg * 8 + 2 * e) * 136 + l0) = (x0[e] & 0xffffu) | (x1[e] << 16);
        *(unsigned*)(BT + (cg * 8 + 2 * e + 1) * 136 + l0) = (x0[e] >> 16) | (x1[e] & 0xffff0000u);
      }
    }
    __syncthreads();
#pragma unroll
    for (int d = 0; d < 2; ++d) {
      const u16* XT = d ? XTb : XTf;
      f32x4 acc[4][2];
#pragma unroll
      for (int i = 0; i < 4; ++i) { acc[i][0] = (f32x4){0, 0, 0, 0}; acc[i][1] = (f32x4){0, 0, 0, 0}; }
#pragma unroll
      for (int kk = 0; kk < 128; kk += 32) {
        bf16x8 af[4], bfr[2];
#pragma unroll
        for (int i = 0; i < 4; ++i) af[i] = ldfrag(XT, 136, i * 16, kk, lane);
#pragma unroll
        for (int j = 0; j < 2; ++j) bfr[j] = ldfrag(BT, 136, wave * 32 + j * 16, kk, lane);
#pragma unroll
        for (int i = 0; i < 4; ++i)
#pragma unroll
          for (int j = 0; j < 2; ++j) acc[i][j] = mma(af[i], bfr[j], acc[i][j]);
      }
      float* so = states + (((size_t)d * 528 + cidx) * 8 + h) * 8192;
#pragma unroll
      for (int i = 0; i < 4; ++i)
#pragma unroll
        for (int j = 0; j < 2; ++j) {
          int pp = i * 16 + (lane & 15), n = wave * 32 + j * 16 + (lane >> 4) * 4;
          *(float4*)(so + pp * 128 + n) = make_float4(acc[i][j][0], acc[i][j][1], acc[i][j][2], acc[i][j][3]);
        }
    }
  }
}

__device__ __forceinline__ int ssd_chunk_seq(int d, int b, int j) {
  if (j < 2) return 2 * b + (d ? 1 - j : j);
  int t = j - 2;
  return 16 + b * 64 + (d ? 63 - t : t);
}

__device__ __forceinline__ void phase_ssd_scan(const Params& p) {
  const int TT = opaque_tid();
  float* states = (float*)(p.ws + O_STATES);
  const float* csb = (const float*)(p.ws + O_CS);
  for (int idx = VBID * 256 + LTID; idx < 2 * 8 * 8 * 2048; idx += VGRID * 256) {
    const int q = idx & 2047, h = (idx >> 11) & 7, b = (idx >> 14) & 7, d = idx >> 17;
    auto sptr = [&](int j) -> f32x4* {
      int cidx = ssd_chunk_seq(d, b, j);
      return (f32x4*)(states + (((size_t)d * 528 + cidx) * 8 + h) * 8192) + q;
    };
    auto totof = [&](int j) -> float {
      int cidx = ssd_chunk_seq(d, b, j);
      return csb[((size_t)d * NTOK + cidx * 128 + (d ? 0 : 127)) * 8 + h];
    };
    f32x4 hh = {0.f, 0.f, 0.f, 0.f};
    f32x4 sv[4]; float tv[4];
#pragma unroll
    for (int u = 0; u < 4; ++u) { sv[u] = *sptr(u); tv[u] = totof(u); }
#pragma unroll 1
    for (int j0 = 0; j0 < 64; j0 += 4) {
      f32x4 sn[4]; float tn[4];
#pragma unroll
      for (int u = 0; u < 4; ++u) {
        const int jn = j0 + 4 + u;
        const int jc = jn < 66 ? jn : 65;
        sn[u] = *sptr(jc); tn[u] = totof(jc);
      }
#pragma unroll
      for (int u = 0; u < 4; ++u) {
        *sptr(j0 + u) = hh;
        hh = hh * __expf(tv[u]) + sv[u];
      }
#pragma unroll
      for (int u = 0; u < 4; ++u) { sv[u] = sn[u]; tv[u] = tn[u]; }
    }
#pragma unroll
    for (int u = 0; u < 2; ++u) {
      *sptr(64 + u) = hh;
      hh = hh * __expf(tv[u]) + sv[u];
    }
  }
}

__device__ __forceinline__ void phase_ssd_out(const Params& p, char* smem) {
  const int TT = opaque_tid();
  u16* P = (u16*)(p.ws + O_P);
  const float* dtb = (const float*)(p.ws + O_DT); const float* csb = (const float*)(p.ws + O_CS);
  const float* states = (const float*)(p.ws + O_STATES);
  const float* cw = p.in[I_SCW]; const float* cb = p.in[I_SCB];
  const u16* X = (const u16*)((const char*)p.out + DO_HX);
  u16* Cs = (u16*)smem;
  u16* Bs = Cs + 64 * 136;
  u16* Gs = Bs; u16* Hs = Bs + 64 * 136;
  u16* XT = Bs + 128 * 136;
  float* csf = (float*)(XT + 64 * 136);
  float* csbk = csf + 128; float* dtf = csbk + 128; float* dtbk = dtf + 128;
  const int tid = LTID, lane = tid & 63, wave = tid >> 6;
  for (int vb = VBID; vb < 528 * 16; vb += VGRID) {
    const int lh = vb & 1, h = (vb >> 1) & 7, cidx = vb >> 4, g = h >> 2;
    const int mb = cidx * 128;
    f32x4 hv[2][8];
#pragma unroll
    for (int d = 0; d < 2; ++d) {
      const float* hp = states + (((size_t)d * 528 + cidx) * 8 + h) * 8192;
#pragma unroll
      for (int i = 0; i < 8; ++i) { int item = tid + i * 256; hv[d][i] = *(const f32x4*)(hp + (item >> 5) * 128 + (item & 31) * 4); }
    }
    __syncthreads();
    if (tid < 128) {
      size_t o0 = ((size_t)0 * NTOK + mb + tid) * 8 + h, o1 = ((size_t)1 * NTOK + mb + tid) * 8 + h;
      csf[tid] = csb[o0]; csbk[tid] = csb[o1]; dtf[tid] = dtb[o0]; dtbk[tid] = dtb[o1];
    }
#pragma unroll
    for (int i = 0; i < 4; ++i) {
      int item = tid + i * 256; int cg = item & 15, l = item >> 4;
      *(u32x4*)(Cs + l * 136 + cg * 8) = *(const u32x4*)(X + (size_t)(mb + lh * 64 + l) * 1024 + 768 + g * 128 + cg * 8);
    }
#pragma unroll
    for (int i = 0; i < 8; ++i) {
      int item = tid + i * 256; int cg = item & 15, sidx = item >> 4;
      *(u32x4*)(Bs + sidx * 136 + cg * 8) = *(const u32x4*)(X + (size_t)(mb + sidx) * 1024 + 512 + g * 128 + cg * 8);
    }
#pragma unroll
    for (int i = 0; i < 2; ++i) {
      int item = tid + i * 256; int lp = item & 63, cg = item >> 6;
      int l0 = 2 * lp;
      const u16* xp = X + (size_t)(mb + l0) * 1024 + h * 64 + cg * 8;
      u32x4 x0 = *(const u32x4*)xp, x1 = *(const u32x4*)(xp + 1024);
#pragma unroll
      for (int e = 0; e < 4; ++e) {
        *(unsigned*)(XT + (cg * 8 + 2 * e) * 136 + l0) = (x0[e] & 0xffffu) | (x1[e] << 16);
        *(unsigned*)(XT + (cg * 8 + 2 * e + 1) * 136 + l0) = (x0[e] >> 16) | (x1[e] & 0xffff0000u);
      }
    }
    __syncthreads();
    f32x4 cbacc[8];
#pragma unroll
    for (int t = 0; t < 8; ++t) cbacc[t] = (f32x4){0, 0, 0, 0};
#pragma unroll 1
    for (int kk = 0; kk < 128; kk += 32) {
      bf16x8 af = ldfrag(Cs, 136, wave * 16, kk, lane);
#pragma unroll
      for (int t = 0; t < 8; ++t) cbacc[t] = mma(af, ldfrag(Bs, 136, t * 16, kk, lane), cbacc[t]);
    }
    __syncthreads();
    const int lloc = wave * 16 + (lane & 15);
    const int l = lh * 64 + lloc;
    const float cfl = csf[l], cbl = csbk[l];
#pragma unroll 2
    for (int t = 0; t < 8; ++t) {
      float gv[4];
#pragma unroll
      for (int j = 0; j < 4; ++j) {
        int s = t * 16 + (lane >> 4) * 4 + j;
        float f = 0.f;
        if (s <= l) f += __expf(cfl - csf[s]) * dtf[s];
        if (s >= l) f += __expf(cbl - csbk[s]) * dtbk[s];
        gv[j] = cbacc[t][j] * f;
      }
      *(uint2*)(Gs + lloc * 136 + t * 16 + (lane >> 4) * 4) = pack4(gv[0], gv[1], gv[2], gv[3]);
    }
    __syncthreads();
    f32x4 yacc[4];
#pragma unroll
    for (int t = 0; t < 4; ++t) yacc[t] = (f32x4){0, 0, 0, 0};
#pragma unroll 1
    for (int kk = 0; kk < 128; kk += 32) {
      bf16x8 af = ldfrag(Gs, 136, wave * 16, kk, lane);
#pragma unroll
      for (int t = 0; t < 4; ++t) yacc[t] = mma(af, ldfrag(XT, 136, t * 16, kk, lane), yacc[t]);
    }
#pragma unroll
    for (int d = 0; d < 2; ++d) {
      __syncthreads();
#pragma unroll
      for (int i = 0; i < 8; ++i) {
        int item = tid + i * 256;
        int pp = item >> 5, n4 = (item & 31) * 4;
        *(uint2*)(Hs + pp * 136 + n4) = pack4(hv[d][i][0], hv[d][i][1], hv[d][i][2], hv[d][i][3]);
      }
      __syncthreads();
      f32x4 ia[4];
#pragma unroll
      for (int t = 0; t < 4; ++t) ia[t] = (f32x4){0, 0, 0, 0};
#pragma unroll 1
      for (int kk = 0; kk < 128; kk += 32) {
        bf16x8 af = ldfrag(Cs, 136, wave * 16, kk, lane);
#pragma unroll
        for (int t = 0; t < 4; ++t) ia[t] = mma(af, ldfrag(Hs, 136, t * 16, kk, lane), ia[t]);
      }
      float sc = __expf(d ? cbl : cfl);
#pragma unroll
      for (int t = 0; t < 4; ++t)
#pragma unroll
        for (int j = 0; j < 4; ++j) yacc[t][j] += sc * ia[t][j];
    }
    const float Dh = p.in[I_SD][h];
    const int m = mb + l;
#pragma unroll
    for (int t = 0; t < 4; ++t) {
      int p0 = t * 16 + (lane >> 4) * 4;
      float o[4];
#pragma unroll
      for (int j = 0; j < 4; ++j) o[j] = yacc[t][j] + Dh * bf2f(XT[(p0 + j) * 136 + l]);
      *(uint2*)(P + (size_t)m * PW + 1024 + h * 64 + p0) = pack4(o[0], o[1], o[2], o[3]);
    }
  }
}

__device__ __forceinline__ void phase_finish(const Params& p) {
  const int TT = opaque_tid();
  const u16* __restrict__ P = (const u16*)(p.ws + O_P);
  const u16* __restrict__ Sv = (const u16*)(p.ws + O_SV);
  const u16* __restrict__ G = (const u16*)((const char*)p.out + DO_G);
  const float* __restrict__ bonus = (const float*)(p.ws + O_BONUS);
  u16* __restrict__ mixed = (u16*)(p.ws + O_MIXED);
  const int lane = LTID & 63, wv = LTID >> 6;
  const int h = lane >> 3, c = h * 64 + (lane & 7) * 8;
  float lnw[8], lnb[8], nw[8];
  load8f(p.in[I_LNW] + c, lnw); load8f(p.in[I_LNB] + c, lnb); load8f(p.in[I_SNW] + c, nw);
#pragma unroll 2
  for (int m = VBID * 4 + wv; m < NTOK; m += VGRID * 4) {
    const u16* row = P + (size_t)m * PW;
    float yf[8], yb[8], sv[8], gg[8], ys[8], z[8];
    unpack8(*(const u32x4*)(row + c), yf);
    unpack8(*(const u32x4*)(row + 512 + c), yb);
    unpack8(*(const u32x4*)(Sv + (size_t)m * 512 + c), sv);
    unpack8(*(const u32x4*)(G + (size_t)m * 512 + c), gg);
    unpack8(*(const u32x4*)(row + 1024 + c), ys);
    unpack8(*(const u32x4*)(row + 1920 + c), z);
    const float bn = bonus[m * 8 + h];
    float sum = 0.f;
#pragma unroll
    for (int i = 0; i < 8; ++i) { yf[i] += yb[i]; sum += yf[i]; }
    const float mean = red8(sum) * (1.f / 64.f);
    float vs = 0.f;
#pragma unroll
    for (int i = 0; i < 8; ++i) { yf[i] -= mean; vs += yf[i] * yf[i]; }
    const float rs = rsqrtf(red8(vs) * (1.f / 64.f) + 64e-5f);
    float o1[8], t[8]; float ss = 0.f;
#pragma unroll
    for (int i = 0; i < 8; ++i) {
      o1[i] = (yf[i] * rs * lnw[i] + lnb[i] + bn * sv[i]) * gg[i];
      t[i] = ys[i] * siluf_(z[i]);
      ss += t[i] * t[i];
    }
    ss = wave_sum(ss);
    const float rstd = rsqrtf(ss * (1.f / 512.f) + 1e-6f);
#pragma unroll
    for (int i = 0; i < 8; ++i) t[i] = t[i] * rstd * nw[i];
    *(u32x4*)(mixed + (size_t)m * 1024 + c) = pack8(o1);
    *(u32x4*)(mixed + (size_t)m * 1024 + 512 + c) = pack8(t);
  }
}

__device__ __forceinline__ void phase_ffnconv(const Params& p, int layer, int r0) {
  const int TT = opaque_tid();
  u16* GV = (u16*)(p.ws + O_GV);
  const float* cw = p.in[I_FCW] + (size_t)layer * 9 * 2816;
  const float* cb = p.in[I_FCB] + (size_t)layer * 2816;
  const int gt = VBID * 256 + LTID;
  const int ngrp = (VGRID * 256) / 352;
  if (gt >= ngrp * 352) return;
  const int j = (gt % 352) * 8, tl = gt / 352;
  float w[9][8], bias[8];
#pragma unroll
  for (int k = 0; k < 9; ++k) load8f(cw + k * 2816 + j, w[k]);
  load8f(cb + j, bias);
  const u32x4 z4 = {0u, 0u, 0u, 0u};
#pragma unroll 1
  for (int m0 = r0 + tl; m0 < NTOK; m0 += 2 * ngrp) {
    u32x4 g[2][9]; u32x4 vq[2];
#pragma unroll
    for (int q = 0; q < 2; ++q) {
      const int m = (m0 + q * ngrp < NTOK) ? m0 + q * ngrp : m0;
      const bool isctx = m < NCTX;
      const int t = isctx ? (m & 255) : ((m - NCTX) & 8191);
      const int rr = t >> 6, cc = t & 63;
#pragma unroll
      for (int dy = -1; dy <= 1; ++dy)
#pragma unroll
        for (int dx = -1; dx <= 1; ++dx) {
          const int k = (dy + 1) * 3 + dx + 1;
          const bool valid = isctx ? (dy == 0 && t + dx >= 0 && t + dx < 256)
                                   : (rr + dy >= 0 && rr + dy < 128 && cc + dx >= 0 && cc + dx < 64);
          const int mm = valid ? m + dy * 64 + dx : m;
          u32x4 qv = *(const u32x4*)(GV + (size_t)mm * 5632 + j);
          g[q][k] = valid ? qv : z4;
        }
      vq[q] = *(const u32x4*)(GV + (size_t)m * 5632 + 2816 + j);
    }
    asm volatile("" ::: "memory");
#pragma unroll
    for (int q = 0; q < 2; ++q) {
      const int m = m0 + q * ngrp;
      if (m < NTOK) {
        float acc[8];
#pragma unroll
        for (int i = 0; i < 8; ++i) acc[i] = bias[i];
#pragma unroll
        for (int k = 0; k < 9; ++k)
#pragma unroll
          for (int e = 0; e < 4; ++e) {
            acc[2 * e] += w[k][2 * e] * XLO(g[q][k][e]);
            acc[2 * e + 1] += w[k][2 * e + 1] * XHI(g[q][k][e]);
          }
        float o[8];
#pragma unroll
        for (int e = 0; e < 4; ++e) {
          o[2 * e] = geluf_(acc[2 * e]) * XLO(vq[q][e]);
          o[2 * e + 1] = geluf_(acc[2 * e + 1]) * XHI(vq[q][e]);
        }
        *(u32x4*)(GV + (size_t)m * 5632 + 2816 + j) = pack8(o);
      }
    }
  }
}

__device__ __forceinline__ void phase_rope(const Params& p) {
  const int TT = opaque_tid();
  u16* QKV = (u16*)(p.ws + O_QKV);
  const float* rope = (const float*)(p.ws + O_ROPE);
  const int total = NLAT * 128;
  const int nthr = VGRID * 256;
  for (int idx0 = VBID * 256 + LTID; idx0 < total; idx0 += nthr * 4) {
    u32x4 a[4], bq[4];
#pragma unroll
    for (int u = 0; u < 4; ++u) {
      const int idx = idx0 + u * nthr;
      if (idx >= total) continue;
      const int t = idx >> 7, r = idx & 127;
      const int jg = r & 7, hh = (r >> 3) & 7, qk = r >> 6;
      const u16* base = QKV + (size_t)(NCTX + t) * 4096 + qk * 1024 + hh * 128 + jg * 8;
      a[u] = *(const u32x4*)base; bq[u] = *(const u32x4*)(base + 64);
    }
    asm volatile("" ::: "memory");
#pragma unroll
    for (int u = 0; u < 4; ++u) {
      const int idx = idx0 + u * nthr;
      if (idx >= total) continue;
      const int t = idx >> 7, r = idx & 127;
      const int jg = r & 7, hh = (r >> 3) & 7, qk = r >> 6;
      const int pos = t & 8191, prow = pos >> 6, pcol = pos & 63;
      const int j = jg * 8;
      u16* base = QKV + (size_t)(NCTX + t) * 4096 + qk * 1024 + hh * 128 + j;
      float x1[8], x2[8], o1[8], o2[8];
      unpack8(a[u], x1); unpack8(bq[u], x2);
      const float* ct = j < 32 ? rope + prow * 32 + j : rope + 8192 + pcol * 32 + j - 32;
      const float* stb = j < 32 ? rope + 4096 + prow * 32 + j : rope + 8192 + 2048 + pcol * 32 + j - 32;
      float cs[8], sn[8];
      load8f(ct, cs); load8f(stb, sn);
#pragma unroll
      for (int i = 0; i < 8; ++i) { o1[i] = x1[i] * cs[i] - x2[i] * sn[i]; o2[i] = x2[i] * cs[i] + x1[i] * sn[i]; }
      *(u32x4*)base = pack8(o1);
      *(u32x4*)(base + 64) = pack8(o2);
    }
  }
}

__device__ __forceinline__ void phase_retention(const Params& p, char* smem) {
  const u16* QKV = (const u16*)(p.ws + O_QKV);
  u16* Y = (u16*)(p.ws + O_Y);
  u16* Qs = (u16*)smem;
  u16* Ks = Qs + 64 * 136;
  u16* KT = Ks + 64 * 136;
  u16* VT = KT + 128 * 72;
  u16* Sb = VT + 64 * 72;
  u16* Pm = Sb + 64 * 136;
  const int tid = opaque_tid(), lane = tid & 63, wave = tid >> 6;
  const int quad = lane >> 4, l16 = lane & 15;
  const int rt = wave & 3, chf = wave >> 2;
  for (int vb = blockIdx.x; vb < 256; vb += gridDim.x) {
    const int xq_ = vb >> 3, bh_ = (vb & 7) * 8 + (xq_ >> 2);
    const int b = bh_ >> 3, h = bh_ & 7, sl = xq_ & 3;
#pragma unroll 1
    for (int d = 0; d < 2; ++d) {
      const float l2 = d ? p.in[I_L2B][h] : p.in[I_L2F][h];
      const float lg = log1pf(-exp2f(-l2));
      const float gC = __expf(lg * 64.f);
      f32x4 st[4];
#pragma unroll
      for (int t = 0; t < 4; ++t) st[t] = (f32x4){0, 0, 0, 0};
      u32x4 rq[2], rk[2], rv;
      auto chunk_m0 = [&](int cs_) { return d ? scan_tok(1, b, cs_ * 64 + 63) : scan_tok(0, b, cs_ * 64); };
      auto gload = [&](int cs_) {
        int m0 = chunk_m0(cs_);
#pragma unroll
        for (int i = 0; i < 2; ++i) {
          int item = tid + i * 512; int row = item & 63, c8 = (item >> 6) * 8;
          const u16* bp = QKV + (size_t)(m0 + row) * 4096 + h * 128 + c8;
          rq[i] = *(const u32x4*)bp;
          rk[i] = *(const u32x4*)(bp + 1024);
        }
        {
          int row = tid & 63, c8 = (tid >> 6) * 8;
          rv = *(const u32x4*)(QKV + (size_t)(m0 + row) * 4096 + 2048 + h * 256 + sl * 64 + c8);
        }
      };
      auto sstore = [&]() {
#pragma unroll
        for (int i = 0; i < 2; ++i) {
          int item = tid + i * 512; int row = item & 63, c8 = (item >> 6) * 8;
          *(u32x4*)(Qs + row * 136 + c8) = rq[i];
          *(u32x4*)(Ks + row * 136 + c8) = rk[i];
          float ke = __expf(lg * (float)(d ? row : 63 - row));
#pragma unroll
          for (int e = 0; e < 4; ++e) {
            KT[(c8 + 2 * e) * 72 + row] = f2bf(bf2f((u16)(rk[i][e] & 0xffff)) * ke);
            KT[(c8 + 2 * e + 1) * 72 + row] = f2bf(bf2f((u16)(rk[i][e] >> 16)) * ke);
          }
        }
        {
          int row = tid & 63, c8 = (tid >> 6) * 8;
#pragma unroll
          for (int e = 0; e < 4; ++e) {
            VT[(c8 + 2 * e) * 72 + row] = (u16)(rv[e] & 0xffff);
            VT[(c8 + 2 * e + 1) * 72 + row] = (u16)(rv[e] >> 16);
          }
        }
#pragma unroll
        for (int t = 0; t < 4; ++t)
          *(uint2*)(Sb + (rt * 16 + l16) * 136 + (4 * chf + t) * 16 + quad * 4) = pack4(st[t][0], st[t][1], st[t][2], st[t][3]);
      };
      gload(0);
#pragma unroll 1
      for (int cs_ = 0; cs_ < 132; ++cs_) {
        const int m0 = chunk_m0(cs_);
        __syncthreads();
        sstore();
        __syncthreads();
        if (cs_ + 1 < 132) gload(cs_ + 1);
        u16* const ypb = Y + (size_t)(m0 + rt * 16 + l16 - NCTX) * 2048 + h * 256 + sl * 64 + quad * 4;
        uint2 yprev[2] = {make_uint2(0u, 0u), make_uint2(0u, 0u)};
        if (d && m0 >= NCTX) {
#pragma unroll
          for (int t = 0; t < 2; ++t) yprev[t] = *(const uint2*)(ypb + (2 * chf + t) * 16);
        }
        f32x4 sc[2];
#pragma unroll
        for (int t = 0; t < 2; ++t) sc[t] = (f32x4){0, 0, 0, 0};
#pragma unroll
        for (int kk = 0; kk < 128; kk += 32) {
          bf16x8 af = ldfrag(Qs, 136, rt * 16, kk, lane);
#pragma unroll
          for (int t = 0; t < 2; ++t) sc[t] = mma(af, ldfrag(Ks, 136, (2 * chf + t) * 16, kk, lane), sc[t]);
        }
        const int l = rt * 16 + l16;
#pragma unroll
        for (int t = 0; t < 2; ++t) {
          float pv[4];
#pragma unroll
          for (int j = 0; j < 4; ++j) {
            int s = (2 * chf + t) * 16 + quad * 4 + j;
            int dist = d ? s - l : l - s;
            pv[j] = dist >= 0 ? sc[t][j] * __expf(lg * (float)dist) : 0.f;
          }
          *(uint2*)(Pm + l * 72 + (2 * chf + t) * 16 + quad * 4) = pack4(pv[0], pv[1], pv[2], pv[3]);
        }
        __syncthreads();
        f32x4 ya[2], yi[2];
#pragma unroll
        for (int t = 0; t < 2; ++t) { ya[t] = (f32x4){0, 0, 0, 0}; yi[t] = (f32x4){0, 0, 0, 0}; }
#pragma unroll
        for (int kk = 0; kk < 64; kk += 32) {
          bf16x8 af = ldfrag(Pm, 72, rt * 16, kk, lane);
#pragma unroll
          for (int t = 0; t < 2; ++t) ya[t] = mma(af, ldfrag(VT, 72, (2 * chf + t) * 16, kk, lane), ya[t]);
        }
#pragma unroll
        for (int kk = 0; kk < 128; kk += 32) {
          bf16x8 af = ldfrag(Qs, 136, rt * 16, kk, lane);
#pragma unroll
          for (int t = 0; t < 2; ++t) yi[t] = mma(af, ldfrag(Sb, 136, (2 * chf + t) * 16, kk, lane), yi[t]);
        }
#pragma unroll
        for (int t = 0; t < 4; ++t) { st[t][0] *= gC; st[t][1] *= gC; st[t][2] *= gC; st[t][3] *= gC; }
#pragma unroll
        for (int kk = 0; kk < 64; kk += 32) {
          bf16x8 af = ldfrag(VT, 72, rt * 16, kk, lane);
#pragma unroll
          for (int t = 0; t < 4; ++t) st[t] = mma(af, ldfrag(KT, 72, (4 * chf + t) * 16, kk, lane), st[t]);
        }
        if (m0 >= NCTX) {
          const float qd = __expf(lg * (float)(d ? 64 - l : l + 1));
          u16* yp = Y + (size_t)(m0 + l - NCTX) * 2048 + h * 256 + sl * 64 + quad * 4;
#pragma unroll
          for (int t = 0; t < 2; ++t) {
            float o[4];
#pragma unroll
            for (int j = 0; j < 4; ++j) o[j] = ya[t][j] + qd * yi[t][j];
            u16* yq = yp + (2 * chf + t) * 16;
            if (d) {
              const uint2 prev = yprev[t];
              o[0] += bf2f((u16)(prev.x & 0xffff)); o[1] += bf2f((u16)(prev.x >> 16));
              o[2] += bf2f((u16)(prev.y & 0xffff)); o[3] += bf2f((u16)(prev.y >> 16));
            }
            *(uint2*)yq = pack4(o[0], o[1], o[2], o[3]);
          }
        }
      }
    }
  }
}

__device__ __forceinline__ void phase_ynorm(const Params& p) {
  const int TT = opaque_tid();
  const u16* __restrict__ Y = (const u16*)(p.ws + O_Y);
  float* __restrict__ rstd = (float*)(p.ws + O_RSTD);
  const int lane = LTID & 63, wv = LTID >> 6;
#pragma unroll 2
  for (int m = VBID * 4 + wv; m < NLAT; m += VGRID * 4) {
#pragma unroll
    for (int h = 0; h < 8; ++h) {
      uint2 q = *(const uint2*)(Y + (size_t)m * 2048 + h * 256 + lane * 4);
      float a = bf2f((u16)(q.x & 0xffff)), b2 = bf2f((u16)(q.x >> 16)), c = bf2f((u16)(q.y & 0xffff)), d = bf2f((u16)(q.y >> 16));
      float ss = wave_sum(a * a + b2 * b2 + c * c + d * d);
      if (lane == 0) rstd[m * 8 + h] = rsqrtf(ss * (1.f / 256.f) + 1e-6f);
    }
  }
}

__device__ __forceinline__ void phase_final(const Params& p) {
  const int TT = opaque_tid();
  const float* g = p.in[I_FNG];
  const int lane = LTID & 63, wv = LTID >> 6;
  for (int m = (VBID * 4 + wv) * 2; m < NLAT; m += VGRID * 8) {
    float4 v[2][4]; float ss[2] = {0.f, 0.f};
#pragma unroll
    for (int q = 0; q < 2; ++q)
#pragma unroll
      for (int i = 0; i < 4; ++i) v[q][i] = *(const float4*)(p.out + (size_t)(m + q) * 1024 + i * 256 + lane * 4);
#pragma unroll
    for (int q = 0; q < 2; ++q) {
#pragma unroll
      for (int i = 0; i < 4; ++i) ss[q] += v[q][i].x * v[q][i].x + v[q][i].y * v[q][i].y + v[q][i].z * v[q][i].z + v[q][i].w * v[q][i].w;
      ss[q] = wave_sum(ss[q]);
    }
#pragma unroll
    for (int q = 0; q < 2; ++q) {
      const float rstd = rsqrtf(ss[q] * (1.f / 1024.f) + 1e-6f);
#pragma unroll
      for (int i = 0; i < 4; ++i) {
        int c = i * 256 + lane * 4;
        float4 gg = *(const float4*)(g + c);
        *(float4*)(p.out + (size_t)(m + q) * 1024 + c) = make_float4(v[q][i].x * rstd * gg.x, v[q][i].y * rstd * gg.y, v[q][i].z * rstd * gg.z, v[q][i].w * rstd * gg.w);
      }
    }
  }
}

#define XB_TMO      128
#define XB_XCNT(j)  (256  + 64 * (j))
#define XB_XSUB(j)  (1280 + 64 * (j))
#define XB_XGEN(j)  (2304 + 64 * (j))
#define XB_TOP      3328
#define XB_TOPGEN   3392
#define XCD_BAR_WORDS 3456
#define XB_SPIN_CAP (1u << 22)
#define LAS __attribute__((address_space(3)))
__device__ __forceinline__ unsigned xb_ld(unsigned* p)              { return __hip_atomic_load(p, __ATOMIC_RELAXED, __HIP_MEMORY_SCOPE_AGENT); }
__device__ __forceinline__ unsigned xb_add(unsigned* p, unsigned v) { return __hip_atomic_fetch_add(p, v, __ATOMIC_RELAXED, __HIP_MEMORY_SCOPE_AGENT); }
__device__ __forceinline__ unsigned xb_xcc_id() { return (unsigned)__builtin_amdgcn_s_getreg((3 << 11) | 20) & 0xFu; }
#define XB_SPIN(cond, bar) do { unsigned _sp = 0; while (cond) { __builtin_amdgcn_s_sleep(1); \
    if ((++_sp & 255u) == 0u) { if (xb_ld(&(bar)[XB_TMO])) break; if (_sp > XB_SPIN_CAP) { atomicAdd(&(bar)[XB_TMO], 1u); break; } } } } while (0)
struct XcdBarrier { unsigned* bar; unsigned x; volatile LAS unsigned* st; };
__device__ __forceinline__ XcdBarrier xcd_barrier_post(unsigned* bar, volatile LAS unsigned* st) {
  XcdBarrier b; b.bar = bar; b.x = xb_xcc_id(); b.st = st;
  if (threadIdx.x == 0) (void)xb_add(&bar[XB_XCNT(b.x)], 1u);
  return b;
}
__device__ __forceinline__ void xcd_barrier_complete(unsigned* bar, unsigned x, unsigned& nloc, unsigned& nx) {
  const unsigned G = gridDim.x * gridDim.y * gridDim.z;
  unsigned sum, cnt, mine, sp = 0u;
  for (;;) {
    sum = 0u; cnt = 0u; mine = 0u;
#pragma unroll
    for (unsigned j = 0; j < 16; ++j) { const unsigned c = xb_ld(&bar[XB_XCNT(j)]); sum += c; cnt += (c > 0u) ? 1u : 0u; mine = (j == x) ? c : mine; }
    if (sum == G) break;
    __builtin_amdgcn_s_sleep(1);
    if ((++sp & 255u) == 0u) { if (xb_ld(&bar[XB_TMO])) break; if (sp > XB_SPIN_CAP) { atomicAdd(&bar[XB_TMO], 1u); break; } }
  }
  nloc = mine > 0u ? mine : 1u; nx = cnt > 0u ? cnt : 1u;
}
__device__ __forceinline__ void xcd_barrier(const XcdBarrier& b) {
  asm volatile("s_waitcnt vmcnt(0)" ::: "memory");
  __syncthreads();
  if (threadIdx.x == 0) {
    unsigned* bar = b.bar;
    __builtin_amdgcn_s_waitcnt(0);
    unsigned nloc = b.st[0], nx = b.st[1];
    if (nloc == 0u) { xcd_barrier_complete(bar, b.x, nloc, nx); b.st[0] = nloc; b.st[1] = nx; }
    const unsigned old = xb_add(&bar[XB_XSUB(b.x)], 1u);
    const unsigned gen = old / nloc;
    if (old + 1u == (gen + 1u) * nloc) {
      __builtin_amdgcn_fence(__ATOMIC_RELEASE, "agent");
      asm volatile("s_waitcnt vmcnt(0)" ::: "memory");
      const unsigned og = xb_add(&bar[XB_TOP], 1u);
      const unsigned tg = og / nx;
      if (og + 1u == (tg + 1u) * nx) xb_add(&bar[XB_TOPGEN], 1u);
      else XB_SPIN(xb_ld(&bar[XB_TOPGEN]) == tg, bar);
      __builtin_amdgcn_fence(__ATOMIC_ACQUIRE, "agent");
      xb_add(&bar[XB_XGEN(b.x)], 1u);
      asm volatile("s_waitcnt vmcnt(0)" ::: "memory");
    } else {
      XB_SPIN(xb_ld(&bar[XB_XGEN(b.x)]) == gen, bar);
      __builtin_amdgcn_fence(__ATOMIC_ACQUIRE, "agent");
      asm volatile("s_waitcnt vmcnt(0)" ::: "memory");
    }
  }
  __syncthreads();
}

#ifndef PHMASK
#define PHMASK 0xFFFFFFFFFFFFFFFFull
#endif
#ifndef PHREP
#define PHREP 0ull
#endif
namespace pg8 {
#define PG8_LAS __attribute__((address_space(3)))
constexpr int BM = 256, BK = 64, HALF = 128, HTB = HALF * BK * 2, STAGE_BYTES = 8 * HTB, NXCD = 8, WGM = 8;
__device__ __forceinline__ int lds_byte(int r, int c) { const int st = (r >> 4) * 2 + (c >> 5), rr = r & 15, cc = c & 31, ob = rr * 64 + cc * 2; return st * 1024 + (ob ^ (((ob >> 9) & 1) << 5)); }
__device__ __forceinline__ void stage_rc(int b, int& R, int& C) { const int st = b / 1024, sb = b % 1024, swz = sb ^ (((sb >> 9) & 1) << 5); R = (st >> 1) * 16 + swz / 64; C = (st & 1) * 32 + (swz % 64) / 2; }
__device__ __forceinline__ int perm32(int rho) { const int n = rho >> 4, i = rho & 15; return 8 * (i >> 2) + 4 * n + (i & 3); }
struct Unit { int pm, pn; };
struct Gemm { const u16* A; const u16* Bt; int M, N, K, lda; };
struct StaticOrder {
  int nM, nN, nwg, G, c;
  __device__ void init(int M, int N, int G_, int c_) { nM = M / BM; nN = N / BM; nwg = nM * nN; G = G_; c = c_; }
  __device__ bool next(int i, Unit& u) const {
    const long L = (long)i * G + c; if (L >= nwg) return false;
    int wgid = (int)L; { const int q = nwg / NXCD, r = nwg % NXCD, xcd = wgid % NXCD, off = wgid / NXCD; wgid = (xcd < r ? xcd * (q + 1) : r * (q + 1) + (xcd - r) * q) + off; }
    const int nig = WGM * nN, gid = wgid / nig, fm = gid * WGM, gsz = (nM - fm) < WGM ? (nM - fm) : WGM;
    u.pm = fm + ((wgid % nig) % gsz); u.pn = (wgid % nig) / gsz; return true;
  }
};
template <class Epi>
__device__ __forceinline__ void gemm_phase(PG8_LAS unsigned char* lds, const Gemm g, const StaticOrder& S, const Epi& E) {
  const int tid = opaque_tid(), wid = __builtin_amdgcn_readfirstlane(tid >> 6), lane = tid & 63, wr = wid >> 2, wc = wid & 3, fr = lane & 15, fq = lane >> 4;
  const int K = g.K, nt = K / BK;
  unsigned voffA[2], voffB[2];
#pragma unroll
  for (int i = 0; i < 2; ++i) { int R, C; stage_rc(tid * 16 + i * 8192, R, C);
    const int Rb = Epi::PERM ? ((R & ~31) + perm32(R & 31)) : R;
    voffA[i] = (unsigned)(R * g.lda + C) * 2u; voffB[i] = (unsigned)(Rb * K + C) * 2u; }
  const size_t kstep = (size_t)(BK * 2);
  const size_t hstepA = (size_t)HALF * g.lda * 2, hstepB = (size_t)HALF * K * 2;
  const size_t tstepA = 2 * hstepA, tstepB = 2 * hstepB;
  const unsigned ldsw = (unsigned)wid * 1024u;
  const int aoff = lds_byte(wr * 64 + fr, fq * 8), boff = lds_byte(wc * 32 + fr, fq * 8);
#define PG8_SA(b, h) (((b) * 2 + (h)) * HTB)
#define PG8_SB(b, h) ((4 + (b) * 2 + (h)) * HTB)
#define PG8_STAGE(bufoff, gbase, voff) do { _Pragma("unroll") for (int _i = 0; _i < 2; ++_i) \
        __builtin_amdgcn_global_load_lds((const unsigned*)((const char*)(gbase) + (voff)[_i]), (PG8_LAS unsigned*)(lds + (bufoff) + ldsw + _i * 8192), 16, 0, 0); } while (0)
#define PG8_LDA(dst, b, h) do { _Pragma("unroll") for (int m = 0; m < 4; ++m) _Pragma("unroll") for (int k = 0; k < 2; ++k) dst[m][k] = *(const PG8_LAS bf16x8*)(lds + PG8_SA(b, h) + aoff + m * 2048 + k * 1024); } while (0)
#define PG8_LDB(dst, b, h) do { _Pragma("unroll") for (int n = 0; n < 2; ++n) _Pragma("unroll") for (int k = 0; k < 2; ++k) dst[n][k] = *(const PG8_LAS bf16x8*)(lds + PG8_SB(b, h) + boff + n * 2048 + k * 1024); } while (0)
#define PG8_MMA(ai, bj, At, Bt) do { __builtin_amdgcn_s_setprio(1); _Pragma("unroll") for (int m = 0; m < 4; ++m) _Pragma("unroll") for (int n = 0; n < 2; ++n) _Pragma("unroll") for (int k = 0; k < 2; ++k) \
        acc[ai][bj][m][n] = __builtin_amdgcn_mfma_f32_16x16x32_bf16(Bt[n][k], At[m][k], acc[ai][bj][m][n], 0, 0, 0); __builtin_amdgcn_s_setprio(0); } while (0)
#define PG8_WAIT_V(n) asm volatile("s_waitcnt vmcnt(" #n ")" ::: "memory")
#define PG8_WAIT_L(n) asm volatile("s_waitcnt lgkmcnt(" #n ")" ::: "memory")
#define PG8_BAR __builtin_amdgcn_s_barrier()
#define PG8_SCHED __builtin_amdgcn_sched_barrier(0)
  Unit cur, nxt; int ui = 0;
  if (!S.next(0, cur)) return;
  f32x4 acc[2][2][4][2];
#pragma unroll
  for (int a = 0; a < 2; ++a)
#pragma unroll
    for (int b = 0; b < 2; ++b)
#pragma unroll
      for (int m = 0; m < 4; ++m)
#pragma unroll
        for (int n = 0; n < 2; ++n) acc[a][b][m][n] = (f32x4){0.f, 0.f, 0.f, 0.f};
  bf16x8 At[4][2], B0[2][2], B1[2][2];
  const char* cA = (const char*)g.A + (size_t)cur.pm * tstepA; const char* cB = (const char*)g.Bt + (size_t)cur.pn * tstepB;
  PG8_STAGE(PG8_SB(0, 0), cB, voffB); PG8_STAGE(PG8_SA(0, 0), cA, voffA); PG8_STAGE(PG8_SB(0, 1), cB + hstepB, voffB); PG8_STAGE(PG8_SA(0, 1), cA + hstepA, voffA);
  if (wr == 1) PG8_BAR;
  PG8_WAIT_V(4); PG8_BAR;
  PG8_STAGE(PG8_SB(1, 0), cB + kstep, voffB); PG8_STAGE(PG8_SA(1, 0), cA + kstep, voffA); PG8_STAGE(PG8_SB(1, 1), cB + hstepB + kstep, voffB);
  PG8_WAIT_V(6); PG8_BAR;
  for (;;) {
    const bool has_next = S.next(ui + 1, nxt);
    const char* nA = has_next ? (const char*)g.A + (size_t)nxt.pm * tstepA : cA; const char* nB = has_next ? (const char*)g.Bt + (size_t)nxt.pn * tstepB : cB;
    for (int t = 0; t < nt; t += 2) {
      const bool last = (t == nt - 2);
      const char* a1 = cA + (size_t)(t + 1) * kstep;
      const char* a2 = last ? nA : cA + (size_t)(t + 2) * kstep; const char* b2 = last ? nB : cB + (size_t)(t + 2) * kstep;
      const char* a3 = a2 + kstep; const char* b3 = b2 + kstep;
      PG8_LDB(B0, 0, 0); PG8_SCHED; PG8_LDA(At, 0, 0); PG8_STAGE(PG8_SA(1, 1), a1 + hstepA, voffA);
      PG8_WAIT_L(8); PG8_BAR; PG8_WAIT_L(0); PG8_MMA(0, 0, At, B0); PG8_BAR; PG8_SCHED;
      PG8_LDB(B1, 0, 1); PG8_STAGE(PG8_SB(0, 0), b2, voffB);
      PG8_BAR; PG8_WAIT_L(0); PG8_MMA(0, 1, At, B1); PG8_BAR;
      PG8_LDA(At, 0, 1); PG8_STAGE(PG8_SA(0, 0), a2, voffA);
      PG8_BAR; PG8_WAIT_L(0); PG8_MMA(1, 0, At, B0); PG8_BAR; PG8_SCHED;
      PG8_STAGE(PG8_SB(0, 1), b2 + hstepB, voffB);
      PG8_WAIT_V(6); PG8_BAR; PG8_MMA(1, 1, At, B1); PG8_BAR;
      PG8_LDB(B0, 1, 0); PG8_SCHED; PG8_LDA(At, 1, 0); PG8_STAGE(PG8_SA(0, 1), a2 + hstepA, voffA);
      PG8_WAIT_L(8); PG8_BAR; PG8_WAIT_L(0); PG8_MMA(0, 0, At, B0); PG8_BAR; PG8_SCHED;
      PG8_LDB(B1, 1, 1); PG8_STAGE(PG8_SB(1, 0), b3, voffB);
      PG8_BAR; PG8_WAIT_L(0); PG8_MMA(0, 1, At, B1); PG8_BAR;
      PG8_LDA(At, 1, 1); PG8_STAGE(PG8_SA(1, 0), a3, voffA);
      PG8_BAR; PG8_WAIT_L(0); PG8_MMA(1, 0, At, B0); PG8_BAR; PG8_SCHED;
      PG8_STAGE(PG8_SB(1, 1), b3 + hstepB, voffB);
      PG8_WAIT_V(6); PG8_BAR; PG8_MMA(1, 1, At, B1); PG8_BAR;
    }
    E(acc, cur, wr, wc, fr, fq);
    if (!has_next) break;
#pragma unroll
    for (int a = 0; a < 2; ++a)
#pragma unroll
      for (int b = 0; b < 2; ++b)
#pragma unroll
        for (int m = 0; m < 4; ++m)
#pragma unroll
          for (int n = 0; n < 2; ++n) acc[a][b][m][n] = (f32x4){0.f, 0.f, 0.f, 0.f};
    cur = nxt; cA = nA; cB = nB; ++ui;
  }
  PG8_WAIT_V(0);
  if (wr == 0) PG8_BAR;
  PG8_BAR;
#undef PG8_SA
#undef PG8_SB
#undef PG8_STAGE
#undef PG8_LDA
#undef PG8_LDB
#undef PG8_MMA
#undef PG8_WAIT_V
#undef PG8_WAIT_L
#undef PG8_BAR
#undef PG8_SCHED
}
}

template <class Epi> struct PgEpi {
  static constexpr bool PERM = Epi::PERM;
  Epi e; int nreal;
  __device__ __forceinline__ void operator()(const f32x4 (&acc)[2][2][4][2], const pg8::Unit& u, int wr, int wc, int fr, int fq) const {
#pragma unroll
    for (int ai = 0; ai < 2; ++ai)
#pragma unroll
      for (int m = 0; m < 4; ++m) {
        const int row = u.pm * 256 + ai * 128 + wr * 64 + m * 16 + fr;
#pragma unroll
        for (int bj = 0; bj < 2; ++bj) {
          if constexpr (Epi::PERM) {
            const int col = u.pn * 256 + bj * 128 + wc * 32 + 8 * fq;
            if (col < nreal) e.store8(row, col, acc[ai][bj][m][0], acc[ai][bj][m][1]);
          } else {
#pragma unroll
            for (int n = 0; n < 2; ++n) {
              const int col = u.pn * 256 + bj * 128 + wc * 32 + n * 16 + 4 * fq;
              if (col < nreal) e(row, col, acc[ai][bj][m][n]);
            }
          }
        }
      }
  }
};
template <> struct PgEpi<EpiRes> {
  static constexpr bool PERM = false;
  EpiRes e; int nreal;
  __device__ __forceinline__ void operator()(const f32x4 (&acc)[2][2][4][2], const pg8::Unit& u, int wr, int wc, int fr, int fq) const {
    const int row0 = u.pm * 256 + e.moff;
    const int col0 = u.pn * 256 + wc * 32 + 4 * fq;
    const float* g = e.modv_l + (mod_row(row0) * 6 + e.gi) * 1024 + col0;
    f32x4 gv[2][2];
#pragma unroll
    for (int bj = 0; bj < 2; ++bj)
#pragma unroll
      for (int n = 0; n < 2; ++n) gv[bj][n] = *(const f32x4*)(g + bj * 128 + n * 16);
    const bool isctx = row0 < NCTX;
    const float* sb = isctx ? e.src_c + (size_t)row0 * 1024 : e.src_l + (size_t)(row0 - NCTX) * 1024;
    float* db = isctx ? e.dst_c + (size_t)row0 * 1024 : e.dst_l + (size_t)(row0 - NCTX) * 1024;
#pragma unroll
    for (int ai = 0; ai < 2; ++ai)
#pragma unroll
      for (int mp = 0; mp < 2; ++mp) {
        f32x4 x[2][2][2];
#pragma unroll
        for (int mi = 0; mi < 2; ++mi) {
          const size_t off = (size_t)(ai * 128 + wr * 64 + (mp * 2 + mi) * 16 + fr) * 1024 + col0;
#pragma unroll
          for (int bj = 0; bj < 2; ++bj)
#pragma unroll
            for (int n = 0; n < 2; ++n) x[mi][bj][n] = *(const f32x4*)(sb + off + bj * 128 + n * 16);
        }
        asm volatile("" ::: "memory");
#pragma unroll
        for (int mi = 0; mi < 2; ++mi) {
          const size_t off = (size_t)(ai * 128 + wr * 64 + (mp * 2 + mi) * 16 + fr) * 1024 + col0;
#pragma unroll
          for (int bj = 0; bj < 2; ++bj)
#pragma unroll
            for (int n = 0; n < 2; ++n) *(f32x4*)(db + off + bj * 128 + n * 16) = x[mi][bj][n] + gv[bj][n] * acc[ai][bj][mp * 2 + mi][n];
        }
        asm volatile("" ::: "memory");
      }
  }
};
template <> struct PgEpi<EpiGate> {
  static constexpr bool PERM = true;
  EpiGate e; int nreal;
  __device__ __forceinline__ void operator()(const f32x4 (&acc)[2][2][4][2], const pg8::Unit& u, int wr, int wc, int fr, int fq) const {
    const int col0 = u.pn * 256 + wc * 32 + 8 * fq;
    u32x4 yv[2][4][2]; float rs[2][4];
#pragma unroll
    for (int ai = 0; ai < 2; ++ai)
#pragma unroll
      for (int m = 0; m < 4; ++m) {
        const int row = u.pm * 256 + ai * 128 + wr * 64 + m * 16 + fr;
        rs[ai][m] = e.rstd[row * 8 + u.pn];
#pragma unroll
        for (int bj = 0; bj < 2; ++bj) yv[ai][m][bj] = *(const u32x4*)(e.Y + (size_t)row * 2048 + col0 + bj * 128);
      }
    asm volatile("" ::: "memory");
#pragma unroll
    for (int ai = 0; ai < 2; ++ai)
#pragma unroll
      for (int m = 0; m < 4; ++m) {
        const int row = u.pm * 256 + ai * 128 + wr * 64 + m * 16 + fr;
#pragma unroll
        for (int bj = 0; bj < 2; ++bj) {
          const f32x4 a = acc[ai][bj][m][0], b = acc[ai][bj][m][1];
          const float r = rs[ai][m];
          const u32x4 yy = yv[ai][m][bj];
          float o[8];
          o[0] = siluf_(a[0]) * XLO(yy[0]) * r; o[1] = siluf_(a[1]) * XHI(yy[0]) * r;
          o[2] = siluf_(a[2]) * XLO(yy[1]) * r; o[3] = siluf_(a[3]) * XHI(yy[1]) * r;
          o[4] = siluf_(b[0]) * XLO(yy[2]) * r; o[5] = siluf_(b[1]) * XHI(yy[2]) * r;
          o[6] = siluf_(b[2]) * XLO(yy[3]) * r; o[7] = siluf_(b[3]) * XHI(yy[3]) * r;
          *(u32x4*)(e.Y + (size_t)row * 2048 + col0 + bj * 128) = pack8(o);
        }
      }
  }
};
template <class Epi>
__device__ __forceinline__ void big_gemm(const u16* A, int lda, const u16* Bt, int M, int N, int K, Epi epi, char* smem) {
  const int npad = (N + 255) & ~255;
  pg8::StaticOrder S; S.init(M, npad, gridDim.x, blockIdx.x);
  pg8::Gemm g{A, Bt, M, npad, K, lda};
  PgEpi<Epi> E{epi, N};
  pg8::gemm_phase((PG8_LAS unsigned char*)smem, g, S, E);
  __syncthreads();
}

__global__ void __launch_bounds__(512, 2) mega(Params p) {
  extern __shared__ __attribute__((aligned(16))) char smem0[];
#define HSMEM (smem0 + (opaque_tid() >> 8) * HALF_LDS)
  cg::grid_group grid = cg::this_grid();
  volatile LAS unsigned* xst = (volatile LAS unsigned*)(smem0 + LDS_BYTES);
  if (threadIdx.x == 0) { xst[0] = 0u; xst[1] = 0u; }
  __syncthreads();
  XcdBarrier xb = xcd_barrier_post((unsigned*)(p.ws + O_BAR), xst);
  u16* W = (u16*)p.ws;
  float* modv = (float*)(p.ws + O_MODV);
  float* ctxr = (float*)(p.ws + O_CTXR);
  u16* hx0 = (u16*)((char*)p.out + DO_HX);
  u16* hx = (u16*)(p.ws + O_HX);

  for (int rep_ = 0; rep_ < (int)(((PHMASK >> 0) & 1ull) + ((PHREP >> 0) & 1ull)); ++rep_) {
  phase_prep(p, HSMEM);
  }
  grid.sync();
  for (int rep_ = 0; rep_ < (int)(((PHMASK >> 1) & 1ull) + ((PHREP >> 1) & 1ull)); ++rep_) {
  phase_norm(p.in[I_CTX], p.in[I_X], p.in[I_N1G], modv, 0, 1, hx0, 0, NTOK);
  }
  xcd_barrier(xb);
  for (int rep_ = 0; rep_ < (int)(((PHMASK >> 2) & 1ull) + ((PHREP >> 2) & 1ull)); ++rep_) {
  big_gemm(hx0, 1024, W + W_EVIN, NTOK, PW, 1024, EpiStore{(u16*)(p.ws + O_P), PW}, smem0);
  }
  xcd_barrier(xb);
  for (int rep_ = 0; rep_ < (int)(((PHMASK >> 3) & 1ull) + ((PHREP >> 3) & 1ull)); ++rep_) {
  phase_feat(p);
  phase_xbc(p);
  }
  xcd_barrier(xb);
  {
    const u16* L = (const u16*)((const char*)p.out + DO_L);
    for (int rep_ = 0; rep_ < (int)(((PHMASK >> 4) & 1ull) + ((PHREP >> 4) & 1ull)); ++rep_) {
    gemm_phase(L + 0, 384, W + W_W2F, 64, NTOK, 512, 64, EpiE{(u16*)(p.ws + O_SEF), p.in[I_W0F]}, HSMEM);
    }
    for (int rep_ = 0; rep_ < (int)(((PHMASK >> 5) & 1ull) + ((PHREP >> 5) & 1ull)); ++rep_) {
    gemm_phase(L + 64, 384, W + W_W2B, 64, NTOK, 512, 64, EpiE{(u16*)(p.ws + O_SEB), p.in[I_W0B]}, HSMEM);
    }
    for (int rep_ = 0; rep_ < (int)(((PHMASK >> 6) & 1ull) + ((PHREP >> 6) & 1ull)); ++rep_) {
    gemm_phase(L + 128, 384, W + W_A2F, 64, NTOK, 512, 64, EpiI{(u16*)(p.ws + O_SIF), p.in[I_A0F]}, HSMEM);
    }
    for (int rep_ = 0; rep_ < (int)(((PHMASK >> 7) & 1ull) + ((PHREP >> 7) & 1ull)); ++rep_) {
    gemm_phase(L + 192, 384, W + W_A2B, 64, NTOK, 512, 64, EpiI{(u16*)(p.ws + O_SIB), p.in[I_A0B]}, HSMEM);
    }
    for (int rep_ = 0; rep_ < (int)(((PHMASK >> 8) & 1ull) + ((PHREP >> 8) & 1ull)); ++rep_) {
    gemm_phase(L + 256, 384, W + W_G2, 128, NTOK, 512, 128, EpiStore{(u16*)((char*)p.out + DO_G), 512}, HSMEM);
    }
    for (int rep_ = 0; rep_ < (int)(((PHMASK >> 9) & 1ull) + ((PHREP >> 9) & 1ull)); ++rep_) {
    phase_ssd_prep(p);
    }
  }
  xcd_barrier(xb);
  for (int rep_ = 0; rep_ < (int)(((PHMASK >> 10) & 1ull) + ((PHREP >> 10) & 1ull)); ++rep_) {
  phase_rwkv(p, smem0);
  }
  xcd_barrier(xb);
  for (int rep_ = 0; rep_ < (int)(((PHMASK >> 11) & 1ull) + ((PHREP >> 11) & 1ull)); ++rep_) {
  phase_ssd_states(p, HSMEM);
  }
  xcd_barrier(xb);
  for (int rep_ = 0; rep_ < (int)(((PHMASK >> 12) & 1ull) + ((PHREP >> 12) & 1ull)); ++rep_) {
  phase_ssd_scan(p);
  }
  xcd_barrier(xb);
  for (int rep_ = 0; rep_ < (int)(((PHMASK >> 13) & 1ull) + ((PHREP >> 13) & 1ull)); ++rep_) {
  phase_ssd_out(p, HSMEM);
  }
  xcd_barrier(xb);
  for (int rep_ = 0; rep_ < (int)(((PHMASK >> 14) & 1ull) + ((PHREP >> 14) & 1ull)); ++rep_) {
  phase_finish(p);
  }
  xcd_barrier(xb);
  for (int rep_ = 0; rep_ < (int)(((PHMASK >> 15) & 1ull) + ((PHREP >> 15) & 1ull)); ++rep_) {
  big_gemm((const u16*)(p.ws + O_MIXED), 1024, W + W_EVOUT, NTOK, 1024, 1024,
             EpiRes{p.in[I_CTX], p.in[I_X], ctxr, p.out, modv, 2, 0}, smem0);
  }
  xcd_barrier(xb);
  for (int rep_ = 0; rep_ < (int)(((PHMASK >> 16) & 1ull) + ((PHREP >> 16) & 1ull)); ++rep_) {
  phase_norm(ctxr, p.out, p.in[I_N2G], modv, 3, 4, hx, 0, NTOK);
  }
  xcd_barrier(xb);
  for (int rep_ = 0; rep_ < (int)(((PHMASK >> 17) & 1ull) + ((PHREP >> 17) & 1ull)); ++rep_) {
  big_gemm(hx, 1024, W + W_UP0, NTOK, 5632, 1024, EpiStore{(u16*)(p.ws + O_GV), 5632}, smem0);
  }
  xcd_barrier(xb);
  for (int rep_ = 0; rep_ < (int)(((PHMASK >> 18) & 1ull) + ((PHREP >> 18) & 1ull)); ++rep_) {
  phase_ffnconv(p, 0, 0);
  }
  xcd_barrier(xb);
  for (int rep_ = 0; rep_ < (int)(((PHMASK >> 19) & 1ull) + ((PHREP >> 19) & 1ull)); ++rep_) {
  big_gemm((const u16*)(p.ws + O_GV) + 2816, 5632, W + W_DN0, NTOK, 1024, 2816,
             EpiRes{ctxr, p.out, ctxr, p.out, modv, 5, 0}, smem0);
  }
  xcd_barrier(xb);
  const float* modv1 = modv + 9 * 6144;
  for (int rep_ = 0; rep_ < (int)(((PHMASK >> 20) & 1ull) + ((PHREP >> 20) & 1ull)); ++rep_) {
  phase_norm(ctxr, p.out, p.in[I_N1G] + 1024, modv1, 0, 1, hx, 0, NTOK);
  }
  xcd_barrier(xb);
  for (int rep_ = 0; rep_ < (int)(((PHMASK >> 21) & 1ull) + ((PHREP >> 21) & 1ull)); ++rep_) {
  big_gemm(hx, 1024, W + W_RIN, NTOK, 4096, 1024, EpiQKV{(u16*)(p.ws + O_QKV)}, smem0);
  }
  xcd_barrier(xb);
  for (int rep_ = 0; rep_ < (int)(((PHMASK >> 22) & 1ull) + ((PHREP >> 22) & 1ull)); ++rep_) {
  phase_rope(p);
  }
  xcd_barrier(xb);
  for (int rep_ = 0; rep_ < (int)(((PHMASK >> 23) & 1ull) + ((PHREP >> 23) & 1ull)); ++rep_) {
  phase_retention(p, smem0);
  }
  xcd_barrier(xb);
  for (int rep_ = 0; rep_ < (int)(((PHMASK >> 24) & 1ull) + ((PHREP >> 24) & 1ull)); ++rep_) {
  phase_ynorm(p);
  }
  xcd_barrier(xb);
  for (int rep_ = 0; rep_ < (int)(((PHMASK >> 25) & 1ull) + ((PHREP >> 25) & 1ull)); ++rep_) {
  big_gemm(hx + (size_t)NCTX * 1024, 1024, W + W_RIN + 4096ull * 1024, NLAT, 2048, 1024,
             EpiGate{(u16*)(p.ws + O_Y), (const float*)(p.ws + O_RSTD)}, smem0);
  }
  xcd_barrier(xb);
  for (int rep_ = 0; rep_ < (int)(((PHMASK >> 26) & 1ull) + ((PHREP >> 26) & 1ull)); ++rep_) {
  big_gemm((const u16*)(p.ws + O_Y), 2048, W + W_ROUT, NLAT, 1024, 2048,
             EpiRes{ctxr, p.out, ctxr, p.out, modv1, 2, NCTX}, smem0);
  }
  xcd_barrier(xb);
  for (int rep_ = 0; rep_ < (int)(((PHMASK >> 27) & 1ull) + ((PHREP >> 27) & 1ull)); ++rep_) {
  phase_norm(ctxr, p.out, p.in[I_N2G] + 1024, modv1, 3, 4, hx, NCTX, NTOK);
  }
  xcd_barrier(xb);
  for (int rep_ = 0; rep_ < (int)(((PHMASK >> 28) & 1ull) + ((PHREP >> 28) & 1ull)); ++rep_) {
  big_gemm(hx + (size_t)NCTX * 1024, 1024, W + W_UP1, NLAT, 5632, 1024,
             EpiStore{(u16*)(p.ws + O_GV) + (size_t)NCTX * 5632, 5632}, smem0);
  }
  xcd_barrier(xb);
  for (int rep_ = 0; rep_ < (int)(((PHMASK >> 29) & 1ull) + ((PHREP >> 29) & 1ull)); ++rep_) {
  phase_ffnconv(p, 1, NCTX);
  }
  xcd_barrier(xb);
  for (int rep_ = 0; rep_ < (int)(((PHMASK >> 30) & 1ull) + ((PHREP >> 30) & 1ull)); ++rep_) {
  big_gemm((const u16*)(p.ws + O_GV) + (size_t)NCTX * 5632 + 2816, 5632, W + W_DN1, NLAT, 1024, 2816,
             EpiRes{ctxr, p.out, ctxr, p.out, modv1, 5, NCTX}, smem0);
  }
  xcd_barrier(xb);
  for (int rep_ = 0; rep_ < (int)(((PHMASK >> 31) & 1ull) + ((PHREP >> 31) & 1ull)); ++rep_) {
  phase_final(p);
  }
}

extern "C" void kernel_launch(void* const* d_in, const int* in_sizes, int n_in, void* d_out, int out_size, void* d_ws,
                              size_t ws_size, hipStream_t stream) {
  static int grid_blocks = 0;
  if (!grid_blocks) {
    int dev = 0, cus = 0, per_cu = 0;
    hipGetDevice(&dev);
    hipDeviceGetAttribute(&cus, hipDeviceAttributeMultiprocessorCount, dev);
    hipFuncSetAttribute((const void*)mega, hipFuncAttributeMaxDynamicSharedMemorySize, LDS_BYTES + 16);
    hipOccupancyMaxActiveBlocksPerMultiprocessor(&per_cu, (const void*)mega, 512, LDS_BYTES + 16);
    if (per_cu < 1) per_cu = 1;
    if (per_cu > 1) per_cu = 1;
    grid_blocks = cus * per_cu;
    fprintf(stderr, "mega: cus=%d per_cu=%d grid=%d ws=%zu\n", cus, per_cu, grid_blocks, ws_size);
  }
  Params p{};
  for (int i = 0; i < N_IN; ++i) p.in[i] = (const float*)d_in[i];
  p.out = (float*)d_out;
  p.ws = (char*)d_ws;
  hipMemsetAsync((char*)d_ws + O_BAR, 0, XCD_BAR_WORDS * 4, stream);
  void* args[] = {&p};
  hipError_t e = hipLaunchCooperativeKernel((const void*)mega, dim3(grid_blocks), dim3(512), args, LDS_BYTES + 16, stream);
  if (e != hipSuccess) fprintf(stderr, "cooperative launch failed: %s (grid %d)\n", hipGetErrorString(e), grid_blocks);
}
```

```cpp
#include <hip/hip_runtime.h>
#include <hip/hip_cooperative_groups.h>
#include <cstdio>
namespace cg = cooperative_groups;

typedef unsigned short u16;
using bf16x8 = __attribute__((ext_vector_type(8))) short;
using f32x4 = __attribute__((ext_vector_type(4))) float;
using u32x4 = __attribute__((ext_vector_type(4))) unsigned int;

#define NTOK 67584
#define NCTX 2048
#define NLAT 65536
#define PW 3472
#define LDS_BYTES 147456
#define HALF_LDS 73728
#define LTID ((int)(TT & 255))
#define VBID ((int)(blockIdx.x * 2 + (TT >> 8)))
__device__ __forceinline__ int opaque_tid() { int t = threadIdx.x; asm volatile("" : "+v"(t)); return t; }
#define VGRID ((int)(gridDim.x * 2))

enum { I_X = 0, I_C, I_CTX, I_CCTX, I_MODW, I_MODB, I_N1G, I_N2G, I_FUP, I_FCW, I_FCB, I_FDN,
       I_EVIN, I_MUP, I_MUN, I_W0F, I_W0B, I_W2F, I_W2B, I_A0F, I_A0B, I_A2F, I_A2B, I_G2, I_KK, I_KA, I_RK,
       I_LNW, I_LNB, I_SCW, I_SCB, I_DTBF, I_DTBB, I_ALF, I_ALB, I_SD, I_SNW, I_EVOUT, I_RIN, I_L2F, I_L2B, I_ROUT, I_FNG, N_IN };

struct Params { const float* in[N_IN]; float* out; char* ws; };

#define MiB (1024ull * 1024ull)
#define W_EVIN   0ull
#define W_EVOUT  (W_EVIN + 3472ull * 1024)
#define W_UP0    (W_EVOUT + 1024ull * 1024)
#define W_UP1    (W_UP0 + 5632ull * 1024)
#define W_DN0    (W_UP1 + 5632ull * 1024)
#define W_DN1    (W_DN0 + 1024ull * 2816)
#define W_RIN    (W_DN1 + 1024ull * 2816)
#define W_ROUT   (W_RIN + 6144ull * 1024)
#define W_W2F    (W_ROUT + 1024ull * 2048)
#define W_W2B    (W_W2F + 512ull * 64)
#define W_A2F    (W_W2B + 512ull * 64)
#define W_A2B    (W_A2F + 512ull * 64)
#define W_G2     (W_A2B + 512ull * 64)
#define O_SMALL  (64 * MiB)
#define O_MODV   (O_SMALL)
#define O_ROPE   (O_MODV + 2ull * 9 * 6144 * 4)
#define O_CTXR   (O_SMALL + 1 * MiB)
#define O_RN     (O_CTXR + 8 * MiB)
#define O_BONUS  (O_RN + 2162688ull)
#define O_DT     (O_BONUS + 2162688ull)
#define O_CS     (O_DT + 2 * 2162688ull)
#define O_RSTD   (O_CS + 2 * 2162688ull)
#define O_BAR    (O_RSTD + 2097152ull)
#define O_BIG    (96 * MiB)
#define SZ_TOK512 (69206016ull)
#define O_P      (O_BIG)
#define O_S      (544 * MiB)
#define O_SR     (O_S)
#define O_SK     (O_S + SZ_TOK512)
#define O_SV     (O_S + 2 * SZ_TOK512)
#define O_SEF    (O_S + 3 * SZ_TOK512)
#define O_SEB    (O_S + 4 * SZ_TOK512)
#define O_SIF    (O_S + 5 * SZ_TOK512)
#define O_SIB    (O_S + 6 * SZ_TOK512)
#define O_STATES (O_SEF)
#define O_MIXED  (O_SR)
#define O_HX     (O_BIG)
#define O_GV     (228 * MiB)
#define O_QKV    (228 * MiB)
#define O_Y      (756 * MiB)
#define DO_HX    0ull
#define DO_L     (138412032ull)
#define DO_G     (DO_L + 51904512ull)

__device__ __forceinline__ unsigned pack2(float a, float b) {
  unsigned r;
  asm("v_cvt_pk_bf16_f32 %0, %1, %2" : "=v"(r) : "v"(a), "v"(b));
  return r;
}
__device__ __forceinline__ u16 f2bf(float f) { return (u16)(pack2(f, f) & 0xffffu); }
__device__ __forceinline__ float bf2f(u16 h) { return __uint_as_float(((unsigned)h) << 16); }
__device__ __forceinline__ uint2 pack4(float a, float b, float c, float d) { return make_uint2(pack2(a, b), pack2(c, d)); }
__device__ __forceinline__ float sigmoidf_(float x) { return __builtin_amdgcn_rcpf(1.f + __expf(-x)); }
__device__ __forceinline__ float siluf_(float x) { return x * __builtin_amdgcn_rcpf(1.f + __expf(-x)); }
__device__ __forceinline__ float tanhf_(float x) { return 1.f - 2.f * __builtin_amdgcn_rcpf(__expf(2.f * x) + 1.f); }
__device__ __forceinline__ float softplusf_(float x) { return x > 20.f ? x : log1pf(__expf(x)); }
__device__ __forceinline__ float geluf_(float x) { return 0.5f * x * (1.f + tanhf_(0.7978845608028654f * (x + 0.044715f * x * x * x))); }
__device__ __forceinline__ float wave_sum(float v) {
#pragma unroll
  for (int o = 32; o; o >>= 1) v += __shfl_xor(v, o);
  return v;
}
template <int C> __device__ __forceinline__ float dppf(float v) {
  return __int_as_float(__builtin_amdgcn_update_dpp(0, __float_as_int(v), C, 0xF, 0xF, true));
}
__device__ __forceinline__ float red16(float v) {
  v += dppf<0xB1>(v);
  v += dppf<0x4E>(v);
  v += dppf<0x141>(v);
  v += dppf<0x140>(v);
  return v;
}
__device__ __forceinline__ bool has_prev(int m) { return m < NCTX ? (m & 255) != 0 : ((m - NCTX) & 8191) != 0; }
__device__ __forceinline__ bool has_next(int m) { return m < NCTX ? (m & 255) != 255 : ((m - NCTX) & 8191) != 8191; }
__device__ __forceinline__ int mod_row(int m) { return m < NCTX ? 8 : ((m - NCTX) >> 13); }
__device__ __forceinline__ int scan_tok(int dir, int b, int s) {
  if (s < 256) return b * 256 + (dir ? 255 - s : s);
  int t = s - 256;
  return NCTX + b * 8192 + (dir ? 8191 - t : t);
}
__device__ __forceinline__ bf16x8 ldfrag(const u16* base, int stride, int row0, int k0, int lane) {
  return *(const bf16x8*)(base + (row0 + (lane & 15)) * stride + k0 + (lane >> 4) * 8);
}
__device__ __forceinline__ f32x4 mma(bf16x8 afrag, bf16x8 bfrag, f32x4 acc) {
  return __builtin_amdgcn_mfma_f32_16x16x32_bf16(bfrag, afrag, acc, 0, 0, 0);
}

template <class Epi> __forceinline__
__device__ __forceinline__ void gemm_phase(const u16* __restrict__ A, int lda, const u16* __restrict__ Bt, int ldb, int M, int N, int K,
                           Epi epi, char* smem_) {
  const int TT = opaque_tid();
  u16* As = (u16*)smem_;
  u16* Bs = As + 128 * 72;
  const int tid = LTID, lane = tid & 63, wave = tid >> 6;
  const int wm = (wave >> 1) * 64, wn = (wave & 1) * 64;
  const int tiles_n = (N + 127) >> 7, tiles_m = (M + 127) >> 7;
  const int ntiles = tiles_m * tiles_n;
  const int lrow = tid >> 3, lkc = (tid & 7) * 8;
  for (int vb = VBID; vb < ntiles; vb += VGRID) {
    const int tm = vb / tiles_n, tn = vb - tm * tiles_n;
    const int m0 = tm * 128, n0 = tn * 128;
    f32x4 acc[4][4];
#pragma unroll
    for (int i = 0; i < 4; ++i)
#pragma unroll
      for (int j = 0; j < 4; ++j) acc[i][j] = (f32x4){0.f, 0.f, 0.f, 0.f};
    u32x4 ra[4], rb[4];
    const u16* ap[4];
    const u16* bp[4];
#pragma unroll
    for (int i = 0; i < 4; ++i) {
      int row = lrow + i * 32;
      int am = min(m0 + row, M - 1), bn = min(n0 + row, N - 1);
      ap[i] = A + (size_t)am * lda + lkc;
      bp[i] = Bt + (size_t)bn * ldb + lkc;
    }
#pragma unroll
    for (int i = 0; i < 4; ++i) { ra[i] = *(const u32x4*)(ap[i]); rb[i] = *(const u32x4*)(bp[i]); }
    for (int k0 = 0; k0 < K; k0 += 64) {
      __syncthreads();
#pragma unroll
      for (int i = 0; i < 4; ++i) {
        *(u32x4*)(As + (lrow + i * 32) * 72 + lkc) = ra[i];
        *(u32x4*)(Bs + (lrow + i * 32) * 72 + lkc) = rb[i];
      }
      __syncthreads();
      if (k0 + 64 < K) {
#pragma unroll
        for (int i = 0; i < 4; ++i) { ra[i] = *(const u32x4*)(ap[i] + k0 + 64); rb[i] = *(const u32x4*)(bp[i] + k0 + 64); }
      }
#pragma unroll
      for (int kk = 0; kk < 64; kk += 32) {
        bf16x8 af[4], bfr[4];
#pragma unroll
        for (int i = 0; i < 4; ++i) af[i] = ldfrag(As, 72, wm + i * 16, kk, lane);
#pragma unroll
        for (int j = 0; j < 4; ++j) bfr[j] = ldfrag(Bs, 72, wn + j * 16, kk, lane);
#pragma unroll
        for (int i = 0; i < 4; ++i)
#pragma unroll
          for (int j = 0; j < 4; ++j) acc[i][j] = mma(af[i], bfr[j], acc[i][j]);
      }
    }
#pragma unroll
    for (int i = 0; i < 4; ++i)
#pragma unroll
      for (int j = 0; j < 4; ++j) {
        int m = m0 + wm + i * 16 + (lane & 15);
        int n = n0 + wn + j * 16 + (lane >> 4) * 4;
        if (m < M && n < N) epi(m, n, acc[i][j]);
      }
  }
}

struct EpiStore { static constexpr bool PERM = true; u16* C; int ldc;
  __device__ void store8(int m, int n, f32x4 a, f32x4 b) const { u32x4 o = {pack2(a[0], a[1]), pack2(a[2], a[3]), pack2(b[0], b[1]), pack2(b[2], b[3])}; *(u32x4*)(C + (size_t)m * ldc + n) = o; }
  __device__ void operator()(int m, int n, f32x4 v) const { *(uint2*)(C + (size_t)m * ldc + n) = pack4(v[0], v[1], v[2], v[3]); } };
struct EpiE { static constexpr bool PERM = false; u16* C; const float* w0;
  __device__ void operator()(int m, int n, f32x4 v) const {
    float4 w = *(const float4*)(w0 + n);
    *(uint2*)(C + (size_t)m * 512 + n) = pack4(sigmoidf_(w.x + v[0]) * 0.6065306597126334f, sigmoidf_(w.y + v[1]) * 0.6065306597126334f,
                                              sigmoidf_(w.z + v[2]) * 0.6065306597126334f, sigmoidf_(w.w + v[3]) * 0.6065306597126334f); } };
struct EpiI { static constexpr bool PERM = false; u16* C; const float* a0;
  __device__ void operator()(int m, int n, f32x4 v) const {
    float4 w = *(const float4*)(a0 + n);
    *(uint2*)(C + (size_t)m * 512 + n) = pack4(sigmoidf_(w.x + v[0]), sigmoidf_(w.y + v[1]), sigmoidf_(w.z + v[2]), sigmoidf_(w.w + v[3])); } };
struct EpiRes { static constexpr bool PERM = false; const float* src_c; const float* src_l; float* dst_c; float* dst_l; const float* modv_l; int gi; int moff;
  __device__ void operator()(int m_, int n, f32x4 v) const {
    int m = m_ + moff;
    const float* g = modv_l + (mod_row(m) * 6 + gi) * 1024 + n;
    float4 gg = *(const float4*)g;
    const float* s; float* d;
    if (m < NCTX) { s = src_c + (size_t)m * 1024 + n; d = dst_c + (size_t)m * 1024 + n; }
    else { s = src_l + (size_t)(m - NCTX) * 1024 + n; d = dst_l + (size_t)(m - NCTX) * 1024 + n; }
    float4 x = *(const float4*)s;
    x.x += gg.x * v[0]; x.y += gg.y * v[1]; x.z += gg.z * v[2]; x.w += gg.w * v[3];
    *(float4*)d = x; } };
struct EpiQKV { static constexpr bool PERM = true; u16* C;
  __device__ void store8(int m, int n, f32x4 a, f32x4 b) const {
    float sc_ = (n >= 1024 && n < 2048) ? 0.08838834764831845f : 1.f;
    u32x4 o = {pack2(a[0] * sc_, a[1] * sc_), pack2(a[2] * sc_, a[3] * sc_), pack2(b[0] * sc_, b[1] * sc_), pack2(b[2] * sc_, b[3] * sc_)};
    *(u32x4*)(C + (size_t)m * 4096 + n) = o; }
  __device__ void operator()(int m, int n, f32x4 v) const {
    float s = (n >= 1024 && n < 2048) ? 0.08838834764831845f : 1.f;
    *(uint2*)(C + (size_t)m * 4096 + n) = pack4(v[0] * s, v[1] * s, v[2] * s, v[3] * s); } };
struct EpiGate { static constexpr bool PERM = true; u16* Y; const float* rstd;
  __device__ void store8(int m, int n, f32x4 a, f32x4 b) const {
    u16* yp = Y + (size_t)m * 2048 + n;
    u32x4 yy = *(const u32x4*)yp;
    float r = rstd[m * 8 + (n >> 8)];
    float g[8] = {a[0], a[1], a[2], a[3], b[0], b[1], b[2], b[3]};
    float o[8];
#pragma unroll
    for (int i = 0; i < 4; ++i) {
      o[2 * i] = siluf_(g[2 * i]) * bf2f((u16)(yy[i] & 0xffff)) * r;
      o[2 * i + 1] = siluf_(g[2 * i + 1]) * bf2f((u16)(yy[i] >> 16)) * r;
    }
    u32x4 ov = {pack2(o[0], o[1]), pack2(o[2], o[3]), pack2(o[4], o[5]), pack2(o[6], o[7])};
    *(u32x4*)yp = ov; }
  __device__ void operator()(int m, int n, f32x4 v) const {
    u16* yp = Y + (size_t)m * 2048 + n;
    uint2 yy = *(const uint2*)yp;
    float r = rstd[m * 8 + (n >> 8)];
    float y0 = bf2f((u16)(yy.x & 0xffff)), y1 = bf2f((u16)(yy.x >> 16)), y2 = bf2f((u16)(yy.y & 0xffff)), y3 = bf2f((u16)(yy.y >> 16));
    *(uint2*)yp = pack4(siluf_(v[0]) * y0 * r, siluf_(v[1]) * y1 * r, siluf_(v[2]) * y2 * r, siluf_(v[3]) * y3 * r); } };

__device__ __forceinline__ void transpose_job(const float* __restrict__ src, u16* __restrict__ dst, int K, int N, char* smem) {
  const int TT = opaque_tid();
  float* tile = (float*)smem;
  const int tid = LTID;
  const int tk = K >> 6, tn = (N + 63) >> 6;
  const int ntiles = tk * tn;
  for (int vb = VBID; vb < ntiles; vb += VGRID) {
    const int k0 = (vb / tn) * 64, n0 = (vb % tn) * 64;
    __syncthreads();
#pragma unroll
    for (int i = 0; i < 4; ++i) {
      int r = (tid >> 4) + i * 16, c4 = (tid & 15) * 4;
      float4 v = make_float4(0.f, 0.f, 0.f, 0.f);
      if (n0 + c4 < N) v = *(const float4*)(src + (size_t)(k0 + r) * N + n0 + c4);
      tile[r * 65 + c4] = v.x; tile[r * 65 + c4 + 1] = v.y; tile[r * 65 + c4 + 2] = v.z; tile[r * 65 + c4 + 3] = v.w;
    }
    __syncthreads();
#pragma unroll
    for (int i = 0; i < 2; ++i) {
      int item = tid + i * 256; int kc = item & 7, n = item >> 3;
      if (n0 + n < N) {
        float v[8];
#pragma unroll
        for (int j = 0; j < 8; ++j) v[j] = tile[(kc * 8 + j) * 65 + n];
        u32x4 o = {pack2(v[0], v[1]), pack2(v[2], v[3]), pack2(v[4], v[5]), pack2(v[6], v[7])};
        *(u32x4*)(dst + (size_t)(n0 + n) * K + k0 + kc * 8) = o;
      }
    }
  }
}

__device__ __forceinline__ void phase_prep(const Params& p, char* smem) {
  const int TT = opaque_tid();
  u16* W = (u16*)p.ws;
  transpose_job(p.in[I_EVIN], W + W_EVIN, 1024, 3472, smem);
  transpose_job(p.in[I_W2F], W + W_W2F, 64, 512, smem);
  transpose_job(p.in[I_W2B], W + W_W2B, 64, 512, smem);
  transpose_job(p.in[I_A2F], W + W_A2F, 64, 512, smem);
  transpose_job(p.in[I_A2B], W + W_A2B, 64, 512, smem);
  transpose_job(p.in[I_G2], W + W_G2, 128, 512, smem);
  {
    float* rope = (float*)(p.ws + O_ROPE);
    for (int idx = VBID * 256 + LTID; idx < (128 + 64) * 32; idx += VGRID * 256) {
      int j = idx & 31, pos = idx >> 5;
      bool isrow = pos < 128;
      int pp = isrow ? pos : pos - 128;
      float inv = powf(10000.f, -(float)j / 32.f);
      float ang = (float)pp * inv;
      double a = (double)ang;
      double kq = rint(a * 0.15915494309189535);
      double r = a - kq * 6.283185307179586476925;
      double r2 = r * r;
      double sn = r, cs = 1.0, ts = r, tc = 1.0;
#pragma unroll 1
      for (int it = 1; it <= 14; ++it) {
        tc = -tc * r2 / (double)((2 * it - 1) * (2 * it));
        ts = -ts * r2 / (double)((2 * it) * (2 * it + 1));
        cs += tc; sn += ts;
      }
      if (isrow) { rope[pp * 32 + j] = (float)cs; rope[4096 + pp * 32 + j] = (float)sn; }
      else { rope[8192 + pp * 32 + j] = (float)cs; rope[8192 + 2048 + pp * 32 + j] = (float)sn; }
    }
  }
  {
    float* sc = (float*)smem;
    float* red = sc + 9 * 1024;
    float* modv = (float*)(p.ws + O_MODV);
    bool loaded = false;
    __syncthreads();
    for (int vb = VBID; vb < 384; vb += VGRID) {
      if (!loaded) {
        for (int i = LTID; i < 9 * 1024; i += 256) {
          int r = i >> 10, k = i & 1023;
          float cv = r < 8 ? p.in[I_C][r * 1024 + k] : p.in[I_CCTX][k];
          sc[i] = cv / (1.f + expf(-cv));
        }
        loaded = true;
        __syncthreads();
      }
      int l = vb / 192, jb = vb % 192;
      int jj = LTID & 31, kc = LTID >> 5;
      int j = jb * 32 + jj;
      const float* w = p.in[I_MODW] + ((size_t)l * 1024 + kc * 128) * 6144 + j;
      float acc[9];
#pragma unroll
      for (int r = 0; r < 9; ++r) acc[r] = 0.f;
#pragma unroll 16
      for (int k = 0; k < 128; ++k) {
        float wv = w[(size_t)k * 6144];
#pragma unroll
        for (int r = 0; r < 9; ++r) acc[r] += sc[r * 1024 + kc * 128 + k] * wv;
      }
      __syncthreads();
#pragma unroll
      for (int r = 0; r < 9; ++r) red[(kc * 9 + r) * 32 + jj] = acc[r];
      __syncthreads();
      if (kc == 0) {
        float mb = p.in[I_MODB][l * 6144 + j];
#pragma unroll
        for (int r = 0; r < 9; ++r) {
          float sum = 0.f;
#pragma unroll
          for (int q = 0; q < 8; ++q) sum += red[(q * 9 + r) * 32 + jj];
          modv[((size_t)l * 9 + r) * 6144 + j] = sum + mb;
        }
      }
    }
    __syncthreads();
  }
}

__device__ __forceinline__ void phase_norm(const float* src_c, const float* src_l, const float* g, const float* modv_l, int si, int sci,
                           u16* hx, int r0, int r1) {
  const int TT = opaque_tid();
  const int lane = LTID & 63, wv = LTID >> 6;
  for (int m = r0 + (VBID * 4 + wv) * 2; m < r1; m += VGRID * 8) {
    float4 v[2][4];
    float ss[2] = {0.f, 0.f};
#pragma unroll
    for (int q = 0; q < 2; ++q) {
      const int mm = m + q;
      const float* src = mm < NCTX ? src_c + (size_t)mm * 1024 : src_l + (size_t)(mm - NCTX) * 1024;
#pragma unroll
      for (int i = 0; i < 4; ++i) v[q][i] = *(const float4*)(src + i * 256 + lane * 4);
    }
#pragma unroll
    for (int q = 0; q < 2; ++q) {
#pragma unroll
      for (int i = 0; i < 4; ++i) ss[q] += v[q][i].x * v[q][i].x + v[q][i].y * v[q][i].y + v[q][i].z * v[q][i].z + v[q][i].w * v[q][i].w;
      ss[q] = wave_sum(ss[q]);
    }
#pragma unroll
    for (int q = 0; q < 2; ++q) {
      const int mm = m + q;
      const int r = mod_row(mm);
      const float* sh = modv_l + (r * 6 + si) * 1024;
      const float* scl = modv_l + (r * 6 + sci) * 1024;
      const float rstd = rsqrtf(ss[q] * (1.f / 1024.f) + 1e-6f);
#pragma unroll
      for (int i = 0; i < 4; ++i) {
        int c = i * 256 + lane * 4;
        float4 gg = *(const float4*)(g + c), s1 = *(const float4*)(scl + c), s0 = *(const float4*)(sh + c);
        float y0 = v[q][i].x * rstd * gg.x * (1.f + s1.x) + s0.x;
        float y1 = v[q][i].y * rstd * gg.y * (1.f + s1.y) + s0.y;
        float y2 = v[q][i].z * rstd * gg.z * (1.f + s1.z) + s0.z;
        float y3 = v[q][i].w * rstd * gg.w * (1.f + s1.w) + s0.w;
        *(uint2*)(hx + (size_t)mm * 1024 + c) = pack4(y0, y1, y2, y3);
      }
    }
  }
}

__device__ __forceinline__ float red8(float v) {
  v += dppf<0xB1>(v);
  v += dppf<0x4E>(v);
  v += dppf<0x141>(v);
  return v;
}
__device__ __forceinline__ void unpack8(u32x4 q, float* o) {
#pragma unroll
  for (int e = 0; e < 4; ++e) { o[2 * e] = bf2f((u16)(q[e] & 0xffff)); o[2 * e + 1] = bf2f((u16)(q[e] >> 16)); }
}
__device__ __forceinline__ u32x4 pack8(const float* o) {
  u32x4 r = {pack2(o[0], o[1]), pack2(o[2], o[3]), pack2(o[4], o[5]), pack2(o[6], o[7])};
  return r;
}
__device__ __forceinline__ void load8f(const float* p, float* o) {
  float4 a = *(const float4*)p, b = *(const float4*)(p + 4);
  o[0] = a.x; o[1] = a.y; o[2] = a.z; o[3] = a.w; o[4] = b.x; o[5] = b.y; o[6] = b.z; o[7] = b.w;
}
__device__ __forceinline__ void shifted8(const u16* row, int col, bool hp, bool hn, const float* mup, const float* mun, float* o) {
  const u32x4 z4 = {0u, 0u, 0u, 0u};
  u32x4 cur = *(const u32x4*)(row + col);
  u32x4 prv = *(const u32x4*)(row + col - (hp ? PW : 0));
  u32x4 nxt = *(const u32x4*)(row + col + (hn ? PW : 0));
  prv = hp ? prv : z4; nxt = hn ? nxt : z4;
  float u[8], pv[8], nx[8], mp[8], mn[8];
  unpack8(cur, u); unpack8(prv, pv); unpack8(nxt, nx);
  load8f(mup + col, mp); load8f(mun + col, mn);
#pragma unroll
  for (int i = 0; i < 8; ++i) o[i] = u[i] + mp[i] * (pv[i] - u[i]) + mn[i] * (nx[i] - u[i]);
}
__device__ __forceinline__ void phase_feat(const Params& p) {
  const int TT = opaque_tid();
  const u16* __restrict__ P = (const u16*)(p.ws + O_P);
  u16* __restrict__ Sr = (u16*)(p.ws + O_SR); u16* __restrict__ Sk = (u16*)(p.ws + O_SK); u16* __restrict__ Sv = (u16*)(p.ws + O_SV);
  float* __restrict__ rn = (float*)(p.ws + O_RN); float* __restrict__ bonus = (float*)(p.ws + O_BONUS);
  u16* __restrict__ L = (u16*)((char*)p.out + DO_L);
  const float* __restrict__ mup = p.in[I_MUP]; const float* __restrict__ mun = p.in[I_MUN];
  const int lane = LTID & 63, wv = LTID >> 6;
  const int h = lane >> 3, c = h * 64 + (lane & 7) * 8;
  float kkw[8], rkw[8];
  load8f(p.in[I_KK] + c, kkw); load8f(p.in[I_RK] + c, rkw);
#pragma unroll 2
  for (int m = VBID * 4 + wv; m < NTOK; m += VGRID * 4) {
    const bool hp = has_prev(m), hn = has_next(m);
    const u16* row = P + (size_t)m * PW;
    float r[8], k[8], v[8];
    shifted8(row, c, hp, hn, mup, mun, r);
    shifted8(row, 512 + c, hp, hn, mup, mun, k);
    shifted8(row, 1024 + c, hp, hn, mup, mun, v);
    *(u32x4*)(Sr + (size_t)m * 512 + c) = pack8(r);
    *(u32x4*)(Sk + (size_t)m * 512 + c) = pack8(k);
    *(u32x4*)(Sv + (size_t)m * 512 + c) = pack8(v);
    float s1 = 0.f, s2 = 0.f;
#pragma unroll
    for (int i = 0; i < 8; ++i) { float kk = k[i] * kkw[i]; s1 += kk * kk; s2 += r[i] * k[i] * rkw[i]; }
    s1 = red8(s1); s2 = red8(s2);
    if ((lane & 7) == 0) {
      rn[m * 8 + h] = 1.f / fmaxf(sqrtf(s1), 1e-12f);
      bonus[m * 8 + h] = s2;
    }
    if (lane < 48) {
      float o[8];
      shifted8(row, 1536 + lane * 8, hp, hn, mup, mun, o);
      const int g = lane >> 3;
#pragma unroll
      for (int i = 0; i < 8; ++i) o[i] = g < 2 ? tanhf_(o[i]) : (g < 4 ? o[i] : sigmoidf_(o[i]));
      *(u32x4*)(L + (size_t)m * 384 + lane * 8) = pack8(o);
    }
  }
}

__device__ __forceinline__ void transpose_item(const float* __restrict__ src, u16* __restrict__ dst, int K, int N, int idx) {
  const int n = idx % N, kb = idx / N;
  const float* sp = src + (size_t)kb * 8 * N + n;
  float v[8];
#pragma unroll
  for (int i = 0; i < 8; ++i) v[i] = sp[(size_t)i * N];
  u32x4 o = {pack2(v[0], v[1]), pack2(v[2], v[3]), pack2(v[4], v[5]), pack2(v[6], v[7])};
  *(u32x4*)(dst + (size_t)n * K + kb * 8) = o;
}
#define LATE_ITEMS 3342336
__device__ __forceinline__ void late_weight_item(const Params& p, int idx) {
  u16* W = (u16*)p.ws;
  if (idx < 131072) { transpose_item(p.in[I_EVOUT], W + W_EVOUT, 1024, 1024, idx); return; }
  idx -= 131072;
  if (idx < 720896) { transpose_item(p.in[I_FUP], W + W_UP0, 1024, 5632, idx); return; }
  idx -= 720896;
  if (idx < 720896) { transpose_item(p.in[I_FUP] + 1024ull * 5632, W + W_UP1, 1024, 5632, idx); return; }
  idx -= 720896;
  if (idx < 360448) { transpose_item(p.in[I_FDN], W + W_DN0, 2816, 1024, idx); return; }
  idx -= 360448;
  if (idx < 360448) { transpose_item(p.in[I_FDN] + 2816ull * 1024, W + W_DN1, 2816, 1024, idx); return; }
  idx -= 360448;
  if (idx < 786432) { transpose_item(p.in[I_RIN], W + W_RIN, 1024, 6144, idx); return; }
  idx -= 786432;
  if (idx < 262144) { transpose_item(p.in[I_ROUT], W + W_ROUT, 2048, 1024, idx); return; }
}

using f32x2 = __attribute__((ext_vector_type(2))) float;
__device__ __forceinline__ void phase_rwkv(const Params& p, char* smem) {
  const u16* Sr = (const u16*)(p.ws + O_SR); const u16* Sk = (const u16*)(p.ws + O_SK); const u16* Sv = (const u16*)(p.ws + O_SV);
  const float* rn = (const float*)(p.ws + O_RN);
  u16* P = (u16*)(p.ws + O_P);
  constexpr int CH = 32;
  constexpr int NCH = 8448 / CH;
  float* buf = (float*)smem;
  float* vbuf = buf + 2 * 5 * CH * 64;
  const int tid = opaque_tid(), lane = tid & 63, wave = tid >> 6;
  const bool producer = tid >= 256;
  const int pt = tid & 255;
  const int ch = pt & 63, st0 = pt >> 6;
  const int rg = lane >> 4, ls = lane & 15;
  const int r0 = (wave & 3) * 8 + rg * 2;
  for (int vb = blockIdx.x; vb < 256; vb += gridDim.x) {
    const int seq = (vb & 7) * 16 + (vb >> 4), hh = (vb >> 3) & 1;
    const int dir = seq >> 6, b = (seq >> 3) & 7, h = seq & 7;
    const u16* Se = (const u16*)(p.ws + (dir ? O_SEB : O_SEF));
    const u16* Si = (const u16*)(p.ws + (dir ? O_SIB : O_SIF));
    const float kkc = p.in[I_KK][h * 64 + ch], kac = p.in[I_KA][h * 64 + ch];
    f32x2 s00 = {0.f, 0.f}, s01 = {0.f, 0.f}, s10 = {0.f, 0.f}, s11 = {0.f, 0.f};
    u16 gr[CH / 4], gk[CH / 4], ge[CH / 4], gi[CH / 4]; float grn[CH / 4]; u16 gv[CH / 8];
    auto gload = [&](int c) {
#pragma unroll
      for (int i = 0; i < CH / 4; ++i) {
        int m = scan_tok(dir, b, c * CH + st0 + i * 4);
        size_t o = (size_t)m * 512 + h * 64 + ch;
        gr[i] = Sr[o]; gk[i] = Sk[o]; ge[i] = Se[o]; gi[i] = Si[o]; grn[i] = rn[m * 8 + h];
      }
#pragma unroll
      for (int i = 0; i < CH / 8; ++i) {
        int item = pt + i * 256;
        int mv = scan_tok(dir, b, c * CH + (item >> 5));
        gv[i] = Sv[(size_t)mv * 512 + h * 64 + hh * 32 + (item & 31)];
      }
    };
    auto sstore = [&](int bi) {
      float* B = buf + bi * (5 * CH * 64);
#pragma unroll
      for (int i = 0; i < CH / 4; ++i) {
        int st = st0 + i * 4;
        float r = bf2f(gr[i]), k = bf2f(gk[i]), e = bf2f(ge[i]), ic = bf2f(gi[i]);
        float kk = k * kkc * grn[i];
        B[(0 * CH + st) * 64 + ch] = -kk;
        B[(1 * CH + st) * 64 + ch] = kk * ic;
        B[(2 * CH + st) * 64 + ch] = k * (1.f + (ic - 1.f) * kac);
        B[(3 * CH + st) * 64 + ch] = __expf(-e);
        B[(4 * CH + st) * 64 + ch] = r;
      }
#pragma unroll
      for (int i = 0; i < CH / 8; ++i) vbuf[bi * (CH * 32) + pt + i * 256] = bf2f(gv[i]);
    };
    __syncthreads();
    if (producer) { gload(0); sstore(0); gload(1); }
    __syncthreads();
    for (int c = 0; c < NCH; ++c) {
      if (producer) {
        if (c + 1 < NCH) { sstore((c + 1) & 1); if (c + 2 < NCH) gload(c + 2); }
        {
          const int li = c * ((int)gridDim.x * 256) + blockIdx.x * 256 + pt;
          if (li < LATE_ITEMS && vb == (int)blockIdx.x) late_weight_item(p, li);
        }
      } else {
        const float* B = buf + (c & 1) * (5 * CH * 64);
        const float* VB = vbuf + (c & 1) * (CH * 32);
        f32x2 ykeep = {0.f, 0.f}, ykeep2 = {0.f, 0.f};
#pragma unroll
        for (int st = 0; st < CH; ++st) {
          f32x4 a = *(const f32x4*)(B + (0 * CH + st) * 64 + ls * 4);
          f32x4 bb = *(const f32x4*)(B + (1 * CH + st) * 64 + ls * 4);
          f32x4 kd = *(const f32x4*)(B + (2 * CH + st) * 64 + ls * 4);
          f32x4 w = *(const f32x4*)(B + (3 * CH + st) * 64 + ls * 4);
          f32x4 r = *(const f32x4*)(B + (4 * CH + st) * 64 + ls * 4);
          f32x2 vv = *(const f32x2*)(VB + st * 32 + r0);
          f32x2 alo = {a[0], a[1]}, ahi = {a[2], a[3]}, blo = {bb[0], bb[1]}, bhi = {bb[2], bb[3]};
          f32x2 klo = {kd[0], kd[1]}, khi = {kd[2], kd[3]}, wlo = {w[0], w[1]}, whi = {w[2], w[3]};
          f32x2 rlo = {r[0], r[1]}, rhi = {r[2], r[3]};
          f32x2 t0 = s00 * alo + s01 * ahi;
          f32x2 t1 = s10 * alo + s11 * ahi;
          float sa0 = red16(t0[0] + t0[1]);
          float sa1 = red16(t1[0] + t1[1]);
          f32x2 sa0v = {sa0, sa0}, sa1v = {sa1, sa1}, v0v = {vv[0], vv[0]}, v1v = {vv[1], vv[1]};
          s00 = s00 * wlo + sa0v * blo + v0v * klo;
          s01 = s01 * whi + sa0v * bhi + v0v * khi;
          s10 = s10 * wlo + sa1v * blo + v1v * klo;
          s11 = s11 * whi + sa1v * bhi + v1v * khi;
          f32x2 u0 = s00 * rlo + s01 * rhi;
          f32x2 u1 = s10 * rlo + s11 * rhi;
          float y0 = red16(u0[0] + u0[1]);
          float y1 = red16(u1[0] + u1[1]);
          if (st < 16) { ykeep[0] = (ls == st) ? y0 : ykeep[0]; ykeep[1] = (ls == st) ? y1 : ykeep[1]; }
          else { ykeep2[0] = (ls == st - 16) ? y0 : ykeep2[0]; ykeep2[1] = (ls == st - 16) ? y1 : ykeep2[1]; }
        }
#pragma unroll
        for (int half_ = 0; half_ < 2; ++half_) {
          const int sidx = c * CH + half_ * 16 + ls;
          const int tt = sidx - 256;
          const int mctx = b * 256 + (dir ? 255 - sidx : sidx);
          const int mlat = NCTX + b * 8192 + (dir ? 8191 - tt : tt);
          const int m = sidx < 256 ? mctx : mlat;
          const f32x2 yk = half_ ? ykeep2 : ykeep;
          *(unsigned*)(P + (size_t)m * PW + dir * 512 + h * 64 + hh * 32 + r0) = pack2(yk[0], yk[1]);
        }
      }
      __syncthreads();
    }
  }
}

__device__ __forceinline__ float xbc_conv(const u16* P, int m, int cx, const float* cw, const float* cb, bool hp, bool hn) {
  const u16* q = P + (size_t)m * PW + 2432 + cx;
  float v = cb[cx] + cw[1024 + cx] * bf2f(q[0]);
  if (hp) v += cw[cx] * bf2f(q[-PW]);
  if (hn) v += cw[2048 + cx] * bf2f(q[PW]);
  return siluf_(v);
}

#define XLO(w) bf2f((u16)((w) & 0xffff))
#define XHI(w) bf2f((u16)((w) >> 16))
__device__ __forceinline__ void phase_xbc(const Params& p) {
  const int TT = opaque_tid();
  const u16* __restrict__ P = (const u16*)(p.ws + O_P);
  u16* __restrict__ X = (u16*)((char*)p.out + DO_HX);
  const float* __restrict__ cw = p.in[I_SCW]; const float* __restrict__ cb = p.in[I_SCB];
  const int total = NTOK * 128;
#pragma unroll 2
  for (int idx = VBID * 256 + LTID; idx < total; idx += VGRID * 256) {
    const int m = idx >> 7, c = (idx & 127) * 8;
    const u16* q = P + (size_t)m * PW + 2432 + c;
    const u32x4 z4 = {0u, 0u, 0u, 0u};
    const bool hp = has_prev(m), hn = has_next(m);
    u32x4 cur = *(const u32x4*)q;
    u32x4 prv = *(const u32x4*)(q - (hp ? PW : 0));
    u32x4 nxt = *(const u32x4*)(q + (hn ? PW : 0));
    prv = hp ? prv : z4; nxt = hn ? nxt : z4;
    float o[8];
#pragma unroll
    for (int e = 0; e < 4; ++e) {
      int c0 = c + 2 * e, c1 = c0 + 1;
      float v0 = cb[c0] + cw[c0] * XLO(prv[e]) + cw[1024 + c0] * XLO(cur[e]) + cw[2048 + c0] * XLO(nxt[e]);
      float v1 = cb[c1] + cw[c1] * XHI(prv[e]) + cw[1024 + c1] * XHI(cur[e]) + cw[2048 + c1] * XHI(nxt[e]);
      o[2 * e] = siluf_(v0); o[2 * e + 1] = siluf_(v1);
    }
    u32x4 ov = {pack2(o[0], o[1]), pack2(o[2], o[3]), pack2(o[4], o[5]), pack2(o[6], o[7])};
    *(u32x4*)(X + (size_t)m * 1024 + c) = ov;
  }
}

__device__ __forceinline__ void phase_ssd_prep(const Params& p) {
  const int TT = opaque_tid();
  const u16* __restrict__ P = (const u16*)(p.ws + O_P);
  float* __restrict__ dtb = (float*)(p.ws + O_DT); float* __restrict__ csb = (float*)(p.ws + O_CS);
  for (int idx = VBID * 256 + LTID; idx < 528 * 16; idx += VGRID * 256) {
    int cidx = idx >> 4, dir = (idx >> 3) & 1, h = idx & 7;
    float bias = dir ? p.in[I_DTBB][h] : p.in[I_DTBF][h];
    float A = -expf(dir ? p.in[I_ALB][h] : p.in[I_ALF][h]);
    float cs = 0.f;
#pragma unroll 16
    for (int i = 0; i < 128; ++i) {
      int l = dir ? 127 - i : i;
      int m = cidx * 128 + l;
      float dtr = bf2f(P[(size_t)m * PW + 3456 + dir * 8 + h]);
      float dt = softplusf_(dtr + bias);
      cs += dt * A;
      dtb[((size_t)dir * NTOK + m) * 8 + h] = dt;
      csb[((size_t)dir * NTOK + m) * 8 + h] = cs;
    }
  }
}

__device__ __forceinline__ void phase_ssd_states(const Params& p, char* smem) {
  const int TT = opaque_tid();
  const u16* P = (const u16*)(p.ws + O_P);
  const float* dtb = (const float*)(p.ws + O_DT); const float* csb = (const float*)(p.ws + O_CS);
  float* states = (float*)(p.ws + O_STATES);
  const float* cw = p.in[I_SCW]; const float* cb = p.in[I_SCB];
  const u16* X = (const u16*)((const char*)p.out + DO_HX);
  u16* XTf = (u16*)smem; u16* XTb = XTf + 64 * 136; u16* BT = XTb + 64 * 136;
  float* wf = (float*)(BT + 128 * 136);
  const int tid = LTID, lane = tid & 63, wave = tid >> 6;
  for (int vb = VBID; vb < 528 * 8; vb += VGRID) {
    const int cidx = vb >> 3, h = vb & 7, g = h >> 2;
    const int mb = cidx * 128;
    __syncthreads();
    {
      int d = tid >> 7, l = tid & 127;
      float tot = csb[((size_t)d * NTOK + mb + (d ? 0 : 127)) * 8 + h];
      size_t o = ((size_t)d * NTOK + mb + l) * 8 + h;
      wf[d * 128 + l] = dtb[o] * __expf(tot - csb[o]);
    }
    __syncthreads();
#pragma unroll
    for (int i = 0; i < 2; ++i) {
      int item = tid + i * 256; int lp = item & 63, cg = item >> 6;
      int l0 = 2 * lp;
      const u16* xp = X + (size_t)(mb + l0) * 1024 + h * 64 + cg * 8;
      u32x4 x0 = *(const u32x4*)xp, x1 = *(const u32x4*)(xp + 1024);
      float f0 = wf[l0], f1 = wf[l0 + 1], b0 = wf[128 + l0], b1 = wf[128 + l0 + 1];
#pragma unroll
      for (int e = 0; e < 4; ++e) {
        float a0 = XLO(x0[e]), a1 = XLO(x1[e]), c0 = XHI(x0[e]), c1 = XHI(x1[e]);
        *(unsigned*)(XTf + (cg * 8 + 2 * e) * 136 + l0) = pack2(a0 * f0, a1 * f1);
        *(unsigned*)(XTf + (cg * 8 + 2 * e + 1) * 136 + l0) = pack2(c0 * f0, c1 * f1);
        *(unsigned*)(XTb + (cg * 8 + 2 * e) * 136 + l0) = pack2(a0 * b0, a1 * b1);
        *(unsigned*)(XTb + (cg * 8 + 2 * e + 1) * 136 + l0) = pack2(c0 * b0, c1 * b1);
      }
    }
#pragma unroll
    for (int i = 0; i < 4; ++i) {
      int item = tid + i * 256; int lp = item & 63, cg = item >> 6;
      int l0 = 2 * lp;
      const u16* xp = X + (size_t)(mb + l0) * 1024 + 512 + g * 128 + cg * 8;
      u32x4 x0 = *(const u32x4*)xp, x1 = *(const u32x4*)(xp + 1024);
#pragma unroll
      for (int e = 0; e < 4; ++e) {
        *(unsigned*)(BT + (cg * 8 + 2 * e) * 136 + l0) = (x0[e] & 0xffffu) | (x1[e] << 16);
        *(unsigned*)(BT + (cg * 8 + 2 * e + 1) * 136 + l0) = (x0[e] >> 16) | (x1[e] & 0xffff0000u);
      }
    }
    __syncthreads();
#pragma unroll
    for (int d = 0; d < 2; ++d) {
      const u16* XT = d ? XTb : XTf;
      f32x4 acc[4][2];
#pragma unroll
      for (int i = 0; i < 4; ++i) { acc[i][0] = (f32x4){0, 0, 0, 0}; acc[i][1] = (f32x4){0, 0, 0, 0}; }
#pragma unroll
      for (int kk = 0; kk < 128; kk += 32) {
        bf16x8 af[4], bfr[2];
#pragma unroll
        for (int i = 0; i < 4; ++i) af[i] = ldfrag(XT, 136, i * 16, kk, lane);
#pragma unroll
        for (int j = 0; j < 2; ++j) bfr[j] = ldfrag(BT, 136, wave * 32 + j * 16, kk, lane);
#pragma unroll
        for (int i = 0; i < 4; ++i)
#pragma unroll
          for (int j = 0; j < 2; ++j) acc[i][j] = mma(af[i], bfr[j], acc[i][j]);
      }
      float* so = states + (((size_t)d * 528 + cidx) * 8 + h) * 8192;
#pragma unroll
      for (int i = 0; i < 4; ++i)
#pragma unroll
        for (int j = 0; j < 2; ++j) {
          int pp = i * 16 + (lane & 15), n = wave * 32 + j * 16 + (lane >> 4) * 4;
          *(float4*)(so + pp * 128 + n) = make_float4(acc[i][j][0], acc[i][j][1], acc[i][j][2], acc[i][j][3]);
        }
    }
  }
}

__device__ __forceinline__ int ssd_chunk_seq(int d, int b, int j) {
  if (j < 2) return 2 * b + (d ? 1 - j : j);
  int t = j - 2;
  return 16 + b * 64 + (d ? 63 - t : t);
}

__device__ __forceinline__ void phase_ssd_scan(const Params& p) {
  const int TT = opaque_tid();
  float* states = (float*)(p.ws + O_STATES);
  const float* csb = (const float*)(p.ws + O_CS);
  for (int idx = VBID * 256 + LTID; idx < 2 * 8 * 8 * 2048; idx += VGRID * 256) {
    const int q = idx & 2047, h = (idx >> 11) & 7, b = (idx >> 14) & 7, d = idx >> 17;
    auto sptr = [&](int j) -> f32x4* {
      int cidx = ssd_chunk_seq(d, b, j);
      return (f32x4*)(states + (((size_t)d * 528 + cidx) * 8 + h) * 8192) + q;
    };
    auto totof = [&](int j) -> float {
      int cidx = ssd_chunk_seq(d, b, j);
      return csb[((size_t)d * NTOK + cidx * 128 + (d ? 0 : 127)) * 8 + h];
    };
    f32x4 hh = {0.f, 0.f, 0.f, 0.f};
    f32x4 sv[4]; float tv[4];
#pragma unroll
    for (int u = 0; u < 4; ++u) { sv[u] = *sptr(u); tv[u] = totof(u); }
#pragma unroll 1
    for (int j0 = 0; j0 < 64; j0 += 4) {
      f32x4 sn[4]; float tn[4];
#pragma unroll
      for (int u = 0; u < 4; ++u) {
        const int jn = j0 + 4 + u;
        const int jc = jn < 66 ? jn : 65;
        sn[u] = *sptr(jc); tn[u] = totof(jc);
      }
#pragma unroll
      for (int u = 0; u < 4; ++u) {
        *sptr(j0 + u) = hh;
        hh = hh * __expf(tv[u]) + sv[u];
      }
#pragma unroll
      for (int u = 0; u < 4; ++u) { sv[u] = sn[u]; tv[u] = tn[u]; }
    }
#pragma unroll
    for (int u = 0; u < 2; ++u) {
      *sptr(64 + u) = hh;
      hh = hh * __expf(tv[u]) + sv[u];
    }
  }
}

__device__ __forceinline__ void phase_ssd_out(const Params& p, char* smem) {
  const int TT = opaque_tid();
  u16* P = (u16*)(p.ws + O_P);
  const float* dtb = (const float*)(p.ws + O_DT); const float* csb = (const float*)(p.ws + O_CS);
  const float* states = (const float*)(p.ws + O_STATES);
  const float* cw = p.in[I_SCW]; const float* cb = p.in[I_SCB];
  const u16* X = (const u16*)((const char*)p.out + DO_HX);
  u16* Cs = (u16*)smem;
  u16* Bs = Cs + 64 * 136;
  u16* Gs = Bs; u16* Hs = Bs + 64 * 136;
  u16* XT = Bs + 128 * 136;
  float* csf = (float*)(XT + 64 * 136);
  float* csbk = csf + 128; float* dtf = csbk + 128; float* dtbk = dtf + 128;
  const int tid = LTID, lane = tid & 63, wave = tid >> 6;
  for (int vb = VBID; vb < 528 * 16; vb += VGRID) {
    const int lh = vb & 1, h = (vb >> 1) & 7, cidx = vb >> 4, g = h >> 2;
    const int mb = cidx * 128;
    f32x4 hv[2][8];
#pragma unroll
    for (int d = 0; d < 2; ++d) {
      const float* hp = states + (((size_t)d * 528 + cidx) * 8 + h) * 8192;
#pragma unroll
      for (int i = 0; i < 8; ++i) { int item = tid + i * 256; hv[d][i] = *(const f32x4*)(hp + (item >> 5) * 128 + (item & 31) * 4); }
    }
    __syncthreads();
    if (tid < 128) {
      size_t o0 = ((size_t)0 * NTOK + mb + tid) * 8 + h, o1 = ((size_t)1 * NTOK + mb + tid) * 8 + h;
      csf[tid] = csb[o0]; csbk[tid] = csb[o1]; dtf[tid] = dtb[o0]; dtbk[tid] = dtb[o1];
    }
#pragma unroll
    for (int i = 0; i < 4; ++i) {
      int item = tid + i * 256; int cg = item & 15, l = item >> 4;
      *(u32x4*)(Cs + l * 136 + cg * 8) = *(const u32x4*)(X + (size_t)(mb + lh * 64 + l) * 1024 + 768 + g * 128 + cg * 8);
    }
#pragma unroll
    for (int i = 0; i < 8; ++i) {
      int item = tid + i * 256; int cg = item & 15, sidx = item >> 4;
      *(u32x4*)(Bs + sidx * 136 + cg * 8) = *(const u32x4*)(X + (size_t)(mb + sidx) * 1024 + 512 + g * 128 + cg * 8);
    }
#pragma unroll
    for (int i = 0; i < 2; ++i) {
      int item = tid + i * 256; int lp = item & 63, cg = item >> 6;
      int l0 = 2 * lp;
      const u16* xp = X + (size_t)(mb + l0) * 1024 + h * 64 + cg * 8;
      u32x4 x0 = *(const u32x4*)xp, x1 = *(const u32x4*)(xp + 1024);
#pragma unroll
      for (int e = 0; e < 4; ++e) {
        *(unsigned*)(XT + (cg * 8 + 2 * e) * 136 + l0) = (x0[e] & 0xffffu) | (x1[e] << 16);
        *(unsigned*)(XT + (cg * 8 + 2 * e + 1) * 136 + l0) = (x0[e] >> 16) | (x1[e] & 0xffff0000u);
      }
    }
    __syncthreads();
    f32x4 cbacc[8];
#pragma unroll
    for (int t = 0; t < 8; ++t) cbacc[t] = (f32x4){0, 0, 0, 0};
#pragma unroll 1
    for (int kk = 0; kk < 128; kk += 32) {
      bf16x8 af = ldfrag(Cs, 136, wave * 16, kk, lane);
#pragma unroll
      for (int t = 0; t < 8; ++t) cbacc[t] = mma(af, ldfrag(Bs, 136, t * 16, kk, lane), cbacc[t]);
    }
    __syncthreads();
    const int lloc = wave * 16 + (lane & 15);
    const int l = lh * 64 + lloc;
    const float cfl = csf[l], cbl = csbk[l];
#pragma unroll 2
    for (int t = 0; t < 8; ++t) {
      float gv[4];
#pragma unroll
      for (int j = 0; j < 4; ++j) {
        int s = t * 16 + (lane >> 4) * 4 + j;
        float f = 0.f;
        if (s <= l) f += __expf(cfl - csf[s]) * dtf[s];
        if (s >= l) f += __expf(cbl - csbk[s]) * dtbk[s];
        gv[j] = cbacc[t][j] * f;
      }
      *(uint2*)(Gs + lloc * 136 + t * 16 + (lane >> 4) * 4) = pack4(gv[0], gv[1], gv[2], gv[3]);
    }
    __syncthreads();
    f32x4 yacc[4];
#pragma unroll
    for (int t = 0; t < 4; ++t) yacc[t] = (f32x4){0, 0, 0, 0};
#pragma unroll 1
    for (int kk = 0; kk < 128; kk += 32) {
      bf16x8 af = ldfrag(Gs, 136, wave * 16, kk, lane);
#pragma unroll
      for (int t = 0; t < 4; ++t) yacc[t] = mma(af, ldfrag(XT, 136, t * 16, kk, lane), yacc[t]);
    }
#pragma unroll
    for (int d = 0; d < 2; ++d) {
      __syncthreads();
#pragma unroll
      for (int i = 0; i < 8; ++i) {
        int item = tid + i * 256;
        int pp = item >> 5, n4 = (item & 31) * 4;
        *(uint2*)(Hs + pp * 136 + n4) = pack4(hv[d][i][0], hv[d][i][1], hv[d][i][2], hv[d][i][3]);
      }
      __syncthreads();
      f32x4 ia[4];
#pragma unroll
      for (int t = 0; t < 4; ++t) ia[t] = (f32x4){0, 0, 0, 0};
#pragma unroll 1
      for (int kk = 0; kk < 128; kk += 32) {
        bf16x8 af = ldfrag(Cs, 136, wave * 16, kk, lane);
#pragma unroll
        for (int t = 0; t < 4; ++t) ia[t] = mma(af, ldfrag(Hs, 136, t * 16, kk, lane), ia[t]);
      }
      float sc = __expf(d ? cbl : cfl);
#pragma unroll
      for (int t = 0; t < 4; ++t)
#pragma unroll
        for (int j = 0; j < 4; ++j) yacc[t][j] += sc * ia[t][j];
    }
    const float Dh = p.in[I_SD][h];
    const int m = mb + l;
#pragma unroll
    for (int t = 0; t < 4; ++t) {
      int p0 = t * 16 + (lane >> 4) * 4;
      float o[4];
#pragma unroll
      for (int j = 0; j < 4; ++j) o[j] = yacc[t][j] + Dh * bf2f(XT[(p0 + j) * 136 + l]);
      *(uint2*)(P + (size_t)m * PW + 1024 + h * 64 + p0) = pack4(o[0], o[1], o[2], o[3]);
    }
  }
}

__device__ __forceinline__ void phase_finish(const Params& p) {
  const int TT = opaque_tid();
  const u16* __restrict__ P = (const u16*)(p.ws + O_P);
  const u16* __restrict__ Sv = (const u16*)(p.ws + O_SV);
  const u16* __restrict__ G = (const u16*)((const char*)p.out + DO_G);
  const float* __restrict__ bonus = (const float*)(p.ws + O_BONUS);
  u16* __restrict__ mixed = (u16*)(p.ws + O_MIXED);
  const int lane = LTID & 63, wv = LTID >> 6;
  const int h = lane >> 3, c = h * 64 + (lane & 7) * 8;
  float lnw[8], lnb[8], nw[8];
  load8f(p.in[I_LNW] + c, lnw); load8f(p.in[I_LNB] + c, lnb); load8f(p.in[I_SNW] + c, nw);
#pragma unroll 2
  for (int m = VBID * 4 + wv; m < NTOK; m += VGRID * 4) {
    const u16* row = P + (size_t)m * PW;
    float yf[8], yb[8], sv[8], gg[8], ys[8], z[8];
    unpack8(*(const u32x4*)(row + c), yf);
    unpack8(*(const u32x4*)(row + 512 + c), yb);
    unpack8(*(const u32x4*)(Sv + (size_t)m * 512 + c), sv);
    unpack8(*(const u32x4*)(G + (size_t)m * 512 + c), gg);
    unpack8(*(const u32x4*)(row + 1024 + c), ys);
    unpack8(*(const u32x4*)(row + 1920 + c), z);
    const float bn = bonus[m * 8 + h];
    float sum = 0.f;
#pragma unroll
    for (int i = 0; i < 8; ++i) { yf[i] += yb[i]; sum += yf[i]; }
    const float mean = red8(sum) * (1.f / 64.f);
    float vs = 0.f;
#pragma unroll
    for (int i = 0; i < 8; ++i) { yf[i] -= mean; vs += yf[i] * yf[i]; }
    const float rs = rsqrtf(red8(vs) * (1.f / 64.f) + 64e-5f);
    float o1[8], t[8]; float ss = 0.f;
#pragma unroll
    for (int i = 0; i < 8; ++i) {
      o1[i] = (yf[i] * rs * lnw[i] + lnb[i] + bn * sv[i]) * gg[i];
      t[i] = ys[i] * siluf_(z[i]);
      ss += t[i] * t[i];
    }
    ss = wave_sum(ss);
    const float rstd = rsqrtf(ss * (1.f / 512.f) + 1e-6f);
#pragma unroll
    for (int i = 0; i < 8; ++i) t[i] = t[i] * rstd * nw[i];
    *(u32x4*)(mixed + (size_t)m * 1024 + c) = pack8(o1);
    *(u32x4*)(mixed + (size_t)m * 1024 + 512 + c) = pack8(t);
  }
}

__device__ __forceinline__ void phase_ffnconv(const Params& p, int layer, int r0) {
  const int TT = opaque_tid();
  u16* GV = (u16*)(p.ws + O_GV);
  const float* cw = p.in[I_FCW] + (size_t)layer * 9 * 2816;
  const float* cb = p.in[I_FCB] + (size_t)layer * 2816;
  const int gt = VBID * 256 + LTID;
  const int ngrp = (VGRID * 256) / 352;
  if (gt >= ngrp * 352) return;
  const int j = (gt % 352) * 8, tl = gt / 352;
  float w[9][8], bias[8];
#pragma unroll
  for (int k = 0; k < 9; ++k) load8f(cw + k * 2816 + j, w[k]);
  load8f(cb + j, bias);
  const u32x4 z4 = {0u, 0u, 0u, 0u};
#pragma unroll 1
  for (int m0 = r0 + tl; m0 < NTOK; m0 += 2 * ngrp) {
    u32x4 g[2][9]; u32x4 vq[2];
#pragma unroll
    for (int q = 0; q < 2; ++q) {
      const int m = (m0 + q * ngrp < NTOK) ? m0 + q * ngrp : m0;
      const bool isctx = m < NCTX;
      const int t = isctx ? (m & 255) : ((m - NCTX) & 8191);
      const int rr = t >> 6, cc = t & 63;
#pragma unroll
      for (int dy = -1; dy <= 1; ++dy)
#pragma unroll
        for (int dx = -1; dx <= 1; ++dx) {
          const int k = (dy + 1) * 3 + dx + 1;
          const bool valid = isctx ? (dy == 0 && t + dx >= 0 && t + dx < 256)
                                   : (rr + dy >= 0 && rr + dy < 128 && cc + dx >= 0 && cc + dx < 64);
          const int mm = valid ? m + dy * 64 + dx : m;
          u32x4 qv = *(const u32x4*)(GV + (size_t)mm * 5632 + j);
          g[q][k] = valid ? qv : z4;
        }
      vq[q] = *(const u32x4*)(GV + (size_t)m * 5632 + 2816 + j);
    }
    asm volatile("" ::: "memory");
#pragma unroll
    for (int q = 0; q < 2; ++q) {
      const int m = m0 + q * ngrp;
      if (m < NTOK) {
        float acc[8];
#pragma unroll
        for (int i = 0; i < 8; ++i) acc[i] = bias[i];
#pragma unroll
        for (int k = 0; k < 9; ++k)
#pragma unroll
          for (int e = 0; e < 4; ++e) {
            acc[2 * e] += w[k][2 * e] * XLO(g[q][k][e]);
            acc[2 * e + 1] += w[k][2 * e + 1] * XHI(g[q][k][e]);
          }
        float o[8];
#pragma unroll
        for (int e = 0; e < 4; ++e) {
          o[2 * e] = geluf_(acc[2 * e]) * XLO(vq[q][e]);
          o[2 * e + 1] = geluf_(acc[2 * e + 1]) * XHI(vq[q][e]);
        }
        *(u32x4*)(GV + (size_t)m * 5632 + 2816 + j) = pack8(o);
      }
    }
  }
}

__device__ __forceinline__ void phase_rope(const Params& p) {
  const int TT = opaque_tid();
  u16* QKV = (u16*)(p.ws + O_QKV);
  const float* rope = (const float*)(p.ws + O_ROPE);
  const int total = NLAT * 128;
  const int nthr = VGRID * 256;
  for (int idx0 = VBID * 256 + LTID; idx0 < total; idx0 += nthr * 4) {
    u32x4 a[4], bq[4];
#pragma unroll
    for (int u = 0; u < 4; ++u) {
      const int idx = idx0 + u * nthr;
      if (idx >= total) continue;
      const int t = idx >> 7, r = idx & 127;
      const int jg = r & 7, hh = (r >> 3) & 7, qk = r >> 6;
      const u16* base = QKV + (size_t)(NCTX + t) * 4096 + qk * 1024 + hh * 128 + jg * 8;
      a[u] = *(const u32x4*)base; bq[u] = *(const u32x4*)(base + 64);
    }
    asm volatile("" ::: "memory");
#pragma unroll
    for (int u = 0; u < 4; ++u) {
      const int idx = idx0 + u * nthr;
      if (idx >= total) continue;
      const int t = idx >> 7, r = idx & 127;
      const int jg = r & 7, hh = (r >> 3) & 7, qk = r >> 6;
      const int pos = t & 8191, prow = pos >> 6, pcol = pos & 63;
      const int j = jg * 8;
      u16* base = QKV + (size_t)(NCTX + t) * 4096 + qk * 1024 + hh * 128 + j;
      float x1[8], x2[8], o1[8], o2[8];
      unpack8(a[u], x1); unpack8(bq[u], x2);
      const float* ct = j < 32 ? rope + prow * 32 + j : rope + 8192 + pcol * 32 + j - 32;
      const float* stb = j < 32 ? rope + 4096 + prow * 32 + j : rope + 8192 + 2048 + pcol * 32 + j - 32;
      float cs[8], sn[8];
      load8f(ct, cs); load8f(stb, sn);
#pragma unroll
      for (int i = 0; i < 8; ++i) { o1[i] = x1[i] * cs[i] - x2[i] * sn[i]; o2[i] = x2[i] * cs[i] + x1[i] * sn[i]; }
      *(u32x4*)base = pack8(o1);
      *(u32x4*)(base + 64) = pack8(o2);
    }
  }
}

__device__ __forceinline__ void phase_retention(const Params& p, char* smem) {
  const u16* QKV = (const u16*)(p.ws + O_QKV);
  u16* Y = (u16*)(p.ws + O_Y);
  u16* Qs = (u16*)smem;
  u16* Ks = Qs + 64 * 136;
  u16* KT = Ks + 64 * 136;
  u16* VT = KT + 128 * 72;
  u16* Sb = VT + 64 * 72;
  u16* Pm = Sb + 64 * 136;
  const int tid = opaque_tid(), lane = tid & 63, wave = tid >> 6;
  const int quad = lane >> 4, l16 = lane & 15;
  const int rt = wave & 3, chf = wave >> 2;
  for (int vb = blockIdx.x; vb < 256; vb += gridDim.x) {
    const int xq_ = vb >> 3, bh_ = (vb & 7) * 8 + (xq_ >> 2);
    const int b = bh_ >> 3, h = bh_ & 7, sl = xq_ & 3;
#pragma unroll 1
    for (int d = 0; d < 2; ++d) {
      const float l2 = d ? p.in[I_L2B][h] : p.in[I_L2F][h];
      const float lg = log1pf(-exp2f(-l2));
      const float gC = __expf(lg * 64.f);
      f32x4 st[4];
#pragma unroll
      for (int t = 0; t < 4; ++t) st[t] = (f32x4){0, 0, 0, 0};
      u32x4 rq[2], rk[2], rv;
      auto chunk_m0 = [&](int cs_) { return d ? scan_tok(1, b, cs_ * 64 + 63) : scan_tok(0, b, cs_ * 64); };
      auto gload = [&](int cs_) {
        int m0 = chunk_m0(cs_);
#pragma unroll
        for (int i = 0; i < 2; ++i) {
          int item = tid + i * 512; int row = item & 63, c8 = (item >> 6) * 8;
          const u16* bp = QKV + (size_t)(m0 + row) * 4096 + h * 128 + c8;
          rq[i] = *(const u32x4*)bp;
          rk[i] = *(const u32x4*)(bp + 1024);
        }
        {
          int row = tid & 63, c8 = (tid >> 6) * 8;
          rv = *(const u32x4*)(QKV + (size_t)(m0 + row) * 4096 + 2048 + h * 256 + sl * 64 + c8);
        }
      };
      auto sstore = [&]() {
#pragma unroll
        for (int i = 0; i < 2; ++i) {
          int item = tid + i * 512; int row = item & 63, c8 = (item >> 6) * 8;
          *(u32x4*)(Qs + row * 136 + c8) = rq[i];
          *(u32x4*)(Ks + row * 136 + c8) = rk[i];
          float ke = __expf(lg * (float)(d ? row : 63 - row));
#pragma unroll
          for (int e = 0; e < 4; ++e) {
            KT[(c8 + 2 * e) * 72 + row] = f2bf(bf2f((u16)(rk[i][e] & 0xffff)) * ke);
            KT[(c8 + 2 * e + 1) * 72 + row] = f2bf(bf2f((u16)(rk[i][e] >> 16)) * ke);
          }
        }
        {
          int row = tid & 63, c8 = (tid >> 6) * 8;
#pragma unroll
          for (int e = 0; e < 4; ++e) {
            VT[(c8 + 2 * e) * 72 + row] = (u16)(rv[e] & 0xffff);
            VT[(c8 + 2 * e + 1) * 72 + row] = (u16)(rv[e] >> 16);
          }
        }
#pragma unroll
        for (int t = 0; t < 4; ++t)
          *(uint2*)(Sb + (rt * 16 + l16) * 136 + (4 * chf + t) * 16 + quad * 4) = pack4(st[t][0], st[t][1], st[t][2], st[t][3]);
      };
      gload(0);
#pragma unroll 1
      for (int cs_ = 0; cs_ < 132; ++cs_) {
        const int m0 = chunk_m0(cs_);
        __syncthreads();
        sstore();
        __syncthreads();
        if (cs_ + 1 < 132) gload(cs_ + 1);
        u16* const ypb = Y + (size_t)(m0 + rt * 16 + l16 - NCTX) * 2048 + h * 256 + sl * 64 + quad * 4;
        uint2 yprev[2] = {make_uint2(0u, 0u), make_uint2(0u, 0u)};
        if (d && m0 >= NCTX) {
#pragma unroll
          for (int t = 0; t < 2; ++t) yprev[t] = *(const uint2*)(ypb + (2 * chf + t) * 16);
        }
        f32x4 sc[2];
#pragma unroll
        for (int t = 0; t < 2; ++t) sc[t] = (f32x4){0, 0, 0, 0};
#pragma unroll
        for (int kk = 0; kk < 128; kk += 32) {
          bf16x8 af = ldfrag(Qs, 136, rt * 16, kk, lane);
#pragma unroll
          for (int t = 0; t < 2; ++t) sc[t] = mma(af, ldfrag(Ks, 136, (2 * chf + t) * 16, kk, lane), sc[t]);
        }
        const int l = rt * 16 + l16;
#pragma unroll
        for (int t = 0; t < 2; ++t) {
          float pv[4];
#pragma unroll
          for (int j = 0; j < 4; ++j) {
            int s = (2 * chf + t) * 16 + quad * 4 + j;
            int dist = d ? s - l : l - s;
            pv[j] = dist >= 0 ? sc[t][j] * __expf(lg * (float)dist) : 0.f;
          }
          *(uint2*)(Pm + l * 72 + (2 * chf + t) * 16 + quad * 4) = pack4(pv[0], pv[1], pv[2], pv[3]);
        }
        __syncthreads();
        f32x4 ya[2], yi[2];
#pragma unroll
        for (int t = 0; t < 2; ++t) { ya[t] = (f32x4){0, 0, 0, 0}; yi[t] = (f32x4){0, 0, 0, 0}; }
#pragma unroll
        for (int kk = 0; kk < 64; kk += 32) {
          bf16x8 af = ldfrag(Pm, 72, rt * 16, kk, lane);
#pragma unroll
          for (int t = 0; t < 2; ++t) ya[t] = mma(af, ldfrag(VT, 72, (2 * chf + t) * 16, kk, lane), ya[t]);
        }
#pragma unroll
        for (int kk = 0; kk < 128; kk += 32) {
          bf16x8 af = ldfrag(Qs, 136, rt * 16, kk, lane);
#pragma unroll
          for (int t = 0; t < 2; ++t) yi[t] = mma(af, ldfrag(Sb, 136, (2 * chf + t) * 16, kk, lane), yi[t]);
        }
#pragma unroll
        for (int t = 0; t < 4; ++t) { st[t][0] *= gC; st[t][1] *= gC; st[t][2] *= gC; st[t][3] *= gC; }
#pragma unroll
        for (int kk = 0; kk < 64; kk += 32) {
          bf16x8 af = ldfrag(VT, 72, rt * 16, kk, lane);
#pragma unroll
          for (int t = 0; t < 4; ++t) st[t] = mma(af, ldfrag(KT, 72, (4 * chf + t) * 16, kk, lane), st[t]);
        }
        if (m0 >= NCTX) {
          const float qd = __expf(lg * (float)(d ? 64 - l : l + 1));
          u16* yp = Y + (size_t)(m0 + l - NCTX) * 2048 + h * 256 + sl * 64 + quad * 4;
#pragma unroll
          for (int t = 0; t < 2; ++t) {
            float o[4];
#pragma unroll
            for (int j = 0; j < 4; ++j) o[j] = ya[t][j] + qd * yi[t][j];
            u16* yq = yp + (2 * chf + t) * 16;
            if (d) {
              const uint2 prev = yprev[t];
              o[0] += bf2f((u16)(prev.x & 0xffff)); o[1] += bf2f((u16)(prev.x >> 16));
              o[2] += bf2f((u16)(prev.y & 0xffff)); o[3] += bf2f((u16)(prev.y >> 16));
            }
            *(uint2*)yq = pack4(o[0], o[1], o[2], o[3]);
          }
        }
      }
    }
  }
}

__device__ __forceinline__ void phase_ynorm(const Params& p) {
  const int TT = opaque_tid();
  const u16* __restrict__ Y = (const u16*)(p.ws + O_Y);
  float* __restrict__ rstd = (float*)(p.ws + O_RSTD);
  const int lane = LTID & 63, wv = LTID >> 6;
#pragma unroll 2
  for (int m = VBID * 4 + wv; m < NLAT; m += VGRID * 4) {
#pragma unroll
    for (int h = 0; h < 8; ++h) {
      uint2 q = *(const uint2*)(Y + (size_t)m * 2048 + h * 256 + lane * 4);
      float a = bf2f((u16)(q.x & 0xffff)), b2 = bf2f((u16)(q.x >> 16)), c = bf2f((u16)(q.y & 0xffff)), d = bf2f((u16)(q.y >> 16));
      float ss = wave_sum(a * a + b2 * b2 + c * c + d * d);
      if (lane == 0) rstd[m * 8 + h] = rsqrtf(ss * (1.f / 256.f) + 1e-6f);
    }
  }
}

__device__ __forceinline__ void phase_final(const Params& p) {
  const int TT = opaque_tid();
  const float* g = p.in[I_FNG];
  const int lane = LTID & 63, wv = LTID >> 6;
  for (int m = (VBID * 4 + wv) * 2; m < NLAT; m += VGRID * 8) {
    float4 v[2][4]; float ss[2] = {0.f, 0.f};
#pragma unroll
    for (int q = 0; q < 2; ++q)
#pragma unroll
      for (int i = 0; i < 4; ++i) v[q][i] = *(const float4*)(p.out + (size_t)(m + q) * 1024 + i * 256 + lane * 4);
#pragma unroll
    for (int q = 0; q < 2; ++q) {
#pragma unroll
      for (int i = 0; i < 4; ++i) ss[q] += v[q][i].x * v[q][i].x + v[q][i].y * v[q][i].y + v[q][i].z * v[q][i].z + v[q][i].w * v[q][i].w;
      ss[q] = wave_sum(ss[q]);
    }
#pragma unroll
    for (int q = 0; q < 2; ++q) {
      const float rstd = rsqrtf(ss[q] * (1.f / 1024.f) + 1e-6f);
#pragma unroll
      for (int i = 0; i < 4; ++i) {
        int c = i * 256 + lane * 4;
        float4 gg = *(const float4*)(g + c);
        *(float4*)(p.out + (size_t)(m + q) * 1024 + c) = make_float4(v[q][i].x * rstd * gg.x, v[q][i].y * rstd * gg.y, v[q][i].z * rstd * gg.z, v[q][i].w * rstd * gg.w);
      }
    }
  }
}

#define XB_TMO      128
#define XB_XCNT(j)  (256  + 64 * (j))
#define XB_XSUB(j)  (1280 + 64 * (j))
#define XB_XGEN(j)  (2304 + 64 * (j))
#define XB_TOP      3328
#define XB_TOPGEN   3392
#define XCD_BAR_WORDS 3456
#define XB_SPIN_CAP (1u << 22)
#define LAS __attribute__((address_space(3)))
__device__ __forceinline__ unsigned xb_ld(unsigned* p)              { return __hip_atomic_load(p, __ATOMIC_RELAXED, __HIP_MEMORY_SCOPE_AGENT); }
__device__ __forceinline__ unsigned xb_add(unsigned* p, unsigned v) { return __hip_atomic_fetch_add(p, v, __ATOMIC_RELAXED, __HIP_MEMORY_SCOPE_AGENT); }
__device__ __forceinline__ unsigned xb_xcc_id() { return (unsigned)__builtin_amdgcn_s_getreg((3 << 11) | 20) & 0xFu; }
#define XB_SPIN(cond, bar) do { unsigned _sp = 0; while (cond) { __builtin_amdgcn_s_sleep(1); \
    if ((++_sp & 255u) == 0u) { if (xb_ld(&(bar)[XB_TMO])) break; if (_sp > XB_SPIN_CAP) { atomicAdd(&(bar)[XB_TMO], 1u); break; } } } } while (0)
struct XcdBarrier { unsigned* bar; unsigned x; volatile LAS unsigned* st; };
__device__ __forceinline__ XcdBarrier xcd_barrier_post(unsigned* bar, volatile LAS unsigned* st) {
  XcdBarrier b; b.bar = bar; b.x = xb_xcc_id(); b.st = st;
  if (threadIdx.x == 0) (void)xb_add(&bar[XB_XCNT(b.x)], 1u);
  return b;
}
__device__ __forceinline__ void xcd_barrier_complete(unsigned* bar, unsigned x, unsigned& nloc, unsigned& nx) {
  const unsigned G = gridDim.x * gridDim.y * gridDim.z;
  unsigned sum, cnt, mine, sp = 0u;
  for (;;) {
    sum = 0u; cnt = 0u; mine = 0u;
#pragma unroll
    for (unsigned j = 0; j < 16; ++j) { const unsigned c = xb_ld(&bar[XB_XCNT(j)]); sum += c; cnt += (c > 0u) ? 1u : 0u; mine = (j == x) ? c : mine; }
    if (sum == G) break;
    __builtin_amdgcn_s_sleep(1);
    if ((++sp & 255u) == 0u) { if (xb_ld(&bar[XB_TMO])) break; if (sp > XB_SPIN_CAP) { atomicAdd(&bar[XB_TMO], 1u); break; } }
  }
  nloc = mine > 0u ? mine : 1u; nx = cnt > 0u ? cnt : 1u;
}
__device__ __forceinline__ void xcd_barrier(const XcdBarrier& b) {
  asm volatile("s_waitcnt vmcnt(0)" ::: "memory");
  __syncthreads();
  if (threadIdx.x == 0) {
    unsigned* bar = b.bar;
    __builtin_amdgcn_s_waitcnt(0);
    unsigned nloc = b.st[0], nx = b.st[1];
    if (nloc == 0u) { xcd_barrier_complete(bar, b.x, nloc, nx); b.st[0] = nloc; b.st[1] = nx; }
    const unsigned old = xb_add(&bar[XB_XSUB(b.x)], 1u);
    const unsigned gen = old / nloc;
    if (old + 1u == (gen + 1u) * nloc) {
      __builtin_amdgcn_fence(__ATOMIC_RELEASE, "agent");
      asm volatile("s_waitcnt vmcnt(0)" ::: "memory");
      const unsigned og = xb_add(&bar[XB_TOP], 1u);
      const unsigned tg = og / nx;
      if (og + 1u == (tg + 1u) * nx) xb_add(&bar[XB_TOPGEN], 1u);
      else XB_SPIN(xb_ld(&bar[XB_TOPGEN]) == tg, bar);
      __builtin_amdgcn_fence(__ATOMIC_ACQUIRE, "agent");
      xb_add(&bar[XB_XGEN(b.x)], 1u);
      asm volatile("s_waitcnt vmcnt(0)" ::: "memory");
    } else {
      XB_SPIN(xb_ld(&bar[XB_XGEN(b.x)]) == gen, bar);
      __builtin_amdgcn_fence(__ATOMIC_ACQUIRE, "agent");
      asm volatile("s_waitcnt vmcnt(0)" ::: "memory");
    }
  }
  __syncthreads();
}

#ifndef PHMASK
#define PHMASK 0xFFFFFFFFFFFFFFFFull
#endif
#ifndef PHREP
#define PHREP 0ull
#endif
namespace pg8 {
#define PG8_LAS __attribute__((address_space(3)))
constexpr int BM = 256, BK = 64, HALF = 128, HTB = HALF * BK * 2, STAGE_BYTES = 8 * HTB, NXCD = 8, WGM = 4;
__device__ __forceinline__ int lds_byte(int r, int c) { const int st = (r >> 4) * 2 + (c >> 5), rr = r & 15, cc = c & 31, ob = rr * 64 + cc * 2; return st * 1024 + (ob ^ (((ob >> 9) & 1) << 5)); }
__device__ __forceinline__ void stage_rc(int b, int& R, int& C) { const int st = b / 1024, sb = b % 1024, swz = sb ^ (((sb >> 9) & 1) << 5); R = (st >> 1) * 16 + swz / 64; C = (st & 1) * 32 + (swz % 64) / 2; }
__device__ __forceinline__ int perm32(int rho) { const int n = rho >> 4, i = rho & 15; return 8 * (i >> 2) + 4 * n + (i & 3); }
struct Unit { int pm, pn; };
struct Gemm { const u16* A; const u16* Bt; int M, N, K, lda; };
struct StaticOrder {
  int nM, nN, nwg, G, c;
  __device__ void init(int M, int N, int G_, int c_) { nM = M / BM; nN = N / BM; nwg = nM * nN; G = G_; c = c_; }
  __device__ bool next(int i, Unit& u) const {
    const long L = (long)i * G + c; if (L >= nwg) return false;
    int wgid = (int)L; { const int q = nwg / NXCD, r = nwg % NXCD, xcd = wgid % NXCD, off = wgid / NXCD; wgid = (xcd < r ? xcd * (q + 1) : r * (q + 1) + (xcd - r) * q) + off; }
    const int nig = WGM * nN, gid = wgid / nig, fm = gid * WGM, gsz = (nM - fm) < WGM ? (nM - fm) : WGM;
    u.pm = fm + ((wgid % nig) % gsz); u.pn = (wgid % nig) / gsz; return true;
  }
};
template <class Epi>
__device__ __forceinline__ void gemm_phase(PG8_LAS unsigned char* lds, const Gemm g, const StaticOrder& S, const Epi& E) {
  const int tid = opaque_tid(), wid = __builtin_amdgcn_readfirstlane(tid >> 6), lane = tid & 63, wr = wid >> 2, wc = wid & 3, fr = lane & 15, fq = lane >> 4;
  const int K = g.K, nt = K / BK;
  unsigned voffA[2], voffB[2];
#pragma unroll
  for (int i = 0; i < 2; ++i) { int R, C; stage_rc(tid * 16 + i * 8192, R, C);
    const int Rb = Epi::PERM ? ((R & ~31) + perm32(R & 31)) : R;
    voffA[i] = (unsigned)(R * g.lda + C) * 2u; voffB[i] = (unsigned)(Rb * K + C) * 2u; }
  const size_t kstep = (size_t)(BK * 2);
  const size_t hstepA = (size_t)HALF * g.lda * 2, hstepB = (size_t)HALF * K * 2;
  const size_t tstepA = 2 * hstepA, tstepB = 2 * hstepB;
  const unsigned ldsw = (unsigned)wid * 1024u;
  const int aoff = lds_byte(wr * 64 + fr, fq * 8), boff = lds_byte(wc * 32 + fr, fq * 8);
#define PG8_SA(b, h) (((b) * 2 + (h)) * HTB)
#define PG8_SB(b, h) ((4 + (b) * 2 + (h)) * HTB)
#define PG8_STAGE(bufoff, gbase, voff) do { _Pragma("unroll") for (int _i = 0; _i < 2; ++_i) \
        __builtin_amdgcn_global_load_lds((const unsigned*)((const char*)(gbase) + (voff)[_i]), (PG8_LAS unsigned*)(lds + (bufoff) + ldsw + _i * 8192), 16, 0, 0); } while (0)
#define PG8_LDA(dst, b, h) do { _Pragma("unroll") for (int m = 0; m < 4; ++m) _Pragma("unroll") for (int k = 0; k < 2; ++k) dst[m][k] = *(const PG8_LAS bf16x8*)(lds + PG8_SA(b, h) + aoff + m * 2048 + k * 1024); } while (0)
#define PG8_LDB(dst, b, h) do { _Pragma("unroll") for (int n = 0; n < 2; ++n) _Pragma("unroll") for (int k = 0; k < 2; ++k) dst[n][k] = *(const PG8_LAS bf16x8*)(lds + PG8_SB(b, h) + boff + n * 2048 + k * 1024); } while (0)
#define PG8_MMA(ai, bj, At, Bt) do { __builtin_amdgcn_s_setprio(1); _Pragma("unroll") for (int m = 0; m < 4; ++m) _Pragma("unroll") for (int n = 0; n < 2; ++n) _Pragma("unroll") for (int k = 0; k < 2; ++k) \
        acc[ai][bj][m][n] = __builtin_amdgcn_mfma_f32_16x16x32_bf16(Bt[n][k], At[m][k], acc[ai][bj][m][n], 0, 0, 0); __builtin_amdgcn_s_setprio(0); } while (0)
#define PG8_WAIT_V(n) asm volatile("s_waitcnt vmcnt(" #n ")" ::: "memory")
#define PG8_WAIT_L(n) asm volatile("s_waitcnt lgkmcnt(" #n ")" ::: "memory")
#define PG8_BAR __builtin_amdgcn_s_barrier()
#define PG8_SCHED __builtin_amdgcn_sched_barrier(0)
  Unit cur, nxt; int ui = 0;
  if (!S.next(0, cur)) return;
  f32x4 acc[2][2][4][2];
#pragma unroll
  for (int a = 0; a < 2; ++a)
#pragma unroll
    for (int b = 0; b < 2; ++b)
#pragma unroll
      for (int m = 0; m < 4; ++m)
#pragma unroll
        for (int n = 0; n < 2; ++n) acc[a][b][m][n] = (f32x4){0.f, 0.f, 0.f, 0.f};
  bf16x8 At[4][2], B0[2][2], B1[2][2];
  const char* cA = (const char*)g.A + (size_t)cur.pm * tstepA; const char* cB = (const char*)g.Bt + (size_t)cur.pn * tstepB;
  PG8_STAGE(PG8_SB(0, 0), cB, voffB); PG8_STAGE(PG8_SA(0, 0), cA, voffA); PG8_STAGE(PG8_SB(0, 1), cB + hstepB, voffB); PG8_STAGE(PG8_SA(0, 1), cA + hstepA, voffA);
  if (wr == 1) PG8_BAR;
  PG8_WAIT_V(4); PG8_BAR;
  PG8_STAGE(PG8_SB(1, 0), cB + kstep, voffB); PG8_STAGE(PG8_SA(1, 0), cA + kstep, voffA); PG8_STAGE(PG8_SB(1, 1), cB + hstepB + kstep, voffB);
  PG8_WAIT_V(6); PG8_BAR;
  for (;;) {
    const bool has_next = S.next(ui + 1, nxt);
    const char* nA = has_next ? (const char*)g.A + (size_t)nxt.pm * tstepA : cA; const char* nB = has_next ? (const char*)g.Bt + (size_t)nxt.pn * tstepB : cB;
    for (int t = 0; t < nt; t += 2) {
      const bool last = (t == nt - 2);
      const char* a1 = cA + (size_t)(t + 1) * kstep;
      const char* a2 = last ? nA : cA + (size_t)(t + 2) * kstep; const char* b2 = last ? nB : cB + (size_t)(t + 2) * kstep;
      const char* a3 = a2 + kstep; const char* b3 = b2 + kstep;
      PG8_LDB(B0, 0, 0); PG8_SCHED; PG8_LDA(At, 0, 0); PG8_STAGE(PG8_SA(1, 1), a1 + hstepA, voffA);
      PG8_WAIT_L(8); PG8_BAR; PG8_WAIT_L(0); PG8_MMA(0, 0, At, B0); PG8_BAR; PG8_SCHED;
      PG8_LDB(B1, 0, 1); PG8_STAGE(PG8_SB(0, 0), b2, voffB);
      PG8_BAR; PG8_WAIT_L(0); PG8_MMA(0, 1, At, B1); PG8_BAR;
      PG8_LDA(At, 0, 1); PG8_STAGE(PG8_SA(0, 0), a2, voffA);
      PG8_BAR; PG8_WAIT_L(0); PG8_MMA(1, 0, At, B0); PG8_BAR; PG8_SCHED;
      PG8_STAGE(PG8_SB(0, 1), b2 + hstepB, voffB);
      PG8_WAIT_V(6); PG8_BAR; PG8_MMA(1, 1, At, B1); PG8_BAR;
      PG8_LDB(B0, 1, 0); PG8_SCHED; PG8_LDA(At, 1, 0); PG8_STAGE(PG8_SA(0, 1), a2 + hstepA, voffA);
      PG8_WAIT_L(8); PG8_BAR; PG8_WAIT_L(0); PG8_MMA(0, 0, At, B0); PG8_BAR; PG8_SCHED;
      PG8_LDB(B1, 1, 1); PG8_STAGE(PG8_SB(1, 0), b3, voffB);
      PG8_BAR; PG8_WAIT_L(0); PG8_MMA(0, 1, At, B1); PG8_BAR;
      PG8_LDA(At, 1, 1); PG8_STAGE(PG8_SA(1, 0), a3, voffA);
      PG8_BAR; PG8_WAIT_L(0); PG8_MMA(1, 0, At, B0); PG8_BAR; PG8_SCHED;
      PG8_STAGE(PG8_SB(1, 1), b3 + hstepB, voffB);
      PG8_WAIT_V(6); PG8_BAR; PG8_MMA(1, 1, At, B1); PG8_BAR;
    }
    E(acc, cur, wr, wc, fr, fq);
    if (!has_next) break;
#pragma unroll
    for (int a = 0; a < 2; ++a)
#pragma unroll
      for (int b = 0; b < 2; ++b)
#pragma unroll
        for (int m = 0; m < 4; ++m)
#pragma unroll
          for (int n = 0; n < 2; ++n) acc[a][b][m][n] = (f32x4){0.f, 0.f, 0.f, 0.f};
    cur = nxt; cA = nA; cB = nB; ++ui;
  }
  PG8_WAIT_V(0);
  if (wr == 0) PG8_BAR;
  PG8_BAR;
#undef PG8_SA
#undef PG8_SB
#undef PG8_STAGE
#undef PG8_LDA
#undef PG8_LDB
#undef PG8_MMA
#undef PG8_WAIT_V
#undef PG8_WAIT_L
#undef PG8_BAR
#undef PG8_SCHED
}
}

template <class Epi> struct PgEpi {
  static constexpr bool PERM = Epi::PERM;
  Epi e; int nreal;
  __device__ __forceinline__ void operator()(const f32x4 (&acc)[2][2][4][2], const pg8::Unit& u, int wr, int wc, int fr, int fq) const {
#pragma unroll
    for (int ai = 0; ai < 2; ++ai)
#pragma unroll
      for (int m = 0; m < 4; ++m) {
        const int row = u.pm * 256 + ai * 128 + wr * 64 + m * 16 + fr;
#pragma unroll
        for (int bj = 0; bj < 2; ++bj) {
          if constexpr (Epi::PERM) {
            const int col = u.pn * 256 + bj * 128 + wc * 32 + 8 * fq;
            if (col < nreal) e.store8(row, col, acc[ai][bj][m][0], acc[ai][bj][m][1]);
          } else {
#pragma unroll
            for (int n = 0; n < 2; ++n) {
              const int col = u.pn * 256 + bj * 128 + wc * 32 + n * 16 + 4 * fq;
              if (col < nreal) e(row, col, acc[ai][bj][m][n]);
            }
          }
        }
      }
  }
};
template <> struct PgEpi<EpiRes> {
  static constexpr bool PERM = false;
  EpiRes e; int nreal;
  __device__ __forceinline__ void operator()(const f32x4 (&acc)[2][2][4][2], const pg8::Unit& u, int wr, int wc, int fr, int fq) const {
    const int row0 = u.pm * 256 + e.moff;
    const int col0 = u.pn * 256 + wc * 32 + 4 * fq;
    const float* g = e.modv_l + (mod_row(row0) * 6 + e.gi) * 1024 + col0;
    f32x4 gv[2][2];
#pragma unroll
    for (int bj = 0; bj < 2; ++bj)
#pragma unroll
      for (int n = 0; n < 2; ++n) gv[bj][n] = *(const f32x4*)(g + bj * 128 + n * 16);
    const bool isctx = row0 < NCTX;
    const float* sb = isctx ? e.src_c + (size_t)row0 * 1024 : e.src_l + (size_t)(row0 - NCTX) * 1024;
    float* db = isctx ? e.dst_c + (size_t)row0 * 1024 : e.dst_l + (size_t)(row0 - NCTX) * 1024;
#pragma unroll
    for (int ai = 0; ai < 2; ++ai)
#pragma unroll
      for (int mp = 0; mp < 2; ++mp) {
        f32x4 x[2][2][2];
#pragma unroll
        for (int mi = 0; mi < 2; ++mi) {
          const size_t off = (size_t)(ai * 128 + wr * 64 + (mp * 2 + mi) * 16 + fr) * 1024 + col0;
#pragma unroll
          for (int bj = 0; bj < 2; ++bj)
#pragma unroll
            for (int n = 0; n < 2; ++n) x[mi][bj][n] = *(const f32x4*)(sb + off + bj * 128 + n * 16);
        }
        asm volatile("" ::: "memory");
#pragma unroll
        for (int mi = 0; mi < 2; ++mi) {
          const size_t off = (size_t)(ai * 128 + wr * 64 + (mp * 2 + mi) * 16 + fr) * 1024 + col0;
#pragma unroll
          for (int bj = 0; bj < 2; ++bj)
#pragma unroll
            for (int n = 0; n < 2; ++n) *(f32x4*)(db + off + bj * 128 + n * 16) = x[mi][bj][n] + gv[bj][n] * acc[ai][bj][mp * 2 + mi][n];
        }
        asm volatile("" ::: "memory");
      }
  }
};
template <> struct PgEpi<EpiGate> {
  static constexpr bool PERM = true;
  EpiGate e; int nreal;
  __device__ __forceinline__ void operator()(const f32x4 (&acc)[2][2][4][2], const pg8::Unit& u, int wr, int wc, int fr, int fq) const {
    const int col0 = u.pn * 256 + wc * 32 + 8 * fq;
    u32x4 yv[2][4][2]; float rs[2][4];
#pragma unroll
    for (int ai = 0; ai < 2; ++ai)
#pragma unroll
      for (int m = 0; m < 4; ++m) {
        const int row = u.pm * 256 + ai * 128 + wr * 64 + m * 16 + fr;
        rs[ai][m] = e.rstd[row * 8 + u.pn];
#pragma unroll
        for (int bj = 0; bj < 2; ++bj) yv[ai][m][bj] = *(const u32x4*)(e.Y + (size_t)row * 2048 + col0 + bj * 128);
      }
    asm volatile("" ::: "memory");
#pragma unroll
    for (int ai = 0; ai < 2; ++ai)
#pragma unroll
      for (int m = 0; m < 4; ++m) {
        const int row = u.pm * 256 + ai * 128 + wr * 64 + m * 16 + fr;
#pragma unroll
        for (int bj = 0; bj < 2; ++bj) {
          const f32x4 a = acc[ai][bj][m][0], b = acc[ai][bj][m][1];
          const float r = rs[ai][m];
          const u32x4 yy = yv[ai][m][bj];
          float o[8];
          o[0] = siluf_(a[0]) * XLO(yy[0]) * r; o[1] = siluf_(a[1]) * XHI(yy[0]) * r;
          o[2] = siluf_(a[2]) * XLO(yy[1]) * r; o[3] = siluf_(a[3]) * XHI(yy[1]) * r;
          o[4] = siluf_(b[0]) * XLO(yy[2]) * r; o[5] = siluf_(b[1]) * XHI(yy[2]) * r;
          o[6] = siluf_(b[2]) * XLO(yy[3]) * r; o[7] = siluf_(b[3]) * XHI(yy[3]) * r;
          *(u32x4*)(e.Y + (size_t)row * 2048 + col0 + bj * 128) = pack8(o);
        }
      }
  }
};
template <class Epi>
__device__ __forceinline__ void big_gemm(const u16* A, int lda, const u16* Bt, int M, int N, int K, Epi epi, char* smem) {
  const int npad = (N + 255) & ~255;
  pg8::StaticOrder S; S.init(M, npad, gridDim.x, blockIdx.x);
  pg8::Gemm g{A, Bt, M, npad, K, lda};
  PgEpi<Epi> E{epi, N};
  pg8::gemm_phase((PG8_LAS unsigned char*)smem, g, S, E);
  __syncthreads();
}

__global__ void __launch_bounds__(512, 2) mega(Params p) {
  extern __shared__ __attribute__((aligned(16))) char smem0[];
#define HSMEM (smem0 + (opaque_tid() >> 8) * HALF_LDS)
  cg::grid_group grid = cg::this_grid();
  volatile LAS unsigned* xst = (volatile LAS unsigned*)(smem0 + LDS_BYTES);
  if (threadIdx.x == 0) { xst[0] = 0u; xst[1] = 0u; }
  __syncthreads();
  XcdBarrier xb = xcd_barrier_post((unsigned*)(p.ws + O_BAR), xst);
  u16* W = (u16*)p.ws;
  float* modv = (float*)(p.ws + O_MODV);
  float* ctxr = (float*)(p.ws + O_CTXR);
  u16* hx0 = (u16*)((char*)p.out + DO_HX);
  u16* hx = (u16*)(p.ws + O_HX);

  for (int rep_ = 0; rep_ < (int)(((PHMASK >> 0) & 1ull) + ((PHREP >> 0) & 1ull)); ++rep_) {
  phase_prep(p, HSMEM);
  }
  grid.sync();
  for (int rep_ = 0; rep_ < (int)(((PHMASK >> 1) & 1ull) + ((PHREP >> 1) & 1ull)); ++rep_) {
  phase_norm(p.in[I_CTX], p.in[I_X], p.in[I_N1G], modv, 0, 1, hx0, 0, NTOK);
  }
  xcd_barrier(xb);
  for (int rep_ = 0; rep_ < (int)(((PHMASK >> 2) & 1ull) + ((PHREP >> 2) & 1ull)); ++rep_) {
  big_gemm(hx0, 1024, W + W_EVIN, NTOK, PW, 1024, EpiStore{(u16*)(p.ws + O_P), PW}, smem0);
  }
  xcd_barrier(xb);
  for (int rep_ = 0; rep_ < (int)(((PHMASK >> 3) & 1ull) + ((PHREP >> 3) & 1ull)); ++rep_) {
  phase_feat(p);
  phase_xbc(p);
  }
  xcd_barrier(xb);
  {
    const u16* L = (const u16*)((const char*)p.out + DO_L);
    for (int rep_ = 0; rep_ < (int)(((PHMASK >> 4) & 1ull) + ((PHREP >> 4) & 1ull)); ++rep_) {
    gemm_phase(L + 0, 384, W + W_W2F, 64, NTOK, 512, 64, EpiE{(u16*)(p.ws + O_SEF), p.in[I_W0F]}, HSMEM);
    }
    for (int rep_ = 0; rep_ < (int)(((PHMASK >> 5) & 1ull) + ((PHREP >> 5) & 1ull)); ++rep_) {
    gemm_phase(L + 64, 384, W + W_W2B, 64, NTOK, 512, 64, EpiE{(u16*)(p.ws + O_SEB), p.in[I_W0B]}, HSMEM);
    }
    for (int rep_ = 0; rep_ < (int)(((PHMASK >> 6) & 1ull) + ((PHREP >> 6) & 1ull)); ++rep_) {
    gemm_phase(L + 128, 384, W + W_A2F, 64, NTOK, 512, 64, EpiI{(u16*)(p.ws + O_SIF), p.in[I_A0F]}, HSMEM);
    }
    for (int rep_ = 0; rep_ < (int)(((PHMASK >> 7) & 1ull) + ((PHREP >> 7) & 1ull)); ++rep_) {
    gemm_phase(L + 192, 384, W + W_A2B, 64, NTOK, 512, 64, EpiI{(u16*)(p.ws + O_SIB), p.in[I_A0B]}, HSMEM);
    }
    for (int rep_ = 0; rep_ < (int)(((PHMASK >> 8) & 1ull) + ((PHREP >> 8) & 1ull)); ++rep_) {
    gemm_phase(L + 256, 384, W + W_G2, 128, NTOK, 512, 128, EpiStore{(u16*)((char*)p.out + DO_G), 512}, HSMEM);
    }
    for (int rep_ = 0; rep_ < (int)(((PHMASK >> 9) & 1ull) + ((PHREP >> 9) & 1ull)); ++rep_) {
    phase_ssd_prep(p);
    }
  }
  xcd_barrier(xb);
  for (int rep_ = 0; rep_ < (int)(((PHMASK >> 10) & 1ull) + ((PHREP >> 10) & 1ull)); ++rep_) {
  phase_rwkv(p, smem0);
  }
  xcd_barrier(xb);
  for (int rep_ = 0; rep_ < (int)(((PHMASK >> 11) & 1ull) + ((PHREP >> 11) & 1ull)); ++rep_) {
  phase_ssd_states(p, HSMEM);
  }
  xcd_barrier(xb);
  for (int rep_ = 0; rep_ < (int)(((PHMASK >> 12) & 1ull) + ((PHREP >> 12) & 1ull)); ++rep_) {
  phase_ssd_scan(p);
  }
  xcd_barrier(xb);
  for (int rep_ = 0; rep_ < (int)(((PHMASK >> 13) & 1ull) + ((PHREP >> 13) & 1ull)); ++rep_) {
  phase_ssd_out(p, HSMEM);
  }
  xcd_barrier(xb);
  for (int rep_ = 0; rep_ < (int)(((PHMASK >> 14) & 1ull) + ((PHREP >> 14) & 1ull)); ++rep_) {
  phase_finish(p);
  }
  xcd_barrier(xb);
  for (int rep_ = 0; rep_ < (int)(((PHMASK >> 15) & 1ull) + ((PHREP >> 15) & 1ull)); ++rep_) {
  big_gemm((const u16*)(p.ws + O_MIXED), 1024, W + W_EVOUT, NTOK, 1024, 1024,
             EpiRes{p.in[I_CTX], p.in[I_X], ctxr, p.out, modv, 2, 0}, smem0);
  }
  xcd_barrier(xb);
  for (int rep_ = 0; rep_ < (int)(((PHMASK >> 16) & 1ull) + ((PHREP >> 16) & 1ull)); ++rep_) {
  phase_norm(ctxr, p.out, p.in[I_N2G], modv, 3, 4, hx, 0, NTOK);
  }
  xcd_barrier(xb);
  for (int rep_ = 0; rep_ < (int)(((PHMASK >> 17) & 1ull) + ((PHREP >> 17) & 1ull)); ++rep_) {
  big_gemm(hx, 1024, W + W_UP0, NTOK, 5632, 1024, EpiStore{(u16*)(p.ws + O_GV), 5632}, smem0);
  }
  xcd_barrier(xb);
  for (int rep_ = 0; rep_ < (int)(((PHMASK >> 18) & 1ull) + ((PHREP >> 18) & 1ull)); ++rep_) {
  phase_ffnconv(p, 0, 0);
  }
  xcd_barrier(xb);
  for (int rep_ = 0; rep_ < (int)(((PHMASK >> 19) & 1ull) + ((PHREP >> 19) & 1ull)); ++rep_) {
  big_gemm((const u16*)(p.ws + O_GV) + 2816, 5632, W + W_DN0, NTOK, 1024, 2816,
             EpiRes{ctxr, p.out, ctxr, p.out, modv, 5, 0}, smem0);
  }
  xcd_barrier(xb);
  const float* modv1 = modv + 9 * 6144;
  for (int rep_ = 0; rep_ < (int)(((PHMASK >> 20) & 1ull) + ((PHREP >> 20) & 1ull)); ++rep_) {
  phase_norm(ctxr, p.out, p.in[I_N1G] + 1024, modv1, 0, 1, hx, 0, NTOK);
  }
  xcd_barrier(xb);
  for (int rep_ = 0; rep_ < (int)(((PHMASK >> 21) & 1ull) + ((PHREP >> 21) & 1ull)); ++rep_) {
  big_gemm(hx, 1024, W + W_RIN, NTOK, 4096, 1024, EpiQKV{(u16*)(p.ws + O_QKV)}, smem0);
  }
  xcd_barrier(xb);
  for (int rep_ = 0; rep_ < (int)(((PHMASK >> 22) & 1ull) + ((PHREP >> 22) & 1ull)); ++rep_) {
  phase_rope(p);
  }
  xcd_barrier(xb);
  for (int rep_ = 0; rep_ < (int)(((PHMASK >> 23) & 1ull) + ((PHREP >> 23) & 1ull)); ++rep_) {
  phase_retention(p, smem0);
  }
  xcd_barrier(xb);
  for (int rep_ = 0; rep_ < (int)(((PHMASK >> 24) & 1ull) + ((PHREP >> 24) & 1ull)); ++rep_) {
  phase_ynorm(p);
  }
  xcd_barrier(xb);
  for (int rep_ = 0; rep_ < (int)(((PHMASK >> 25) & 1ull) + ((PHREP >> 25) & 1ull)); ++rep_) {
  big_gemm(hx + (size_t)NCTX * 1024, 1024, W + W_RIN + 4096ull * 1024, NLAT, 2048, 1024,
             EpiGate{(u16*)(p.ws + O_Y), (const float*)(p.ws + O_RSTD)}, smem0);
  }
  xcd_barrier(xb);
  for (int rep_ = 0; rep_ < (int)(((PHMASK >> 26) & 1ull) + ((PHREP >> 26) & 1ull)); ++rep_) {
  big_gemm((const u16*)(p.ws + O_Y), 2048, W + W_ROUT, NLAT, 1024, 2048,
             EpiRes{ctxr, p.out, ctxr, p.out, modv1, 2, NCTX}, smem0);
  }
  xcd_barrier(xb);
  for (int rep_ = 0; rep_ < (int)(((PHMASK >> 27) & 1ull) + ((PHREP >> 27) & 1ull)); ++rep_) {
  phase_norm(ctxr, p.out, p.in[I_N2G] + 1024, modv1, 3, 4, hx, NCTX, NTOK);
  }
  xcd_barrier(xb);
  for (int rep_ = 0; rep_ < (int)(((PHMASK >> 28) & 1ull) + ((PHREP >> 28) & 1ull)); ++rep_) {
  big_gemm(hx + (size_t)NCTX * 1024, 1024, W + W_UP1, NLAT, 5632, 1024,
             EpiStore{(u16*)(p.ws + O_GV) + (size_t)NCTX * 5632, 5632}, smem0);
  }
  xcd_barrier(xb);
  for (int rep_ = 0; rep_ < (int)(((PHMASK >> 29) & 1ull) + ((PHREP >> 29) & 1ull)); ++rep_) {
  phase_ffnconv(p, 1, NCTX);
  }
  xcd_barrier(xb);
  for (int rep_ = 0; rep_ < (int)(((PHMASK >> 30) & 1ull) + ((PHREP >> 30) & 1ull)); ++rep_) {
  big_gemm((const u16*)(p.ws + O_GV) + (size_t)NCTX * 5632 + 2816, 5632, W + W_DN1, NLAT, 1024, 2816,
             EpiRes{ctxr, p.out, ctxr, p.out, modv1, 5, NCTX}, smem0);
  }
  xcd_barrier(xb);
  for (int rep_ = 0; rep_ < (int)(((PHMASK >> 31) & 1ull) + ((PHREP >> 31) & 1ull)); ++rep_) {
  phase_final(p);
  }
}

extern "C" void kernel_launch(void* const* d_in, const int* in_sizes, int n_in, void* d_out, int out_size, void* d_ws,
                              size_t ws_size, hipStream_t stream) {
  static int grid_blocks = 0;
  if (!grid_blocks) {
    int dev = 0, cus = 0, per_cu = 0;
    hipGetDevice(&dev);
    hipDeviceGetAttribute(&cus, hipDeviceAttributeMultiprocessorCount, dev);
    hipFuncSetAttribute((const void*)mega, hipFuncAttributeMaxDynamicSharedMemorySize, LDS_BYTES + 16);
    hipOccupancyMaxActiveBlocksPerMultiprocessor(&per_cu, (const void*)mega, 512, LDS_BYTES + 16);
    if (per_cu < 1) per_cu = 1;
    if (per_cu > 1) per_cu = 1;
    grid_blocks = cus * per_cu;
    fprintf(stderr, "mega: cus=%d per_cu=%d grid=%d ws=%zu\n", cus, per_cu, grid_blocks, ws_size);
  }
  Params p{};
  for (int i = 0; i < N_IN; ++i) p.in[i] = (const float*)d_in[i];
  p.out = (float*)d_out;
  p.ws = (char*)d_ws;
  hipMemsetAsync((char*)d_ws + O_BAR, 0, XCD_BAR_WORDS * 4, stream);
  void* args[] = {&p};
  hipError_t e = hipLaunchCooperativeKernel((const void*)mega, dim3(grid_blocks), dim3(512), args, LDS_BYTES + 16, stream);
  if (e != hipSuccess) fprintf(stderr, "cooperative launch failed: %s (grid %d)\n", hipGetErrorString(e), grid_blocks);
}
```

```cpp
#include <hip/hip_runtime.h>
#include <hip/hip_cooperative_groups.h>
#include <cstdio>
namespace cg = cooperative_groups;

typedef unsigned short u16;
using bf16x8 = __attribute__((ext_vector_type(8))) short;
using f32x4 = __attribute__((ext_vector_type(4))) float;
using u32x4 = __attribute__((ext_vector_type(4))) unsigned int;

#define NTOK 67584
#define NCTX 2048
#define NLAT 65536
#define PW 3472
#define LDS_BYTES 147456
#define HALF_LDS 73728
#define LTID ((int)(TT & 255))
#define VBID ((int)(blockIdx.x * 2 + (TT >> 8)))
__device__ __forceinline__ int opaque_tid() { int t = threadIdx.x; asm volatile("" : "+v"(t)); return t; }
#define VGRID ((int)(gridDim.x * 2))

enum { I_X = 0, I_C, I_CTX, I_CCTX, I_MODW, I_MODB, I_N1G, I_N2G, I_FUP, I_FCW, I_FCB, I_FDN,
       I_EVIN, I_MUP, I_MUN, I_W0F, I_W0B, I_W2F, I_W2B, I_A0F, I_A0B, I_A2F, I_A2B, I_G2, I_KK, I_KA, I_RK,
       I_LNW, I_LNB, I_SCW, I_SCB, I_DTBF, I_DTBB, I_ALF, I_ALB, I_SD, I_SNW, I_EVOUT, I_RIN, I_L2F, I_L2B, I_ROUT, I_FNG, N_IN };

struct Params { const float* in[N_IN]; float* out; char* ws; };

#define MiB (1024ull * 1024ull)
#define W_EVIN   0ull
#define W_EVOUT  (W_EVIN + 3472ull * 1024)
#define W_UP0    (W_EVOUT + 1024ull * 1024)
#define W_UP1    (W_UP0 + 5632ull * 1024)
#define W_DN0    (W_UP1 + 5632ull * 1024)
#define W_DN1    (W_DN0 + 1024ull * 2816)
#define W_RIN    (W_DN1 + 1024ull * 2816)
#define W_ROUT   (W_RIN + 6144ull * 1024)
#define W_W2F    (W_ROUT + 1024ull * 2048)
#define W_W2B    (W_W2F + 512ull * 64)
#define W_A2F    (W_W2B + 512ull * 64)
#define W_A2B    (W_A2F + 512ull * 64)
#define W_G2     (W_A2B + 512ull * 64)
#define O_SMALL  (64 * MiB)
#define O_MODV   (O_SMALL)
#define O_ROPE   (O_MODV + 2ull * 9 * 6144 * 4)
#define O_CTXR   (O_SMALL + 1 * MiB)
#define O_RN     (O_CTXR + 8 * MiB)
#define O_BONUS  (O_RN + 2162688ull)
#define O_DT     (O_BONUS + 2162688ull)
#define O_CS     (O_DT + 2 * 2162688ull)
#define O_RSTD   (O_CS + 2 * 2162688ull)
#define O_BAR    (O_RSTD + 2097152ull)
#define O_BIG    (96 * MiB)
#define SZ_TOK512 (69206016ull)
#define O_P      (O_BIG)
#define O_S      (544 * MiB)
#define O_SR     (O_S)
#define O_SK     (O_S + SZ_TOK512)
#define O_SV     (O_S + 2 * SZ_TOK512)
#define O_SEF    (O_S + 3 * SZ_TOK512)
#define O_SEB    (O_S + 4 * SZ_TOK512)
#define O_SIF    (O_S + 5 * SZ_TOK512)
#define O_SIB    (O_S + 6 * SZ_TOK512)
#define O_STATES (O_SEF)
#define O_MIXED  (O_SR)
#define O_HX     (O_BIG)
#define O_GV     (228 * MiB)
#define O_QKV    (228 * MiB)
#define O_Y      (756 * MiB)
#define DO_HX    0ull
#define DO_L     (138412032ull)
#define DO_G     (DO_L + 51904512ull)

__device__ __forceinline__ unsigned pack2(float a, float b) {
  unsigned r;
  asm("v_cvt_pk_bf16_f32 %0, %1, %2" : "=v"(r) : "v"(a), "v"(b));
  return r;
}
__device__ __forceinline__ u16 f2bf(float f) { return (u16)(pack2(f, f) & 0xffffu); }
__device__ __forceinline__ float bf2f(u16 h) { return __uint_as_float(((unsigned)h) << 16); }
__device__ __forceinline__ uint2 pack4(float a, float b, float c, float d) { return make_uint2(pack2(a, b), pack2(c, d)); }
__device__ __forceinline__ float sigmoidf_(float x) { return __builtin_amdgcn_rcpf(1.f + __expf(-x)); }
__device__ __forceinline__ float siluf_(float x) { return x * __builtin_amdgcn_rcpf(1.f + __expf(-x)); }
__device__ __forceinline__ float tanhf_(float x) { return 1.f - 2.f * __builtin_amdgcn_rcpf(__expf(2.f * x) + 1.f); }
__device__ __forceinline__ float softplusf_(float x) { return x > 20.f ? x : log1pf(__expf(x)); }
__device__ __forceinline__ float geluf_(float x) { return 0.5f * x * (1.f + tanhf_(0.7978845608028654f * (x + 0.044715f * x * x * x))); }
__device__ __forceinline__ float wave_sum(float v) {
#pragma unroll
  for (int o = 32; o; o >>= 1) v += __shfl_xor(v, o);
  return v;
}
template <int C> __device__ __forceinline__ float dppf(float v) {
  return __int_as_float(__builtin_amdgcn_update_dpp(0, __float_as_int(v), C, 0xF, 0xF, true));
}
__device__ __forceinline__ float red16(float v) {
  v += dppf<0xB1>(v);
  v += dppf<0x4E>(v);
  v += dppf<0x141>(v);
  v += dppf<0x140>(v);
  return v;
}
__device__ __forceinline__ bool has_prev(int m) { return m < NCTX ? (m & 255) != 0 : ((m - NCTX) & 8191) != 0; }
__device__ __forceinline__ bool has_next(int m) { return m < NCTX ? (m & 255) != 255 : ((m - NCTX) & 8191) != 8191; }
__device__ __forceinline__ int mod_row(int m) { return m < NCTX ? 8 : ((m - NCTX) >> 13); }
__device__ __forceinline__ int scan_tok(int dir, int b, int s) {
  if (s < 256) return b * 256 + (dir ? 255 - s : s);
  int t = s - 256;
  return NCTX + b * 8192 + (dir ? 8191 - t : t);
}
__device__ __forceinline__ bf16x8 ldfrag(const u16* base, int stride, int row0, int k0, int lane) {
  return *(const bf16x8*)(base + (row0 + (lane & 15)) * stride + k0 + (lane >> 4) * 8);
}
__device__ __forceinline__ f32x4 mma(bf16x8 afrag, bf16x8 bfrag, f32x4 acc) {
  return __builtin_amdgcn_mfma_f32_16x16x32_bf16(bfrag, afrag, acc, 0, 0, 0);
}

template <class Epi> __forceinline__
__device__ __forceinline__ void gemm_phase(const u16* __restrict__ A, int lda, const u16* __restrict__ Bt, int ldb, int M, int N, int K,
                           Epi epi, char* smem_) {
  const int TT = opaque_tid();
  u16* As = (u16*)smem_;
  u16* Bs = As + 128 * 72;
  const int tid = LTID, lane = tid & 63, wave = tid >> 6;
  const int wm = (wave >> 1) * 64, wn = (wave & 1) * 64;
  const int tiles_n = (N + 127) >> 7, tiles_m = (M + 127) >> 7;
  const int ntiles = tiles_m * tiles_n;
  const int lrow = tid >> 3, lkc = (tid & 7) * 8;
  for (int vb = VBID; vb < ntiles; vb += VGRID) {
    const int tm = vb / tiles_n, tn = vb - tm * tiles_n;
    const int m0 = tm * 128, n0 = tn * 128;
    f32x4 acc[4][4];
#pragma unroll
    for (int i = 0; i < 4; ++i)
#pragma unroll
      for (int j = 0; j < 4; ++j) acc[i][j] = (f32x4){0.f, 0.f, 0.f, 0.f};
    u32x4 ra[4], rb[4];
    const u16* ap[4];
    const u16* bp[4];
#pragma unroll
    for (int i = 0; i < 4; ++i) {
      int row = lrow + i * 32;
      int am = min(m0 + row, M - 1), bn = min(n0 + row, N - 1);
      ap[i] = A + (size_t)am * lda + lkc;
      bp[i] = Bt + (size_t)bn * ldb + lkc;
    }
#pragma unroll
    for (int i = 0; i < 4; ++i) { ra[i] = *(const u32x4*)(ap[i]); rb[i] = *(const u32x4*)(bp[i]); }
    for (int k0 = 0; k0 < K; k0 += 64) {
      __syncthreads();
#pragma unroll
      for (int i = 0; i < 4; ++i) {
        *(u32x4*)(As + (lrow + i * 32) * 72 + lkc) = ra[i];
        *(u32x4*)(Bs + (lrow + i * 32) * 72 + lkc) = rb[i];
      }
      __syncthreads();
      if (k0 + 64 < K) {
#pragma unroll
        for (int i = 0; i < 4; ++i) { ra[i] = *(const u32x4*)(ap[i] + k0 + 64); rb[i] = *(const u32x4*)(bp[i] + k0 + 64); }
      }
#pragma unroll
      for (int kk = 0; kk < 64; kk += 32) {
        bf16x8 af[4], bfr[4];
#pragma unroll
        for (int i = 0; i < 4; ++i) af[i] = ldfrag(As, 72, wm + i * 16, kk, lane);
#pragma unroll
        for (int j = 0; j < 4; ++j) bfr[j] = ldfrag(Bs, 72, wn + j * 16, kk, lane);
#pragma unroll
        for (int i = 0; i < 4; ++i)
#pragma unroll
          for (int j = 0; j < 4; ++j) acc[i][j] = mma(af[i], bfr[j], acc[i][j]);
      }
    }
#pragma unroll
    for (int i = 0; i < 4; ++i)
#pragma unroll
      for (int j = 0; j < 4; ++j) {
        int m = m0 + wm + i * 16 + (lane & 15);
        int n = n0 + wn + j * 16 + (lane >> 4) * 4;
        if (m < M && n < N) epi(m, n, acc[i][j]);
      }
  }
}

struct EpiStore { static constexpr bool PERM = true; u16* C; int ldc;
  __device__ void store8(int m, int n, f32x4 a, f32x4 b) const { u32x4 o = {pack2(a[0], a[1]), pack2(a[2], a[3]), pack2(b[0], b[1]), pack2(b[2], b[3])}; *(u32x4*)(C + (size_t)m * ldc + n) = o; }
  __device__ void operator()(int m, int n, f32x4 v) const { *(uint2*)(C + (size_t)m * ldc + n) = pack4(v[0], v[1], v[2], v[3]); } };
struct EpiE { static constexpr bool PERM = false; u16* C; const float* w0;
  __device__ void operator()(int m, int n, f32x4 v) const {
    float4 w = *(const float4*)(w0 + n);
    *(uint2*)(C + (size_t)m * 512 + n) = pack4(sigmoidf_(w.x + v[0]) * 0.6065306597126334f, sigmoidf_(w.y + v[1]) * 0.6065306597126334f,
                                              sigmoidf_(w.z + v[2]) * 0.6065306597126334f, sigmoidf_(w.w + v[3]) * 0.6065306597126334f); } };
struct EpiI { static constexpr bool PERM = false; u16* C; const float* a0;
  __device__ void operator()(int m, int n, f32x4 v) const {
    float4 w = *(const float4*)(a0 + n);
    *(uint2*)(C + (size_t)m * 512 + n) = pack4(sigmoidf_(w.x + v[0]), sigmoidf_(w.y + v[1]), sigmoidf_(w.z + v[2]), sigmoidf_(w.w + v[3])); } };
struct EpiRes { static constexpr bool PERM = false; const float* src_c; const float* src_l; float* dst_c; float* dst_l; const float* modv_l; int gi; int moff;
  __device__ void operator()(int m_, int n, f32x4 v) const {
    int m = m_ + moff;
    const float* g = modv_l + (mod_row(m) * 6 + gi) * 1024 + n;
    float4 gg = *(const float4*)g;
    const float* s; float* d;
    if (m < NCTX) { s = src_c + (size_t)m * 1024 + n; d = dst_c + (size_t)m * 1024 + n; }
    else { s = src_l + (size_t)(m - NCTX) * 1024 + n; d = dst_l + (size_t)(m - NCTX) * 1024 + n; }
    float4 x = *(const float4*)s;
    x.x += gg.x * v[0]; x.y += gg.y * v[1]; x.z += gg.z * v[2]; x.w += gg.w * v[3];
    *(float4*)d = x; } };
struct EpiQKV { static constexpr bool PERM = true; u16* C;
  __device__ void store8(int m, int n, f32x4 a, f32x4 b) const {
    float sc_ = (n >= 1024 && n < 2048) ? 0.08838834764831845f : 1.f;
    u32x4 o = {pack2(a[0] * sc_, a[1] * sc_), pack2(a[2] * sc_, a[3] * sc_), pack2(b[0] * sc_, b[1] * sc_), pack2(b[2] * sc_, b[3] * sc_)};
    *(u32x4*)(C + (size_t)m * 4096 + n) = o; }
  __device__ void operator()(int m, int n, f32x4 v) const {
    float s = (n >= 1024 && n < 2048) ? 0.08838834764831845f : 1.f;
    *(uint2*)(C + (size_t)m * 4096 + n) = pack4(v[0] * s, v[1] * s, v[2] * s, v[3] * s); } };
struct EpiGate { static constexpr bool PERM = true; u16* Y; const float* rstd;
  __device__ void store8(int m, int n, f32x4 a, f32x4 b) const {
    u16* yp = Y + (size_t)m * 2048 + n;
    u32x4 yy = *(const u32x4*)yp;
    float r = rstd[m * 8 + (n >> 8)];
    float g[8] = {a[0], a[1], a[2], a[3], b[0], b[1], b[2], b[3]};
    float o[8];
#pragma unroll
    for (int i = 0; i < 4; ++i) {
      o[2 * i] = siluf_(g[2 * i]) * bf2f((u16)(yy[i] & 0xffff)) * r;
      o[2 * i + 1] = siluf_(g[2 * i + 1]) * bf2f((u16)(yy[i] >> 16)) * r;
    }
    u32x4 ov = {pack2(o[0], o[1]), pack2(o[2], o[3]), pack2(o[4], o[5]), pack2(o[6], o[7])};
    *(u32x4*)yp = ov; }
  __device__ void operator()(int m, int n, f32x4 v) const {
    u16* yp = Y + (size_t)m * 2048 + n;
    uint2 yy = *(const uint2*)yp;
    float r = rstd[m * 8 + (n >> 8)];
    float y0 = bf2f((u16)(yy.x & 0xffff)), y1 = bf2f((u16)(yy.x >> 16)), y2 = bf2f((u16)(yy.y & 0xffff)), y3 = bf2f((u16)(yy.y >> 16));
    *(uint2*)yp = pack4(siluf_(v[0]) * y0 * r, siluf_(v[1]) * y1 * r, siluf_(v[2]) * y2 * r, siluf_(v[3]) * y3 * r); } };

__device__ __forceinline__ void transpose_job(const float* __restrict__ src, u16* __restrict__ dst, int K, int N, char* smem) {
  const int TT = opaque_tid();
  float* tile = (float*)smem;
  const int tid = LTID;
  const int tk = K >> 6, tn = (N + 63) >> 6;
  const int ntiles = tk * tn;
  for (int vb = VBID; vb < ntiles; vb += VGRID) {
    const int k0 = (vb / tn) * 64, n0 = (vb % tn) * 64;
    __syncthreads();
#pragma unroll
    for (int i = 0; i < 4; ++i) {
      int r = (tid >> 4) + i * 16, c4 = (tid & 15) * 4;
      float4 v = make_float4(0.f, 0.f, 0.f, 0.f);
      if (n0 + c4 < N) v = *(const float4*)(src + (size_t)(k0 + r) * N + n0 + c4);
      tile[r * 65 + c4] = v.x; tile[r * 65 + c4 + 1] = v.y; tile[r * 65 + c4 + 2] = v.z; tile[r * 65 + c4 + 3] = v.w;
    }
    __syncthreads();
#pragma unroll
    for (int i = 0; i < 2; ++i) {
      int item = tid + i * 256; int kc = item & 7, n = item >> 3;
      if (n0 + n < N) {
        float v[8];
#pragma unroll
        for (int j = 0; j < 8; ++j) v[j] = tile[(kc * 8 + j) * 65 + n];
        u32x4 o = {pack2(v[0], v[1]), pack2(v[2], v[3]), pack2(v[4], v[5]), pack2(v[6], v[7])};
        *(u32x4*)(dst + (size_t)(n0 + n) * K + k0 + kc * 8) = o;
      }
    }
  }
}

__device__ __forceinline__ void phase_prep(const Params& p, char* smem) {
  const int TT = opaque_tid();
  u16* W = (u16*)p.ws;
  transpose_job(p.in[I_EVIN], W + W_EVIN, 1024, 3472, smem);
  transpose_job(p.in[I_W2F], W + W_W2F, 64, 512, smem);
  transpose_job(p.in[I_W2B], W + W_W2B, 64, 512, smem);
  transpose_job(p.in[I_A2F], W + W_A2F, 64, 512, smem);
  transpose_job(p.in[I_A2B], W + W_A2B, 64, 512, smem);
  transpose_job(p.in[I_G2], W + W_G2, 128, 512, smem);
  {
    float* rope = (float*)(p.ws + O_ROPE);
    for (int idx = VBID * 256 + LTID; idx < (128 + 64) * 32; idx += VGRID * 256) {
      int j = idx & 31, pos = idx >> 5;
      bool isrow = pos < 128;
      int pp = isrow ? pos : pos - 128;
      float inv = powf(10000.f, -(float)j / 32.f);
      float ang = (float)pp * inv;
      double a = (double)ang;
      double kq = rint(a * 0.15915494309189535);
      double r = a - kq * 6.283185307179586476925;
      double r2 = r * r;
      double sn = r, cs = 1.0, ts = r, tc = 1.0;
#pragma unroll 1
      for (int it = 1; it <= 14; ++it) {
        tc = -tc * r2 / (double)((2 * it - 1) * (2 * it));
        ts = -ts * r2 / (double)((2 * it) * (2 * it + 1));
        cs += tc; sn += ts;
      }
      if (isrow) { rope[pp * 32 + j] = (float)cs; rope[4096 + pp * 32 + j] = (float)sn; }
      else { rope[8192 + pp * 32 + j] = (float)cs; rope[8192 + 2048 + pp * 32 + j] = (float)sn; }
    }
  }
  {
    float* sc = (float*)smem;
    float* red = sc + 9 * 1024;
    float* modv = (float*)(p.ws + O_MODV);
    bool loaded = false;
    __syncthreads();
    for (int vb = VBID; vb < 384; vb += VGRID) {
      if (!loaded) {
        for (int i = LTID; i < 9 * 1024; i += 256) {
          int r = i >> 10, k = i & 1023;
          float cv = r < 8 ? p.in[I_C][r * 1024 + k] : p.in[I_CCTX][k];
          sc[i] = cv / (1.f + expf(-cv));
        }
        loaded = true;
        __syncthreads();
      }
      int l = vb / 192, jb = vb % 192;
      int jj = LTID & 31, kc = LTID >> 5;
      int j = jb * 32 + jj;
      const float* w = p.in[I_MODW] + ((size_t)l * 1024 + kc * 128) * 6144 + j;
      float acc[9];
#pragma unroll
      for (int r = 0; r < 9; ++r) acc[r] = 0.f;
#pragma unroll 16
      for (int k = 0; k < 128; ++k) {
        float wv = w[(size_t)k * 6144];
#pragma unroll
        for (int r = 0; r < 9; ++r) acc[r] += sc[r * 1024 + kc * 128 + k] * wv;
      }
      __syncthreads();
#pragma unroll
      for (int r = 0; r < 9; ++r) red[(kc * 9 + r) * 32 + jj] = acc[r];
      __syncthreads();
      if (kc == 0) {
        float mb = p.in[I_MODB][l * 6144 + j];
#pragma unroll
        for (int r = 0; r < 9; ++r) {
          float sum = 0.f;
#pragma unroll
          for (int q = 0; q < 8; ++q) sum += red[(q * 9 + r) * 32 + jj];
          modv[((size_t)l * 9 + r) * 6144 + j] = sum + mb;
        }
      }
    }
    __syncthreads();
  }
}

__device__ __forceinline__ void phase_norm(const float* src_c, const float* src_l, const float* g, const float* modv_l, int si, int sci,
                           u16* hx, int r0, int r1) {
  const int TT = opaque_tid();
  const int lane = LTID & 63, wv = LTID >> 6;
  for (int m = r0 + (VBID * 4 + wv) * 2; m < r1; m += VGRID * 8) {
    float4 v[2][4];
    float ss[2] = {0.f, 0.f};
#pragma unroll
    for (int q = 0; q < 2; ++q) {
      const int mm = m + q;
      const float* src = mm < NCTX ? src_c + (size_t)mm * 1024 : src_l + (size_t)(mm - NCTX) * 1024;
#pragma unroll
      for (int i = 0; i < 4; ++i) v[q][i] = *(const float4*)(src + i * 256 + lane * 4);
    }
#pragma unroll
    for (int q = 0; q < 2; ++q) {
#pragma unroll
      for (int i = 0; i < 4; ++i) ss[q] += v[q][i].x * v[q][i].x + v[q][i].y * v[q][i].y + v[q][i].z * v[q][i].z + v[q][i].w * v[q][i].w;
      ss[q] = wave_sum(ss[q]);
    }
#pragma unroll
    for (int q = 0; q < 2; ++q) {
      const int mm = m + q;
      const int r = mod_row(mm);
      const float* sh = modv_l + (r * 6 + si) * 1024;
      const float* scl = modv_l + (r * 6 + sci) * 1024;
      const float rstd = rsqrtf(ss[q] * (1.f / 1024.f) + 1e-6f);
#pragma unroll
      for (int i = 0; i < 4; ++i) {
        int c = i * 256 + lane * 4;
        float4 gg = *(const float4*)(g + c), s1 = *(const float4*)(scl + c), s0 = *(const float4*)(sh + c);
        float y0 = v[q][i].x * rstd * gg.x * (1.f + s1.x) + s0.x;
        float y1 = v[q][i].y * rstd * gg.y * (1.f + s1.y) + s0.y;
        float y2 = v[q][i].z * rstd * gg.z * (1.f + s1.z) + s0.z;
        float y3 = v[q][i].w * rstd * gg.w * (1.f + s1.w) + s0.w;
        *(uint2*)(hx + (size_t)mm * 1024 + c) = pack4(y0, y1, y2, y3);
      }
    }
  }
}

__device__ __forceinline__ float red8(float v) {
  v += dppf<0xB1>(v);
  v += dppf<0x4E>(v);
  v += dppf<0x141>(v);
  return v;
}
__device__ __forceinline__ void unpack8(u32x4 q, float* o) {
#pragma unroll
  for (int e = 0; e < 4; ++e) { o[2 * e] = bf2f((u16)(q[e] & 0xffff)); o[2 * e + 1] = bf2f((u16)(q[e] >> 16)); }
}
__device__ __forceinline__ u32x4 pack8(const float* o) {
  u32x4 r = {pack2(o[0], o[1]), pack2(o[2], o[3]), pack2(o[4], o[5]), pack2(o[6], o[7])};
  return r;
}
__device__ __forceinline__ void load8f(const float* p, float* o) {
  float4 a = *(const float4*)p, b = *(const float4*)(p + 4);
  o[0] = a.x; o[1] = a.y; o[2] = a.z; o[3] = a.w; o[4] = b.x; o[5] = b.y; o[6] = b.z; o[7] = b.w;
}
__device__ __forceinline__ void shifted8(const u16* row, int col, bool hp, bool hn, const float* mup, const float* mun, float* o) {
  const u32x4 z4 = {0u, 0u, 0u, 0u};
  u32x4 cur = *(const u32x4*)(row + col);
  u32x4 prv = *(const u32x4*)(row + col - (hp ? PW : 0));
  u32x4 nxt = *(const u32x4*)(row + col + (hn ? PW : 0));
  prv = hp ? prv : z4; nxt = hn ? nxt : z4;
  float u[8], pv[8], nx[8], mp[8], mn[8];
  unpack8(cur, u); unpack8(prv, pv); unpack8(nxt, nx);
  load8f(mup + col, mp); load8f(mun + col, mn);
#pragma unroll
  for (int i = 0; i < 8; ++i) o[i] = u[i] + mp[i] * (pv[i] - u[i]) + mn[i] * (nx[i] - u[i]);
}
__device__ __forceinline__ void phase_feat(const Params& p) {
  const int TT = opaque_tid();
  const u16* __restrict__ P = (const u16*)(p.ws + O_P);
  u16* __restrict__ Sr = (u16*)(p.ws + O_SR); u16* __restrict__ Sk = (u16*)(p.ws + O_SK); u16* __restrict__ Sv = (u16*)(p.ws + O_SV);
  float* __restrict__ rn = (float*)(p.ws + O_RN); float* __restrict__ bonus = (float*)(p.ws + O_BONUS);
  u16* __restrict__ L = (u16*)((char*)p.out + DO_L);
  const float* __restrict__ mup = p.in[I_MUP]; const float* __restrict__ mun = p.in[I_MUN];
  const int lane = LTID & 63, wv = LTID >> 6;
  const int h = lane >> 3, c = h * 64 + (lane & 7) * 8;
  float kkw[8], rkw[8];
  load8f(p.in[I_KK] + c, kkw); load8f(p.in[I_RK] + c, rkw);
#pragma unroll 2
  for (int m = VBID * 4 + wv; m < NTOK; m += VGRID * 4) {
    const bool hp = has_prev(m), hn = has_next(m);
    const u16* row = P + (size_t)m * PW;
    float r[8], k[8], v[8];
    shifted8(row, c, hp, hn, mup, mun, r);
    shifted8(row, 512 + c, hp, hn, mup, mun, k);
    shifted8(row, 1024 + c, hp, hn, mup, mun, v);
    *(u32x4*)(Sr + (size_t)m * 512 + c) = pack8(r);
    *(u32x4*)(Sk + (size_t)m * 512 + c) = pack8(k);
    *(u32x4*)(Sv + (size_t)m * 512 + c) = pack8(v);
    float s1 = 0.f, s2 = 0.f;
#pragma unroll
    for (int i = 0; i < 8; ++i) { float kk = k[i] * kkw[i]; s1 += kk * kk; s2 += r[i] * k[i] * rkw[i]; }
    s1 = red8(s1); s2 = red8(s2);
    if ((lane & 7) == 0) {
      rn[m * 8 + h] = 1.f / fmaxf(sqrtf(s1), 1e-12f);
      bonus[m * 8 + h] = s2;
    }
    if (lane < 48) {
      float o[8];
      shifted8(row, 1536 + lane * 8, hp, hn, mup, mun, o);
      const int g = lane >> 3;
#pragma unroll
      for (int i = 0; i < 8; ++i) o[i] = g < 2 ? tanhf_(o[i]) : (g < 4 ? o[i] : sigmoidf_(o[i]));
      *(u32x4*)(L + (size_t)m * 384 + lane * 8) = pack8(o);
    }
  }
}

__device__ __forceinline__ void transpose_item(const float* __restrict__ src, u16* __restrict__ dst, int K, int N, int idx) {
  const int n = idx % N, kb = idx / N;
  const float* sp = src + (size_t)kb * 8 * N + n;
  float v[8];
#pragma unroll
  for (int i = 0; i < 8; ++i) v[i] = sp[(size_t)i * N];
  u32x4 o = {pack2(v[0], v[1]), pack2(v[2], v[3]), pack2(v[4], v[5]), pack2(v[6], v[7])};
  *(u32x4*)(dst + (size_t)n * K + kb * 8) = o;
}
#define LATE_ITEMS 3342336
__device__ __forceinline__ void late_weight_item(const Params& p, int idx) {
  u16* W = (u16*)p.ws;
  if (idx < 131072) { transpose_item(p.in[I_EVOUT], W + W_EVOUT, 1024, 1024, idx); return; }
  idx -= 131072;
  if (idx < 720896) { transpose_item(p.in[I_FUP], W + W_UP0, 1024, 5632, idx); return; }
  idx -= 720896;
  if (idx < 720896) { transpose_item(p.in[I_FUP] + 1024ull * 5632, W + W_UP1, 1024, 5632, idx); return; }
  idx -= 720896;
  if (idx < 360448) { transpose_item(p.in[I_FDN], W + W_DN0, 2816, 1024, idx); return; }
  idx -= 360448;
  if (idx < 360448) { transpose_item(p.in[I_FDN] + 2816ull * 1024, W + W_DN1, 2816, 1024, idx); return; }
  idx -= 360448;
  if (idx < 786432) { transpose_item(p.in[I_RIN], W + W_RIN, 1024, 6144, idx); return; }
  idx -= 786432;
  if (idx < 262144) { transpose_item(p.in[I_ROUT], W + W_ROUT, 2048, 1024, idx); return; }
}

using f32x2 = __attribute__((ext_vector_type(2))) float;
__device__ __forceinline__ void phase_rwkv(const Params& p, char* smem) {
  const u16* Sr = (const u16*)(p.ws + O_SR); const u16* Sk = (const u16*)(p.ws + O_SK); const u16* Sv = (const u16*)(p.ws + O_SV);
  const float* rn = (const float*)(p.ws + O_RN);
  u16* P = (u16*)(p.ws + O_P);
  constexpr int CH = 32;
  constexpr int NCH = 8448 / CH;
  float* buf = (float*)smem;
  float* vbuf = buf + 2 * 5 * CH * 64;
  const int tid = opaque_tid(), lane = tid & 63, wave = tid >> 6;
  const bool producer = tid >= 256;
  const int pt = tid & 255;
  const int ch = pt & 63, st0 = pt >> 6;
  const int rg = lane >> 4, ls = lane & 15;
  const int r0 = (wave & 3) * 8 + rg * 2;
  for (int vb = blockIdx.x; vb < 256; vb += gridDim.x) {
    const int seq = (vb & 7) * 16 + (vb >> 4), hh = (vb >> 3) & 1;
    const int dir = seq >> 6, b = (seq >> 3) & 7, h = seq & 7;
    const u16* Se = (const u16*)(p.ws + (dir ? O_SEB : O_SEF));
    const u16* Si = (const u16*)(p.ws + (dir ? O_SIB : O_SIF));
    const float kkc = p.in[I_KK][h * 64 + ch], kac = p.in[I_KA][h * 64 + ch];
    f32x2 s00 = {0.f, 0.f}, s01 = {0.f, 0.f}, s10 = {0.f, 0.f}, s11 = {0.f, 0.f};
    u16 gr[CH / 4], gk[CH / 4], ge[CH / 4], gi[CH / 4]; float grn[CH / 4]; u16 gv[CH / 8];
    auto gload = [&](int c) {
#pragma unroll
      for (int i = 0; i < CH / 4; ++i) {
        int m = scan_tok(dir, b, c * CH + st0 + i * 4);
        size_t o = (size_t)m * 512 + h * 64 + ch;
        gr[i] = Sr[o]; gk[i] = Sk[o]; ge[i] = Se[o]; gi[i] = Si[o]; grn[i] = rn[m * 8 + h];
      }
#pragma unroll
      for (int i = 0; i < CH / 8; ++i) {
        int item = pt + i * 256;
        int mv = scan_tok(dir, b, c * CH + (item >> 5));
        gv[i] = Sv[(size_t)mv * 512 + h * 64 + hh * 32 + (item & 31)];
      }
    };
    auto sstore = [&](int bi) {
      float* B = buf + bi * (5 * CH * 64);
#pragma unroll
      for (int i = 0; i < CH / 4; ++i) {
        int st = st0 + i * 4;
        float r = bf2f(gr[i]), k = bf2f(gk[i]), e = bf2f(ge[i]), ic = bf2f(gi[i]);
        float kk = k * kkc * grn[i];
        B[(0 * CH + st) * 64 + ch] = -kk;
        B[(1 * CH + st) * 64 + ch] = kk * ic;
        B[(2 * CH + st) * 64 + ch] = k * (1.f + (ic - 1.f) * kac);
        B[(3 * CH + st) * 64 + ch] = __expf(-e);
        B[(4 * CH + st) * 64 + ch] = r;
      }
#pragma unroll
      for (int i = 0; i < CH / 8; ++i) vbuf[bi * (CH * 32) + pt + i * 256] = bf2f(gv[i]);
    };
    __syncthreads();
    if (producer) { gload(0); sstore(0); gload(1); }
    __syncthreads();
    for (int c = 0; c < NCH; ++c) {
      if (producer) {
        if (c + 1 < NCH) { sstore((c + 1) & 1); if (c + 2 < NCH) gload(c + 2); }
        {
          const int li = c * ((int)gridDim.x * 256) + blockIdx.x * 256 + pt;
          if (li < LATE_ITEMS && vb == (int)blockIdx.x) late_weight_item(p, li);
        }
      } else {
        const float* B = buf + (c & 1) * (5 * CH * 64);
        const float* VB = vbuf + (c & 1) * (CH * 32);
        f32x2 ykeep = {0.f, 0.f}, ykeep2 = {0.f, 0.f};
#pragma unroll
        for (int st = 0; st < CH; ++st) {
          f32x4 a = *(const f32x4*)(B + (0 * CH + st) * 64 + ls * 4);
          f32x4 bb = *(const f32x4*)(B + (1 * CH + st) * 64 + ls * 4);
          f32x4 kd = *(const f32x4*)(B + (2 * CH + st) * 64 + ls * 4);
          f32x4 w = *(const f32x4*)(B + (3 * CH + st) * 64 + ls * 4);
          f32x4 r = *(const f32x4*)(B + (4 * CH + st) * 64 + ls * 4);
          f32x2 vv = *(const f32x2*)(VB + st * 32 + r0);
          f32x2 alo = {a[0], a[1]}, ahi = {a[2], a[3]}, blo = {bb[0], bb[1]}, bhi = {bb[2], bb[3]};
          f32x2 klo = {kd[0], kd[1]}, khi = {kd[2], kd[3]}, wlo = {w[0], w[1]}, whi = {w[2], w[3]};
          f32x2 rlo = {r[0], r[1]}, rhi = {r[2], r[3]};
          f32x2 t0 = s00 * alo + s01 * ahi;
          f32x2 t1 = s10 * alo + s11 * ahi;
          float sa0 = red16(t0[0] + t0[1]);
          float sa1 = red16(t1[0] + t1[1]);
          f32x2 sa0v = {sa0, sa0}, sa1v = {sa1, sa1}, v0v = {vv[0], vv[0]}, v1v = {vv[1], vv[1]};
          s00 = s00 * wlo + sa0v * blo + v0v * klo;
          s01 = s01 * whi + sa0v * bhi + v0v * khi;
          s10 = s10 * wlo + sa1v * blo + v1v * klo;
          s11 = s11 * whi + sa1v * bhi + v1v * khi;
          f32x2 u0 = s00 * rlo + s01 * rhi;
          f32x2 u1 = s10 * rlo + s11 * rhi;
          float y0 = red16(u0[0] + u0[1]);
          float y1 = red16(u1[0] + u1[1]);
          if (st < 16) { ykeep[0] = (ls == st) ? y0 : ykeep[0]; ykeep[1] = (ls == st) ? y1 : ykeep[1]; }
          else { ykeep2[0] = (ls == st - 16) ? y0 : ykeep2[0]; ykeep2[1] = (ls == st - 16) ? y1 : ykeep2[1]; }
        }
#pragma unroll
        for (int half_ = 0; half_ < 2; ++half_) {
          const int sidx = c * CH + half_ * 16 + ls;
          const int tt = sidx - 256;
          const int mctx = b * 256 + (dir ? 255 - sidx : sidx);
          const int mlat = NCTX + b * 8192 + (dir ? 8191 - tt : tt);
          const int m = sidx < 256 ? mctx : mlat;
          const f32x2 yk = half_ ? ykeep2 : ykeep;
          *(unsigned*)(P + (size_t)m * PW + dir * 512 + h * 64 + hh * 32 + r0) = pack2(yk[0], yk[1]);
        }
      }
      __syncthreads();
    }
  }
}

__device__ __forceinline__ float xbc_conv(const u16* P, int m, int cx, const float* cw, const float* cb, bool hp, bool hn) {
  const u16* q = P + (size_t)m * PW + 2432 + cx;
  float v = cb[cx] + cw[1024 + cx] * bf2f(q[0]);
  if (hp) v += cw[cx] * bf2f(q[-PW]);
  if (hn) v += cw[2048 + cx] * bf2f(q[PW]);
  return siluf_(v);
}

#define XLO(w) bf2f((u16)((w) & 0xffff))
#define XHI(w) bf2f((u16)((w) >> 16))
__device__ __forceinline__ void phase_xbc(const Params& p) {
  const int TT = opaque_tid();
  const u16* __restrict__ P = (const u16*)(p.ws + O_P);
  u16* __restrict__ X = (u16*)((char*)p.out + DO_HX);
  const float* __restrict__ cw = p.in[I_SCW]; const float* __restrict__ cb = p.in[I_SCB];
  const int total = NTOK * 128;
#pragma unroll 2
  for (int idx = VBID * 256 + LTID; idx < total; idx += VGRID * 256) {
    const int m = idx >> 7, c = (idx & 127) * 8;
    const u16* q = P + (size_t)m * PW + 2432 + c;
    const u32x4 z4 = {0u, 0u, 0u, 0u};
    const bool hp = has_prev(m), hn = has_next(m);
    u32x4 cur = *(const u32x4*)q;
    u32x4 prv = *(const u32x4*)(q - (hp ? PW : 0));
    u32x4 nxt = *(const u32x4*)(q + (hn ? PW : 0));
    prv = hp ? prv : z4; nxt = hn ? nxt : z4;
    float o[8];
#pragma unroll
    for (int e = 0; e < 4; ++e) {
      int c0 = c + 2 * e, c1 = c0 + 1;
      float v0 = cb[c0] + cw[c0] * XLO(prv[e]) + cw[1024 + c0] * XLO(cur[e]) + cw[2048 + c0] * XLO(nxt[e]);
      float v1 = cb[c1] + cw[c1] * XHI(prv[e]) + cw[1024 + c1] * XHI(cur[e]) + cw[2048 + c1] * XHI(nxt[e]);
      o[2 * e] = siluf_(v0); o[2 * e + 1] = siluf_(v1);
    }
    u32x4 ov = {pack2(o[0], o[1]), pack2(o[2], o[3]), pack2(o[4], o[5]), pack2(o[6], o[7])};
    *(u32x4*)(X + (size_t)m * 1024 + c) = ov;
  }
}

__device__ __forceinline__ void phase_ssd_prep(const Params& p) {
  const int TT = opaque_tid();
  const u16* __restrict__ P = (const u16*)(p.ws + O_P);
  float* __restrict__ dtb = (float*)(p.ws + O_DT); float* __restrict__ csb = (float*)(p.ws + O_CS);
  for (int idx = VBID * 256 + LTID; idx < 528 * 16; idx += VGRID * 256) {
    int cidx = idx >> 4, dir = (idx >> 3) & 1, h = idx & 7;
    float bias = dir ? p.in[I_DTBB][h] : p.in[I_DTBF][h];
    float A = -expf(dir ? p.in[I_ALB][h] : p.in[I_ALF][h]);
    float cs = 0.f;
#pragma unroll 16
    for (int i = 0; i < 128; ++i) {
      int l = dir ? 127 - i : i;
      int m = cidx * 128 + l;
      float dtr = bf2f(P[(size_t)m * PW + 3456 + dir * 8 + h]);
      float dt = softplusf_(dtr + bias);
      cs += dt * A;
      dtb[((size_t)dir * NTOK + m) * 8 + h] = dt;
      csb[((size_t)dir * NTOK + m) * 8 + h] = cs;
    }
  }
}

__device__ __forceinline__ void phase_ssd_states(const Params& p, char* smem) {
  const int TT = opaque_tid();
  const u16* P = (const u16*)(p.ws + O_P);
  const float* dtb = (const float*)(p.ws + O_DT); const float* csb = (const float*)(p.ws + O_CS);
  float* states = (float*)(p.ws + O_STATES);
  const float* cw = p.in[I_SCW]; const float* cb = p.in[I_SCB];
  const u16* X = (const u16*)((const char*)p.out + DO_HX);
  u16* XTf = (u16*)smem; u16* XTb = XTf + 64 * 136; u16* BT = XTb + 64 * 136;
  float* wf = (float*)(BT + 128 * 136);
  const int tid = LTID, lane = tid & 63, wave = tid >> 6;
  for (int vb = VBID; vb < 528 * 8; vb += VGRID) {
    const int cidx = vb >> 3, h = vb & 7, g = h >> 2;
    const int mb = cidx * 128;
    __syncthreads();
    {
      int d = tid >> 7, l = tid & 127;
      float tot = csb[((size_t)d * NTOK + mb + (d ? 0 : 127)) * 8 + h];
      size_t o = ((size_t)d * NTOK + mb + l) * 8 + h;
      wf[d * 128 + l] = dtb[o] * __expf(tot - csb[o]);
    }
    __syncthreads();
#pragma unroll
    for (int i = 0; i < 2; ++i) {
      int item = tid + i * 256; int lp = item & 63, cg = item >> 6;
      int l0 = 2 * lp;
      const u16* xp = X + (size_t)(mb + l0) * 1024 + h * 64 + cg * 8;
      u32x4 x0 = *(const u32x4*)xp, x1 = *(const u32x4*)(xp + 1024);
      float f0 = wf[l0], f1 = wf[l0 + 1], b0 = wf[128 + l0], b1 = wf[128 + l0 + 1];
#pragma unroll
      for (int e = 0; e < 4; ++e) {
        float a0 = XLO(x0[e]), a1 = XLO(x1[e]), c0 = XHI(x0[e]), c1 = XHI(x1[e]);
        *(unsigned*)(XTf + (cg * 8 + 2 * e) * 136 + l0) = pack2(a0 * f0, a1 * f1);
        *(unsigned*)(XTf + (cg * 8 + 2 * e + 1) * 136 + l0) = pack2(c0 * f0, c1 * f1);
        *(unsigned*)(XTb + (cg * 8 + 2 * e) * 136 + l0) = pack2(a0 * b0, a1 * b1);
        *(unsigned*)(XTb + (cg * 8 + 2 * e + 1) * 136 + l0) = pack2(c0 * b0, c1 * b1);
      }
    }
#pragma unroll
    for (int i = 0; i < 4; ++i) {
      int item = tid + i * 256; int lp = item & 63, cg = item >> 6;
      int l0 = 2 * lp;
      const u16* xp = X + (size_t)(mb + l0) * 1024 + 512 + g * 128 + cg * 8;
      u32x4 x0 = *(const u32x4*)xp, x1 = *(const u32x4*)(xp + 1024);
#pragma unroll
      for (int e = 0; e < 4; ++e) {
        *(unsigned*)(BT + (cg * 8 + 2 * e) * 136 + l0) = (x0[e] & 0xffffu) | (x1[e] << 16);
        *(unsigned*)(BT + (cg * 8 + 2 * e + 1) * 136 + l0) = (x0[e] >> 16) | (x1[e] & 0xffff0000u);
      }
    }
    __syncthreads();
#pragma unroll
    for (int d = 0; d < 2; ++d) {
      const u16* XT = d ? XTb : XTf;
      f32x4 acc[4][2];
#pragma unroll
      for (int i = 0; i < 4; ++i) { acc[i][0] = (f32x4){0, 0, 0, 0}; acc[i][1] = (f32x4){0, 0, 0, 0}; }
#pragma unroll
      for (int kk = 0; kk < 128; kk += 32) {
        bf16x8 af[4], bfr[2];
#pragma unroll
        for (int i = 0; i < 4; ++i) af[i] = ldfrag(XT, 136, i * 16, kk, lane);
#pragma unroll
        for (int j = 0; j < 2; ++j) bfr[j] = ldfrag(BT, 136, wave * 32 + j * 16, kk, lane);
#pragma unroll
        for (int i = 0; i < 4; ++i)
#pragma unroll
          for (int j = 0; j < 2; ++j) acc[i][j] = mma(af[i], bfr[j], acc[i][j]);
      }
      float* so = states + (((size_t)d * 528 + cidx) * 8 + h) * 8192;
#pragma unroll
      for (int i = 0; i < 4; ++i)
#pragma unroll
        for (int j = 0; j < 2; ++j) {
          int pp = i * 16 + (lane & 15), n = wave * 32 + j * 16 + (lane >> 4) * 4;
          *(float4*)(so + pp * 128 + n) = make_float4(acc[i][j][0], acc[i][j][1], acc[i][j][2], acc[i][j][3]);
        }
    }
  }
}

__device__ __forceinline__ int ssd_chunk_seq(int d, int b, int j) {
  if (j < 2) return 2 * b + (d ? 1 - j : j);
  int t = j - 2;
  return 16 + b * 64 + (d ? 63 - t : t);
}

__device__ __forceinline__ void phase_ssd_scan(const Params& p) {
  const int TT = opaque_tid();
  float* states = (float*)(p.ws + O_STATES);
  const float* csb = (const float*)(p.ws + O_CS);
  for (int idx = VBID * 256 + LTID; idx < 2 * 8 * 8 * 2048; idx += VGRID * 256) {
    const int q = idx & 2047, h = (idx >> 11) & 7, b = (idx >> 14) & 7, d = idx >> 17;
    auto sptr = [&](int j) -> f32x4* {
      int cidx = ssd_chunk_seq(d, b, j);
      return (f32x4*)(states + (((size_t)d * 528 + cidx) * 8 + h) * 8192) + q;
    };
    auto totof = [&](int j) -> float {
      int cidx = ssd_chunk_seq(d, b, j);
      return csb[((size_t)d * NTOK + cidx * 128 + (d ? 0 : 127)) * 8 + h];
    };
    f32x4 hh = {0.f, 0.f, 0.f, 0.f};
    f32x4 sv[4]; float tv[4];
#pragma unroll
    for (int u = 0; u < 4; ++u) { sv[u] = *sptr(u); tv[u] = totof(u); }
#pragma unroll 1
    for (int j0 = 0; j0 < 64; j0 += 4) {
      f32x4 sn[4]; float tn[4];
#pragma unroll
      for (int u = 0; u < 4; ++u) {
        const int jn = j0 + 4 + u;
        const int jc = jn < 66 ? jn : 65;
        sn[u] = *sptr(jc); tn[u] = totof(jc);
      }
#pragma unroll
      for (int u = 0; u < 4; ++u) {
        *sptr(j0 + u) = hh;
        hh = hh * __expf(tv[u]) + sv[u];
      }
#pragma unroll
      for (int u = 0; u < 4; ++u) { sv[u] = sn[u]; tv[u] = tn[u]; }
    }
#pragma unroll
    for (int u = 0; u < 2; ++u) {
      *sptr(64 + u) = hh;
      hh = hh * __expf(tv[u]) + sv[u];
    }
  }
}

__device__ __forceinline__ void phase_ssd_out(const Params& p, char* smem) {
  const int TT = opaque_tid();
  u16* P = (u16*)(p.ws + O_P);
  const float* dtb = (const float*)(p.ws + O_DT); const float* csb = (const float*)(p.ws + O_CS);
  const float* states = (const float*)(p.ws + O_STATES);
  const float* cw = p.in[I_SCW]; const float* cb = p.in[I_SCB];
  const u16* X = (const u16*)((const char*)p.out + DO_HX);
  u16* Cs = (u16*)smem;
  u16* Bs = Cs + 64 * 136;
  u16* Gs = Bs; u16* Hs = Bs + 64 * 136;
  u16* XT = Bs + 128 * 136;
  float* csf = (float*)(XT + 64 * 136);
  float* csbk = csf + 128; float* dtf = csbk + 128; float* dtbk = dtf + 128;
  const int tid = LTID, lane = tid & 63, wave = tid >> 6;
  for (int vb = VBID; vb < 528 * 16; vb += VGRID) {
    const int lh = vb & 1, h = (vb >> 1) & 7, cidx = vb >> 4, g = h >> 2;
    const int mb = cidx * 128;
    f32x4 hv[2][8];
#pragma unroll
    for (int d = 0; d < 2; ++d) {
      const float* hp = states + (((size_t)d * 528 + cidx) * 8 + h) * 8192;
#pragma unroll
      for (int i = 0; i < 8; ++i) { int item = tid + i * 256; hv[d][i] = *(const f32x4*)(hp + (item >> 5) * 128 + (item & 31) * 4); }
    }
    __syncthreads();
    if (tid < 128) {
      size_t o0 = ((size_t)0 * NTOK + mb + tid) * 8 + h, o1 = ((size_t)1 * NTOK + mb + tid) * 8 + h;
      csf[tid] = csb[o0]; csbk[tid] = csb[o1]; dtf[tid] = dtb[o0]; dtbk[tid] = dtb[o1];
    }
#pragma unroll
    for (int i = 0; i < 4; ++i) {
      int item = tid + i * 256; int cg = item & 15, l = item >> 4;
      *(u32x4*)(Cs + l * 136 + cg * 8) = *(const u32x4*)(X + (size_t)(mb + lh * 64 + l) * 1024 + 768 + g * 128 + cg * 8);
    }
#pragma unroll
    for (int i = 0; i < 8; ++i) {
      int item = tid + i * 256; int cg = item & 15, sidx = item >> 4;
      *(u32x4*)(Bs + sidx * 136 + cg * 8) = *(const u32x4*)(X + (size_t)(mb + sidx) * 1024 + 512 + g * 128 + cg * 8);
    }
#pragma unroll
    for (int i = 0; i < 2; ++i) {
      int item = tid + i * 256; int lp = item & 63, cg = item >> 6;
      int l0 = 2 * lp;
      const u16* xp = X + (size_t)(mb + l0) * 1024 + h * 64 + cg * 8;
      u32x4 x0 = *(const u32x4*)xp, x1 = *(const u32x4*)(xp + 1024);
#pragma unroll
      for (int e = 0; e < 4; ++e) {
        *(unsigned*)(XT + (cg * 8 + 2 * e) * 136 + l0) = (x0[e] & 0xffffu) | (x1[e] << 16);
        *(unsigned*)(XT + (cg * 8 + 2 * e + 1) * 136 + l0) = (x0[e] >> 16) | (x1[e] & 0xffff0000u);
      }
    }
    __syncthreads();
    f32x4 cbacc[8];
#pragma unroll
    for (int t = 0; t < 8; ++t) cbacc[t] = (f32x4){0, 0, 0, 0};
#pragma unroll 1
    for (int kk = 0; kk < 128; kk += 32) {
      bf16x8 af = ldfrag(Cs, 136, wave * 16, kk, lane);
#pragma unroll
      for (int t = 0; t < 8; ++t) cbacc[t] = mma(af, ldfrag(Bs, 136, t * 16, kk, lane), cbacc[t]);
    }
    __syncthreads();
    const int lloc = wave * 16 + (lane & 15);
    const int l = lh * 64 + lloc;
    const float cfl = csf[l], cbl = csbk[l];
#pragma unroll 2
    for (int t = 0; t < 8; ++t) {
      float gv[4];
#pragma unroll
      for (int j = 0; j < 4; ++j) {
        int s = t * 16 + (lane >> 4) * 4 + j;
        float f = 0.f;
        if (s <= l) f += __expf(cfl - csf[s]) * dtf[s];
        if (s >= l) f += __expf(cbl - csbk[s]) * dtbk[s];
        gv[j] = cbacc[t][j] * f;
      }
      *(uint2*)(Gs + lloc * 136 + t * 16 + (lane >> 4) * 4) = pack4(gv[0], gv[1], gv[2], gv[3]);
    }
    __syncthreads();
    f32x4 yacc[4];
#pragma unroll
    for (int t = 0; t < 4; ++t) yacc[t] = (f32x4){0, 0, 0, 0};
#pragma unroll 1
    for (int kk = 0; kk < 128; kk += 32) {
      bf16x8 af = ldfrag(Gs, 136, wave * 16, kk, lane);
#pragma unroll
      for (int t = 0; t < 4; ++t) yacc[t] = mma(af, ldfrag(XT, 136, t * 16, kk, lane), yacc[t]);
    }
#pragma unroll
    for (int d = 0; d < 2; ++d) {
      __syncthreads();
#pragma unroll
      for (int i = 0; i < 8; ++i) {
        int item = tid + i * 256;
        int pp = item >> 5, n4 = (item & 31) * 4;
        *(uint2*)(Hs + pp * 136 + n4) = pack4(hv[d][i][0], hv[d][i][1], hv[d][i][2], hv[d][i][3]);
      }
      __syncthreads();
      f32x4 ia[4];
#pragma unroll
      for (int t = 0; t < 4; ++t) ia[t] = (f32x4){0, 0, 0, 0};
#pragma unroll 1
      for (int kk = 0; kk < 128; kk += 32) {
        bf16x8 af = ldfrag(Cs, 136, wave * 16, kk, lane);
#pragma unroll
        for (int t = 0; t < 4; ++t) ia[t] = mma(af, ldfrag(Hs, 136, t * 16, kk, lane), ia[t]);
      }
      float sc = __expf(d ? cbl : cfl);
#pragma unroll
      for (int t = 0; t < 4; ++t)
#pragma unroll
        for (int j = 0; j < 4; ++j) yacc[t][j] += sc * ia[t][j];
    }
    const float Dh = p.in[I_SD][h];
    const int m = mb + l;
#pragma unroll
    for (int t = 0; t < 4; ++t) {
      int p0 = t * 16 + (lane >> 4) * 4;
      float o[4];
#pragma unroll
      for (int j = 0; j < 4; ++j) o[j] = yacc[t][j] + Dh * bf2f(XT[(p0 + j) * 136 + l]);
      *(uint2*)(P + (size_t)m * PW + 1024 + h * 64 + p0) = pack4(o[0], o[1], o[2], o[3]);
    }
  }
}

__device__ __forceinline__ void phase_finish(const Params& p) {
  const int TT = opaque_tid();
  const u16* __restrict__ P = (const u16*)(p.ws + O_P);
  const u16* __restrict__ Sv = (const u16*)(p.ws + O_SV);
  const u16* __restrict__ G = (const u16*)((const char*)p.out + DO_G);
  const float* __restrict__ bonus = (const float*)(p.ws + O_BONUS);
  u16* __restrict__ mixed = (u16*)(p.ws + O_MIXED);
  const int lane = LTID & 63, wv = LTID >> 6;
  const int h = lane >> 3, c = h * 64 + (lane & 7) * 8;
  float lnw[8], lnb[8], nw[8];
  load8f(p.in[I_LNW] + c, lnw); load8f(p.in[I_LNB] + c, lnb); load8f(p.in[I_SNW] + c, nw);
#pragma unroll 2
  for (int m = VBID * 4 + wv; m < NTOK; m += VGRID * 4) {
    const u16* row = P + (size_t)m * PW;
    float yf[8], yb[8], sv[8], gg[8], ys[8], z[8];
    unpack8(*(const u32x4*)(row + c), yf);
    unpack8(*(const u32x4*)(row + 512 + c), yb);
    unpack8(*(const u32x4*)(Sv + (size_t)m * 512 + c), sv);
    unpack8(*(const u32x4*)(G + (size_t)m * 512 + c), gg);
    unpack8(*(const u32x4*)(row + 1024 + c), ys);
    unpack8(*(const u32x4*)(row + 1920 + c), z);
    const float bn = bonus[m * 8 + h];
    float sum = 0.f;
#pragma unroll
    for (int i = 0; i < 8; ++i) { yf[i] += yb[i]; sum += yf[i]; }
    const float mean = red8(sum) * (1.f / 64.f);
    float vs = 0.f;
#pragma unroll
    for (int i = 0; i < 8; ++i) { yf[i] -= mean; vs += yf[i] * yf[i]; }
    const float rs = rsqrtf(red8(vs) * (1.f / 64.f) + 64e-5f);
    float o1[8], t[8]; float ss = 0.f;
#pragma unroll
    for (int i = 0; i < 8; ++i) {
      o1[i] = (yf[i] * rs * lnw[i] + lnb[i] + bn * sv[i]) * gg[i];
      t[i] = ys[i] * siluf_(z[i]);
      ss += t[i] * t[i];
    }
    ss = wave_sum(ss);
    const float rstd = rsqrtf(ss * (1.f / 512.f) + 1e-6f);
#pragma unroll
    for (int i = 0; i < 8; ++i) t[i] = t[i] * rstd * nw[i];
    *(u32x4*)(mixed + (size_t)m * 1024 + c) = pack8(o1);
    *(u32x4*)(mixed + (size_t)m * 1024 + 512 + c) = pack8(t);
  }
}

__device__ __forceinline__ void phase_ffnconv(const Params& p, int layer, int r0) {
  const int TT = opaque_tid();
  u16* GV = (u16*)(p.ws + O_GV);
  const float* cw = p.in[I_FCW] + (size_t)layer * 9 * 2816;
  const float* cb = p.in[I_FCB] + (size_t)layer * 2816;
  const int gt = VBID * 256 + LTID;
  const int ngrp = (VGRID * 256) / 352;
  if (gt >= ngrp * 352) return;
  const int j = (gt % 352) * 8, tl = gt / 352;
  float w[9][8], bias[8];
#pragma unroll
  for (int k = 0; k < 9; ++k) load8f(cw + k * 2816 + j, w[k]);
  load8f(cb + j, bias);
  const u32x4 z4 = {0u, 0u, 0u, 0u};
#pragma unroll 1
  for (int m0 = r0 + tl; m0 < NTOK; m0 += 2 * ngrp) {
    u32x4 g[2][9]; u32x4 vq[2];
#pragma unroll
    for (int q = 0; q < 2; ++q) {
      const int m = (m0 + q * ngrp < NTOK) ? m0 + q * ngrp : m0;
      const bool isctx = m < NCTX;
      const int t = isctx ? (m & 255) : ((m - NCTX) & 8191);
      const int rr = t >> 6, cc = t & 63;
#pragma unroll
      for (int dy = -1; dy <= 1; ++dy)
#pragma unroll
        for (int dx = -1; dx <= 1; ++dx) {
          const int k = (dy + 1) * 3 + dx + 1;
          const bool valid = isctx ? (dy == 0 && t + dx >= 0 && t + dx < 256)
                                   : (rr + dy >= 0 && rr + dy < 128 && cc + dx >= 0 && cc + dx < 64);
          const int mm = valid ? m + dy * 64 + dx : m;
          u32x4 qv = *(const u32x4*)(GV + (size_t)mm * 5632 + j);
          g[q][k] = valid ? qv : z4;
        }
      vq[q] = *(const u32x4*)(GV + (size_t)m * 5632 + 2816 + j);
    }
    asm volatile("" ::: "memory");
#pragma unroll
    for (int q = 0; q < 2; ++q) {
      const int m = m0 + q * ngrp;
      if (m < NTOK) {
        float acc[8];
#pragma unroll
        for (int i = 0; i < 8; ++i) acc[i] = bias[i];
#pragma unroll
        for (int k = 0; k < 9; ++k)
#pragma unroll
          for (int e = 0; e < 4; ++e) {
            acc[2 * e] += w[k][2 * e] * XLO(g[q][k][e]);
            acc[2 * e + 1] += w[k][2 * e + 1] * XHI(g[q][k][e]);
          }
        float o[8];
#pragma unroll
        for (int e = 0; e < 4; ++e) {
          o[2 * e] = geluf_(acc[2 * e]) * XLO(vq[q][e]);
          o[2 * e + 1] = geluf_(acc[2 * e + 1]) * XHI(vq[q][e]);
        }
        *(u32x4*)(GV + (size_t)m * 5632 + 2816 + j) = pack8(o);
      }
    }
  }
}

__device__ __forceinline__ void phase_rope(const Params& p) {
  const int TT = opaque_tid();
  u16* QKV = (u16*)(p.ws + O_QKV);
  const float* rope = (const float*)(p.ws + O_ROPE);
  const int total = NLAT * 128;
  const int nthr = VGRID * 256;
  for (int idx0 = VBID * 256 + LTID; idx0 < total; idx0 += nthr * 4) {
    u32x4 a[4], bq[4];
#pragma unroll
    for (int u = 0; u < 4; ++u) {
      const int idx = idx0 + u * nthr;
      if (idx >= total) continue;
      const int t = idx >> 7, r = idx & 127;
      const int jg = r & 7, hh = (r >> 3) & 7, qk = r >> 6;
      const u16* base = QKV + (size_t)(NCTX + t) * 4096 + qk * 1024 + hh * 128 + jg * 8;
      a[u] = *(const u32x4*)base; bq[u] = *(const u32x4*)(base + 64);
    }
    asm volatile("" ::: "memory");
#pragma unroll
    for (int u = 0; u < 4; ++u) {
      const int idx = idx0 + u * nthr;
      if (idx >= total) continue;
      const int t = idx >> 7, r = idx & 127;
      const int jg = r & 7, hh = (r >> 3) & 7, qk = r >> 6;
      const int pos = t & 8191, prow = pos >> 6, pcol = pos & 63;
      const int j = jg * 8;
      u16* base = QKV + (size_t)(NCTX + t) * 4096 + qk * 1024 + hh * 128 + j;
      float x1[8], x2[8], o1[8], o2[8];
      unpack8(a[u], x1); unpack8(bq[u], x2);
      const float* ct = j < 32 ? rope + prow * 32 + j : rope + 8192 + pcol * 32 + j - 32;
      const float* stb = j < 32 ? rope + 4096 + prow * 32 + j : rope + 8192 + 2048 + pcol * 32 + j - 32;
      float cs[8], sn[8];
      load8f(ct, cs); load8f(stb, sn);
#pragma unroll
      for (int i = 0; i < 8; ++i) { o1[i] = x1[i] * cs[i] - x2[i] * sn[i]; o2[i] = x2[i] * cs[i] + x1[i] * sn[i]; }
      *(u32x4*)base = pack8(o1);
      *(u32x4*)(base + 64) = pack8(o2);
    }
  }
}

typedef short s16x4 __attribute__((ext_vector_type(4)));
__device__ __forceinline__ bf16x8 ldfrag_tr(const u16* X, int stride, int row0, int k0, int lane) {
  const int li = lane & 15, g = lane >> 4;
  const u16* pp = X + (k0 + g * 8 + (li >> 2)) * stride + row0 + (li & 3) * 4;
  const s16x4 lo = __builtin_amdgcn_ds_read_tr16_b64_v4i16((__attribute__((address_space(3))) s16x4*)pp);
  const s16x4 hi = __builtin_amdgcn_ds_read_tr16_b64_v4i16((__attribute__((address_space(3))) s16x4*)(pp + 4 * stride));
  return (bf16x8){lo[0], lo[1], lo[2], lo[3], hi[0], hi[1], hi[2], hi[3]};
}
__device__ __forceinline__ bf16x8 ldfrag_tr_acc(const u16* X, int stride, int row0, int k0, int lane) {
  const int li = lane & 15, g = lane >> 4;
  const u16* pp = X + (k0 + g * 4 + (li >> 2)) * stride + row0 + (li & 3) * 4;
  const s16x4 lo = __builtin_amdgcn_ds_read_tr16_b64_v4i16((__attribute__((address_space(3))) s16x4*)pp);
  const s16x4 hi = __builtin_amdgcn_ds_read_tr16_b64_v4i16((__attribute__((address_space(3))) s16x4*)(pp + 16 * stride));
  return (bf16x8){lo[0], lo[1], lo[2], lo[3], hi[0], hi[1], hi[2], hi[3]};
}
__device__ __forceinline__ void phase_retention(const Params& p, char* smem) {
  const u16* QKV = (const u16*)(p.ws + O_QKV);
  u16* Y = (u16*)(p.ws + O_Y);
  u16* Qs = (u16*)smem;
  u16* Ks = Qs + 64 * 136;
  u16* Vs = Ks + 64 * 136;
  u16* Vs2 = Vs + 64 * 72;
  u16* Sb = Vs2 + 64 * 72;
  u16* Pm = Sb + 64 * 136;
  const int tid = opaque_tid(), lane = tid & 63, wave = tid >> 6;
  const int quad = lane >> 4, l16 = lane & 15;
  const int rt = wave & 3, chf = wave >> 2;
  for (int vb = blockIdx.x; vb < 256; vb += gridDim.x) {
    const int xq_ = vb >> 3, bh_ = (vb & 7) * 8 + (xq_ >> 2);
    const int b = bh_ >> 3, h = bh_ & 7, sl = xq_ & 3;
#pragma unroll 1
    for (int d = 0; d < 2; ++d) {
      const float l2 = d ? p.in[I_L2B][h] : p.in[I_L2F][h];
      const float lg = log1pf(-exp2f(-l2));
      const float gC = __expf(lg * 64.f);
      f32x4 st[4];
#pragma unroll
      for (int t = 0; t < 4; ++t) st[t] = (f32x4){0, 0, 0, 0};
      u32x4 rqA[2], rkA[2], rvA, rqB[2], rkB[2], rvB;
      auto chunk_m0 = [&](int cs_) { return d ? scan_tok(1, b, cs_ * 64 + 63) : scan_tok(0, b, cs_ * 64); };
      auto gload = [&](int cs_, u32x4 (&rq)[2], u32x4 (&rk)[2], u32x4& rv) {
        int m0 = chunk_m0(cs_);
#pragma unroll
        for (int i = 0; i < 2; ++i) {
          int item = tid + i * 512; int row = item & 63, c8 = (item >> 6) * 8;
          const u16* bp = QKV + (size_t)(m0 + row) * 4096 + h * 128 + c8;
          rq[i] = *(const u32x4*)bp;
          rk[i] = *(const u32x4*)(bp + 1024);
        }
        {
          int row = tid & 63, c8 = (tid >> 6) * 8;
          rv = *(const u32x4*)(QKV + (size_t)(m0 + row) * 4096 + 2048 + h * 256 + sl * 64 + c8);
        }
      };
      auto sstore = [&](const u32x4 (&rq)[2], const u32x4 (&rk)[2], const u32x4& rv) {
#pragma unroll
        for (int i = 0; i < 2; ++i) {
          int item = tid + i * 512; int row = item & 63, c8 = (item >> 6) * 8;
          *(u32x4*)(Qs + row * 136 + c8) = rq[i];
          *(u32x4*)(Ks + row * 136 + c8) = rk[i];
        }
        {
          int row = tid & 63, c8 = (tid >> 6) * 8;
          const float ke = __expf(lg * (float)(d ? row : 63 - row));
          *(u32x4*)(Vs + row * 72 + c8) = rv;
          u32x4 sv_;
#pragma unroll
          for (int e = 0; e < 4; ++e) sv_[e] = pack2(bf2f((u16)(rv[e] & 0xffff)) * ke, bf2f((u16)(rv[e] >> 16)) * ke);
          *(u32x4*)(Vs2 + row * 72 + c8) = sv_;
        }
#pragma unroll
        for (int t = 0; t < 4; ++t)
          *(uint2*)(Sb + (rt * 16 + l16) * 136 + (4 * chf + t) * 16 + quad * 4) = pack4(st[t][0], st[t][1], st[t][2], st[t][3]);
      };
      gload(0, rqA, rkA, rvA);
      gload(1, rqB, rkB, rvB);
      auto body = [&](int cs_, u32x4 (&rq)[2], u32x4 (&rk)[2], u32x4& rv) {
        const int m0 = chunk_m0(cs_);
        __syncthreads();
        sstore(rq, rk, rv);
        __syncthreads();
        u16* const ypb = Y + (size_t)(m0 + rt * 16 + l16 - NCTX) * 2048 + h * 256 + sl * 64 + quad * 4;
        uint2 yprev[2] = {make_uint2(0u, 0u), make_uint2(0u, 0u)};
        if (d && m0 >= NCTX) {
#pragma unroll
          for (int t = 0; t < 2; ++t) yprev[t] = *(const uint2*)(ypb + (2 * chf + t) * 16);
        }
        if (cs_ + 2 < 132) gload(cs_ + 2, rq, rk, rv);
        f32x4 sc[4];
#pragma unroll
        for (int t = 0; t < 4; ++t) sc[t] = (f32x4){0, 0, 0, 0};
#pragma unroll
        for (int kk = 0; kk < 128; kk += 32) {
          bf16x8 af = ldfrag(Qs, 136, rt * 16, kk, lane);
#pragma unroll
          for (int t = 0; t < 4; ++t) sc[t] = mma(af, ldfrag(Ks, 136, t * 16, kk, lane), sc[t]);
        }
        const int l = rt * 16 + l16;
        unsigned pk[4][2];
#pragma unroll
        for (int t = 0; t < 4; ++t) {
          float pv[4];
#pragma unroll
          for (int j = 0; j < 4; ++j) {
            int s_ = t * 16 + quad * 4 + j;
            int dist = d ? s_ - l : l - s_;
            pv[j] = dist >= 0 ? sc[t][j] * __expf(lg * (float)dist) : 0.f;
          }
          pk[t][0] = pack2(pv[0], pv[1]); pk[t][1] = pack2(pv[2], pv[3]);
        }
        f32x4 ya[2], yi[2];
#pragma unroll
        for (int t = 0; t < 2; ++t) { ya[t] = (f32x4){0, 0, 0, 0}; yi[t] = (f32x4){0, 0, 0, 0}; }
#pragma unroll
        for (int ks = 0; ks < 2; ++ks) {
          const u32x4 pw = {pk[2 * ks][0], pk[2 * ks][1], pk[2 * ks + 1][0], pk[2 * ks + 1][1]};
          bf16x8 af = __builtin_bit_cast(bf16x8, pw);
#pragma unroll
          for (int t = 0; t < 2; ++t) ya[t] = mma(af, ldfrag_tr_acc(Vs, 72, (2 * chf + t) * 16, ks * 32, lane), ya[t]);
        }
#pragma unroll
        for (int kk = 0; kk < 128; kk += 32) {
          bf16x8 af = ldfrag(Qs, 136, rt * 16, kk, lane);
#pragma unroll
          for (int t = 0; t < 2; ++t) yi[t] = mma(af, ldfrag(Sb, 136, (2 * chf + t) * 16, kk, lane), yi[t]);
        }
#pragma unroll
        for (int t = 0; t < 4; ++t) { st[t][0] *= gC; st[t][1] *= gC; st[t][2] *= gC; st[t][3] *= gC; }
#pragma unroll
        for (int kk = 0; kk < 64; kk += 32) {
          bf16x8 af = ldfrag_tr(Vs2, 72, rt * 16, kk, lane);
#pragma unroll
          for (int t = 0; t < 4; ++t) st[t] = mma(af, ldfrag_tr(Ks, 136, (4 * chf + t) * 16, kk, lane), st[t]);
        }
        if (m0 >= NCTX) {
          const float qd = __expf(lg * (float)(d ? 64 - l : l + 1));
          u16* yp = Y + (size_t)(m0 + l - NCTX) * 2048 + h * 256 + sl * 64 + quad * 4;
#pragma unroll
          for (int t = 0; t < 2; ++t) {
            float o[4];
#pragma unroll
            for (int j = 0; j < 4; ++j) o[j] = ya[t][j] + qd * yi[t][j];
            u16* yq = yp + (2 * chf + t) * 16;
            if (d) {
              const uint2 prev = yprev[t];
              o[0] += bf2f((u16)(prev.x & 0xffff)); o[1] += bf2f((u16)(prev.x >> 16));
              o[2] += bf2f((u16)(prev.y & 0xffff)); o[3] += bf2f((u16)(prev.y >> 16));
            }
            *(uint2*)yq = pack4(o[0], o[1], o[2], o[3]);
          }
        }
      };
#pragma unroll 1
      for (int cs_ = 0; cs_ < 132; cs_ += 2) {
        body(cs_, rqA, rkA, rvA);
        body(cs_ + 1, rqB, rkB, rvB);
      }
    }
  }
}

__device__ __forceinline__ void phase_ynorm(const Params& p) {
  const int TT = opaque_tid();
  const u16* __restrict__ Y = (const u16*)(p.ws + O_Y);
  float* __restrict__ rstd = (float*)(p.ws + O_RSTD);
  const int lane = LTID & 63, wv = LTID >> 6;
#pragma unroll 2
  for (int m = VBID * 4 + wv; m < NLAT; m += VGRID * 4) {
#pragma unroll
    for (int h = 0; h < 8; ++h) {
      uint2 q = *(const uint2*)(Y + (size_t)m * 2048 + h * 256 + lane * 4);
      float a = bf2f((u16)(q.x & 0xffff)), b2 = bf2f((u16)(q.x >> 16)), c = bf2f((u16)(q.y & 0xffff)), d = bf2f((u16)(q.y >> 16));
      float ss = wave_sum(a * a + b2 * b2 + c * c + d * d);
      if (lane == 0) rstd[m * 8 + h] = rsqrtf(ss * (1.f / 256.f) + 1e-6f);
    }
  }
}

__device__ __forceinline__ void phase_final(const Params& p) {
  const int TT = opaque_tid();
  const float* g = p.in[I_FNG];
  const int lane = LTID & 63, wv = LTID >> 6;
  for (int m = (VBID * 4 + wv) * 2; m < NLAT; m += VGRID * 8) {
    float4 v[2][4]; float ss[2] = {0.f, 0.f};
#pragma unroll
    for (int q = 0; q < 2; ++q)
#pragma unroll
      for (int i = 0; i < 4; ++i) v[q][i] = *(const float4*)(p.out + (size_t)(m + q) * 1024 + i * 256 + lane * 4);
#pragma unroll
    for (int q = 0; q < 2; ++q) {
#pragma unroll
      for (int i = 0; i < 4; ++i) ss[q] += v[q][i].x * v[q][i].x + v[q][i].y * v[q][i].y + v[q][i].z * v[q][i].z + v[q][i].w * v[q][i].w;
      ss[q] = wave_sum(ss[q]);
    }
#pragma unroll
    for (int q = 0; q < 2; ++q) {
      const float rstd = rsqrtf(ss[q] * (1.f / 1024.f) + 1e-6f);
#pragma unroll
      for (int i = 0; i < 4; ++i) {
        int c = i * 256 + lane * 4;
        float4 gg = *(const float4*)(g + c);
        *(float4*)(p.out + (size_t)(m + q) * 1024 + c) = make_float4(v[q][i].x * rstd * gg.x, v[q][i].y * rstd * gg.y, v[q][i].z * rstd * gg.z, v[q][i].w * rstd * gg.w);
      }
    }
  }
}

#define XB_TMO      128
#define XB_XCNT(j)  (256  + 64 * (j))
#define XB_XSUB(j)  (1280 + 64 * (j))
#define XB_XGEN(j)  (2304 + 64 * (j))
#define XB_TOP      3328
#define XB_TOPGEN   3392
#define XCD_BAR_WORDS 3456
#define XB_SPIN_CAP (1u << 22)
#define LAS __attribute__((address_space(3)))
__device__ __forceinline__ unsigned xb_ld(unsigned* p)              { return __hip_atomic_load(p, __ATOMIC_RELAXED, __HIP_MEMORY_SCOPE_AGENT); }
__device__ __forceinline__ unsigned xb_add(unsigned* p, unsigned v) { return __hip_atomic_fetch_add(p, v, __ATOMIC_RELAXED, __HIP_MEMORY_SCOPE_AGENT); }
__device__ __forceinline__ unsigned xb_xcc_id() { return (unsigned)__builtin_amdgcn_s_getreg((3 << 11) | 20) & 0xFu; }
#define XB_SPIN(cond, bar) do { unsigned _sp = 0; while (cond) { __builtin_amdgcn_s_sleep(1); \
    if ((++_sp & 255u) == 0u) { if (xb_ld(&(bar)[XB_TMO])) break; if (_sp > XB_SPIN_CAP) { atomicAdd(&(bar)[XB_TMO], 1u); break; } } } } while (0)
struct XcdBarrier { unsigned* bar; unsigned x; volatile LAS unsigned* st; };
__device__ __forceinline__ XcdBarrier xcd_barrier_post(unsigned* bar, volatile LAS unsigned* st) {
  XcdBarrier b; b.bar = bar; b.x = xb_xcc_id(); b.st = st;
  if (threadIdx.x == 0) (void)xb_add(&bar[XB_XCNT(b.x)], 1u);
  return b;
}
__device__ __forceinline__ void xcd_barrier_complete(unsigned* bar, unsigned x, unsigned& nloc, unsigned& nx) {
  const unsigned G = gridDim.x * gridDim.y * gridDim.z;
  unsigned sum, cnt, mine, sp = 0u;
  for (;;) {
    sum = 0u; cnt = 0u; mine = 0u;
#pragma unroll
    for (unsigned j = 0; j < 16; ++j) { const unsigned c = xb_ld(&bar[XB_XCNT(j)]); sum += c; cnt += (c > 0u) ? 1u : 0u; mine = (j == x) ? c : mine; }
    if (sum == G) break;
    __builtin_amdgcn_s_sleep(1);
    if ((++sp & 255u) == 0u) { if (xb_ld(&bar[XB_TMO])) break; if (sp > XB_SPIN_CAP) { atomicAdd(&bar[XB_TMO], 1u); break; } }
  }
  nloc = mine > 0u ? mine : 1u; nx = cnt > 0u ? cnt : 1u;
}
__device__ __forceinline__ void xcd_barrier(const XcdBarrier& b) {
  asm volatile("s_waitcnt vmcnt(0)" ::: "memory");
  __syncthreads();
  if (threadIdx.x == 0) {
    unsigned* bar = b.bar;
    __builtin_amdgcn_s_waitcnt(0);
    unsigned nloc = b.st[0], nx = b.st[1];
    if (nloc == 0u) { xcd_barrier_complete(bar, b.x, nloc, nx); b.st[0] = nloc; b.st[1] = nx; }
    const unsigned old = xb_add(&bar[XB_XSUB(b.x)], 1u);
    const unsigned gen = old / nloc;
    if (old + 1u == (gen + 1u) * nloc) {
      __builtin_amdgcn_fence(__ATOMIC_RELEASE, "agent");
      asm volatile("s_waitcnt vmcnt(0)" ::: "memory");
      const unsigned og = xb_add(&bar[XB_TOP], 1u);
      const unsigned tg = og / nx;
      if (og + 1u == (tg + 1u) * nx) xb_add(&bar[XB_TOPGEN], 1u);
      else XB_SPIN(xb_ld(&bar[XB_TOPGEN]) == tg, bar);
      __builtin_amdgcn_fence(__ATOMIC_ACQUIRE, "agent");
      xb_add(&bar[XB_XGEN(b.x)], 1u);
      asm volatile("s_waitcnt vmcnt(0)" ::: "memory");
    } else {
      XB_SPIN(xb_ld(&bar[XB_XGEN(b.x)]) == gen, bar);
      __builtin_amdgcn_fence(__ATOMIC_ACQUIRE, "agent");
      asm volatile("s_waitcnt vmcnt(0)" ::: "memory");
    }
  }
  __syncthreads();
}

#ifndef PHMASK
#define PHMASK 0xFFFFFFFFFFFFFFFFull
#endif
#ifndef PHREP
#define PHREP 0ull
#endif
namespace pg8 {
#define PG8_LAS __attribute__((address_space(3)))
constexpr int BM = 256, BK = 64, HALF = 128, HTB = HALF * BK * 2, STAGE_BYTES = 8 * HTB, NXCD = 8, WGM = 4;
__device__ __forceinline__ int lds_byte(int r, int c) { const int st = (r >> 4) * 2 + (c >> 5), rr = r & 15, cc = c & 31, ob = rr * 64 + cc * 2; return st * 1024 + (ob ^ (((ob >> 9) & 1) << 5)); }
__device__ __forceinline__ void stage_rc(int b, int& R, int& C) { const int st = b / 1024, sb = b % 1024, swz = sb ^ (((sb >> 9) & 1) << 5); R = (st >> 1) * 16 + swz / 64; C = (st & 1) * 32 + (swz % 64) / 2; }
__device__ __forceinline__ int perm32(int rho) { const int n = rho >> 4, i = rho & 15; return 8 * (i >> 2) + 4 * n + (i & 3); }
struct Unit { int pm, pn; };
struct Gemm { const u16* A; const u16* Bt; int M, N, K, lda; };
struct StaticOrder {
  int nM, nN, nwg, G, c;
  __device__ void init(int M, int N, int G_, int c_) { nM = M / BM; nN = N / BM; nwg = nM * nN; G = G_; c = c_; }
  __device__ bool next(int i, Unit& u) const {
    const long L = (long)i * G + c; if (L >= nwg) return false;
    int wgid = (int)L; { const int q = nwg / NXCD, r = nwg % NXCD, xcd = wgid % NXCD, off = wgid / NXCD; wgid = (xcd < r ? xcd * (q + 1) : r * (q + 1) + (xcd - r) * q) + off; }
    const int nig = WGM * nN, gid = wgid / nig, fm = gid * WGM, gsz = (nM - fm) < WGM ? (nM - fm) : WGM;
    u.pm = fm + ((wgid % nig) % gsz); u.pn = (wgid % nig) / gsz; return true;
  }
};
template <class Epi>
__device__ __forceinline__ void gemm_phase(PG8_LAS unsigned char* lds, const Gemm g, const StaticOrder& S, const Epi& E) {
  const int tid = opaque_tid(), wid = __builtin_amdgcn_readfirstlane(tid >> 6), lane = tid & 63, wr = wid >> 2, wc = wid & 3, fr = lane & 15, fq = lane >> 4;
  const int K = g.K, nt = K / BK;
  unsigned voffA[2], voffB[2];
#pragma unroll
  for (int i = 0; i < 2; ++i) { int R, C; stage_rc(tid * 16 + i * 8192, R, C);
    const int Rb = Epi::PERM ? ((R & ~31) + perm32(R & 31)) : R;
    voffA[i] = (unsigned)(R * g.lda + C) * 2u; voffB[i] = (unsigned)(Rb * K + C) * 2u; }
  const size_t kstep = (size_t)(BK * 2);
  const size_t hstepA = (size_t)HALF * g.lda * 2, hstepB = (size_t)HALF * K * 2;
  const size_t tstepA = 2 * hstepA, tstepB = 2 * hstepB;
  const unsigned ldsw = (unsigned)wid * 1024u;
  const int aoff = lds_byte(wr * 64 + fr, fq * 8), boff = lds_byte(wc * 32 + fr, fq * 8);
#define PG8_SA(b, h) (((b) * 2 + (h)) * HTB)
#define PG8_SB(b, h) ((4 + (b) * 2 + (h)) * HTB)
#define PG8_STAGE(bufoff, gbase, voff) do { _Pragma("unroll") for (int _i = 0; _i < 2; ++_i) \
        __builtin_amdgcn_global_load_lds((const unsigned*)((const char*)(gbase) + (voff)[_i]), (PG8_LAS unsigned*)(lds + (bufoff) + ldsw + _i * 8192), 16, 0, 0); } while (0)
#define PG8_LDA(dst, b, h) do { _Pragma("unroll") for (int m = 0; m < 4; ++m) _Pragma("unroll") for (int k = 0; k < 2; ++k) dst[m][k] = *(const PG8_LAS bf16x8*)(lds + PG8_SA(b, h) + aoff + m * 2048 + k * 1024); } while (0)
#define PG8_LDB(dst, b, h) do { _Pragma("unroll") for (int n = 0; n < 2; ++n) _Pragma("unroll") for (int k = 0; k < 2; ++k) dst[n][k] = *(const PG8_LAS bf16x8*)(lds + PG8_SB(b, h) + boff + n * 2048 + k * 1024); } while (0)
#define PG8_MMA(ai, bj, At, Bt) do { __builtin_amdgcn_s_setprio(1); _Pragma("unroll") for (int m = 0; m < 4; ++m) _Pragma("unroll") for (int n = 0; n < 2; ++n) _Pragma("unroll") for (int k = 0; k < 2; ++k) \
        acc[ai][bj][m][n] = __builtin_amdgcn_mfma_f32_16x16x32_bf16(Bt[n][k], At[m][k], acc[ai][bj][m][n], 0, 0, 0); __builtin_amdgcn_s_setprio(0); } while (0)
#define PG8_WAIT_V(n) asm volatile("s_waitcnt vmcnt(" #n ")" ::: "memory")
#define PG8_WAIT_L(n) asm volatile("s_waitcnt lgkmcnt(" #n ")" ::: "memory")
#define PG8_BAR __builtin_amdgcn_s_barrier()
#define PG8_SCHED __builtin_amdgcn_sched_barrier(0)
  Unit cur, nxt; int ui = 0;
  if (!S.next(0, cur)) return;
  f32x4 acc[2][2][4][2];
#pragma unroll
  for (int a = 0; a < 2; ++a)
#pragma unroll
    for (int b = 0; b < 2; ++b)
#pragma unroll
      for (int m = 0; m < 4; ++m)
#pragma unroll
        for (int n = 0; n < 2; ++n) acc[a][b][m][n] = (f32x4){0.f, 0.f, 0.f, 0.f};
  bf16x8 At[4][2], B0[2][2], B1[2][2];
  const char* cA = (const char*)g.A + (size_t)cur.pm * tstepA; const char* cB = (const char*)g.Bt + (size_t)cur.pn * tstepB;
  PG8_STAGE(PG8_SB(0, 0), cB, voffB); PG8_STAGE(PG8_SA(0, 0), cA, voffA); PG8_STAGE(PG8_SB(0, 1), cB + hstepB, voffB); PG8_STAGE(PG8_SA(0, 1), cA + hstepA, voffA);
  if (wr == 1) PG8_BAR;
  PG8_WAIT_V(4); PG8_BAR;
  PG8_STAGE(PG8_SB(1, 0), cB + kstep, voffB); PG8_STAGE(PG8_SA(1, 0), cA + kstep, voffA); PG8_STAGE(PG8_SB(1, 1), cB + hstepB + kstep, voffB);
  PG8_WAIT_V(6); PG8_BAR;
  for (;;) {
    const bool has_next = S.next(ui + 1, nxt);
    const char* nA = has_next ? (const char*)g.A + (size_t)nxt.pm * tstepA : cA; const char* nB = has_next ? (const char*)g.Bt + (size_t)nxt.pn * tstepB : cB;
    for (int t = 0; t < nt; t += 2) {
      const bool last = (t == nt - 2);
      const char* a1 = cA + (size_t)(t + 1) * kstep;
      const char* a2 = last ? nA : cA + (size_t)(t + 2) * kstep; const char* b2 = last ? nB : cB + (size_t)(t + 2) * kstep;
      const char* a3 = a2 + kstep; const char* b3 = b2 + kstep;
      PG8_LDB(B0, 0, 0); PG8_SCHED; PG8_LDA(At, 0, 0); PG8_STAGE(PG8_SA(1, 1), a1 + hstepA, voffA);
      PG8_WAIT_L(8); PG8_BAR; PG8_WAIT_L(0); PG8_MMA(0, 0, At, B0); PG8_BAR; PG8_SCHED;
      PG8_LDB(B1, 0, 1); PG8_STAGE(PG8_SB(0, 0), b2, voffB);
      PG8_BAR; PG8_WAIT_L(0); PG8_MMA(0, 1, At, B1); PG8_BAR;
      PG8_LDA(At, 0, 1); PG8_STAGE(PG8_SA(0, 0), a2, voffA);
      PG8_BAR; PG8_WAIT_L(0); PG8_MMA(1, 0, At, B0); PG8_BAR; PG8_SCHED;
      PG8_STAGE(PG8_SB(0, 1), b2 + hstepB, voffB);
      PG8_WAIT_V(6); PG8_BAR; PG8_MMA(1, 1, At, B1); PG8_BAR;
      PG8_LDB(B0, 1, 0); PG8_SCHED; PG8_LDA(At, 1, 0); PG8_STAGE(PG8_SA(0, 1), a2 + hstepA, voffA);
      PG8_WAIT_L(8); PG8_BAR; PG8_WAIT_L(0); PG8_MMA(0, 0, At, B0); PG8_BAR; PG8_SCHED;
      PG8_LDB(B1, 1, 1); PG8_STAGE(PG8_SB(1, 0), b3, voffB);
      PG8_BAR; PG8_WAIT_L(0); PG8_MMA(0, 1, At, B1); PG8_BAR;
      PG8_LDA(At, 1, 1); PG8_STAGE(PG8_SA(1, 0), a3, voffA);
      PG8_BAR; PG8_WAIT_L(0); PG8_MMA(1, 0, At, B0); PG8_BAR; PG8_SCHED;
      PG8_STAGE(PG8_SB(1, 1), b3 + hstepB, voffB);
      PG8_WAIT_V(6); PG8_BAR; PG8_MMA(1, 1, At, B1); PG8_BAR;
    }
    E(acc, cur, wr, wc, fr, fq);
    if (!has_next) break;
#pragma unroll
    for (int a = 0; a < 2; ++a)
#pragma unroll
      for (int b = 0; b < 2; ++b)
#pragma unroll
        for (int m = 0; m < 4; ++m)
#pragma unroll
          for (int n = 0; n < 2; ++n) acc[a][b][m][n] = (f32x4){0.f, 0.f, 0.f, 0.f};
    cur = nxt; cA = nA; cB = nB; ++ui;
  }
  PG8_WAIT_V(0);
  if (wr == 0) PG8_BAR;
  PG8_BAR;
#undef PG8_SA
#undef PG8_SB
#undef PG8_STAGE
#undef PG8_LDA
#undef PG8_LDB
#undef PG8_MMA
#undef PG8_WAIT_V
#undef PG8_WAIT_L
#undef PG8_BAR
#undef PG8_SCHED
}
}

template <class Epi> struct PgEpi {
  static constexpr bool PERM = Epi::PERM;
  Epi e; int nreal;
  __device__ __forceinline__ void operator()(const f32x4 (&acc)[2][2][4][2], const pg8::Unit& u, int wr, int wc, int fr, int fq) const {
#pragma unroll
    for (int ai = 0; ai < 2; ++ai)
#pragma unroll
      for (int m = 0; m < 4; ++m) {
        const int row = u.pm * 256 + ai * 128 + wr * 64 + m * 16 + fr;
#pragma unroll
        for (int bj = 0; bj < 2; ++bj) {
          if constexpr (Epi::PERM) {
            const int col = u.pn * 256 + bj * 128 + wc * 32 + 8 * fq;
            if (col < nreal) e.store8(row, col, acc[ai][bj][m][0], acc[ai][bj][m][1]);
          } else {
#pragma unroll
            for (int n = 0; n < 2; ++n) {
              const int col = u.pn * 256 + bj * 128 + wc * 32 + n * 16 + 4 * fq;
              if (col < nreal) e(row, col, acc[ai][bj][m][n]);
            }
          }
        }
      }
  }
};
template <> struct PgEpi<EpiRes> {
  static constexpr bool PERM = false;
  EpiRes e; int nreal;
  __device__ __forceinline__ void operator()(const f32x4 (&acc)[2][2][4][2], const pg8::Unit& u, int wr, int wc, int fr, int fq) const {
    const int row0 = u.pm * 256 + e.moff;
    const int col0 = u.pn * 256 + wc * 32 + 4 * fq;
    const float* g = e.modv_l + (mod_row(row0) * 6 + e.gi) * 1024 + col0;
    f32x4 gv[2][2];
#pragma unroll
    for (int bj = 0; bj < 2; ++bj)
#pragma unroll
      for (int n = 0; n < 2; ++n) gv[bj][n] = *(const f32x4*)(g + bj * 128 + n * 16);
    const bool isctx = row0 < NCTX;
    const float* sb = isctx ? e.src_c + (size_t)row0 * 1024 : e.src_l + (size_t)(row0 - NCTX) * 1024;
    float* db = isctx ? e.dst_c + (size_t)row0 * 1024 : e.dst_l + (size_t)(row0 - NCTX) * 1024;
#pragma unroll
    for (int ai = 0; ai < 2; ++ai)
#pragma unroll
      for (int mp = 0; mp < 2; ++mp) {
        f32x4 x[2][2][2];
#pragma unroll
        for (int mi = 0; mi < 2; ++mi) {
          const size_t off = (size_t)(ai * 128 + wr * 64 + (mp * 2 + mi) * 16 + fr) * 1024 + col0;
#pragma unroll
          for (int bj = 0; bj < 2; ++bj)
#pragma unroll
            for (int n = 0; n < 2; ++n) x[mi][bj][n] = *(const f32x4*)(sb + off + bj * 128 + n * 16);
        }
        asm volatile("" ::: "memory");
#pragma unroll
        for (int mi = 0; mi < 2; ++mi) {
          const size_t off = (size_t)(ai * 128 + wr * 64 + (mp * 2 + mi) * 16 + fr) * 1024 + col0;
#pragma unroll
          for (int bj = 0; bj < 2; ++bj)
#pragma unroll
            for (int n = 0; n < 2; ++n) *(f32x4*)(db + off + bj * 128 + n * 16) = x[mi][bj][n] + gv[bj][n] * acc[ai][bj][mp * 2 + mi][n];
        }
        asm volatile("" ::: "memory");
      }
  }
};
template <> struct PgEpi<EpiGate> {
  static constexpr bool PERM = true;
  EpiGate e; int nreal;
  __device__ __forceinline__ void operator()(const f32x4 (&acc)[2][2][4][2], const pg8::Unit& u, int wr, int wc, int fr, int fq) const {
    const int col0 = u.pn * 256 + wc * 32 + 8 * fq;
    u32x4 yv[2][4][2]; float rs[2][4];
#pragma unroll
    for (int ai = 0; ai < 2; ++ai)
#pragma unroll
      for (int m = 0; m < 4; ++m) {
        const int row = u.pm * 256 + ai * 128 + wr * 64 + m * 16 + fr;
        rs[ai][m] = e.rstd[row * 8 + u.pn];
#pragma unroll
        for (int bj = 0; bj < 2; ++bj) yv[ai][m][bj] = *(const u32x4*)(e.Y + (size_t)row * 2048 + col0 + bj * 128);
      }
    asm volatile("" ::: "memory");
#pragma unroll
    for (int ai = 0; ai < 2; ++ai)
#pragma unroll
      for (int m = 0; m < 4; ++m) {
        const int row = u.pm * 256 + ai * 128 + wr * 64 + m * 16 + fr;
#pragma unroll
        for (int bj = 0; bj < 2; ++bj) {
          const f32x4 a = acc[ai][bj][m][0], b = acc[ai][bj][m][1];
          const float r = rs[ai][m];
          const u32x4 yy = yv[ai][m][bj];
          float o[8];
          o[0] = siluf_(a[0]) * XLO(yy[0]) * r; o[1] = siluf_(a[1]) * XHI(yy[0]) * r;
          o[2] = siluf_(a[2]) * XLO(yy[1]) * r; o[3] = siluf_(a[3]) * XHI(yy[1]) * r;
          o[4] = siluf_(b[0]) * XLO(yy[2]) * r; o[5] = siluf_(b[1]) * XHI(yy[2]) * r;
          o[6] = siluf_(b[2]) * XLO(yy[3]) * r; o[7] = siluf_(b[3]) * XHI(yy[3]) * r;
          *(u32x4*)(e.Y + (size_t)row * 2048 + col0 + bj * 128) = pack8(o);
        }
      }
  }
};
template <class Epi>
__device__ __forceinline__ void big_gemm(const u16* A, int lda, const u16* Bt, int M, int N, int K, Epi epi, char* smem) {
  const int npad = (N + 255) & ~255;
  pg8::StaticOrder S; S.init(M, npad, gridDim.x, blockIdx.x);
  pg8::Gemm g{A, Bt, M, npad, K, lda};
  PgEpi<Epi> E{epi, N};
  pg8::gemm_phase((PG8_LAS unsigned char*)smem, g, S, E);
  __syncthreads();
}

__global__ void __launch_bounds__(512, 2) mega(Params p) {
  extern __shared__ __attribute__((aligned(16))) char smem0[];
#define HSMEM (smem0 + (opaque_tid() >> 8) * HALF_LDS)
  cg::grid_group grid = cg::this_grid();
  volatile LAS unsigned* xst = (volatile LAS unsigned*)(smem0 + LDS_BYTES);
  if (threadIdx.x == 0) { xst[0] = 0u; xst[1] = 0u; }
  __syncthreads();
  XcdBarrier xb = xcd_barrier_post((unsigned*)(p.ws + O_BAR), xst);
  u16* W = (u16*)p.ws;
  float* modv = (float*)(p.ws + O_MODV);
  float* ctxr = (float*)(p.ws + O_CTXR);
  u16* hx0 = (u16*)((char*)p.out + DO_HX);
  u16* hx = (u16*)(p.ws + O_HX);

  for (int rep_ = 0; rep_ < (int)(((PHMASK >> 0) & 1ull) + ((PHREP >> 0) & 1ull)); ++rep_) {
  phase_prep(p, HSMEM);
  }
  grid.sync();
  for (int rep_ = 0; rep_ < (int)(((PHMASK >> 1) & 1ull) + ((PHREP >> 1) & 1ull)); ++rep_) {
  phase_norm(p.in[I_CTX], p.in[I_X], p.in[I_N1G], modv, 0, 1, hx0, 0, NTOK);
  }
  xcd_barrier(xb);
  for (int rep_ = 0; rep_ < (int)(((PHMASK >> 2) & 1ull) + ((PHREP >> 2) & 1ull)); ++rep_) {
  big_gemm(hx0, 1024, W + W_EVIN, NTOK, PW, 1024, EpiStore{(u16*)(p.ws + O_P), PW}, smem0);
  }
  xcd_barrier(xb);
  for (int rep_ = 0; rep_ < (int)(((PHMASK >> 3) & 1ull) + ((PHREP >> 3) & 1ull)); ++rep_) {
  phase_feat(p);
  phase_xbc(p);
  }
  xcd_barrier(xb);
  {
    const u16* L = (const u16*)((const char*)p.out + DO_L);
    for (int rep_ = 0; rep_ < (int)(((PHMASK >> 4) & 1ull) + ((PHREP >> 4) & 1ull)); ++rep_) {
    gemm_phase(L + 0, 384, W + W_W2F, 64, NTOK, 512, 64, EpiE{(u16*)(p.ws + O_SEF), p.in[I_W0F]}, HSMEM);
    }
    for (int rep_ = 0; rep_ < (int)(((PHMASK >> 5) & 1ull) + ((PHREP >> 5) & 1ull)); ++rep_) {
    gemm_phase(L + 64, 384, W + W_W2B, 64, NTOK, 512, 64, EpiE{(u16*)(p.ws + O_SEB), p.in[I_W0B]}, HSMEM);
    }
    for (int rep_ = 0; rep_ < (int)(((PHMASK >> 6) & 1ull) + ((PHREP >> 6) & 1ull)); ++rep_) {
    gemm_phase(L + 128, 384, W + W_A2F, 64, NTOK, 512, 64, EpiI{(u16*)(p.ws + O_SIF), p.in[I_A0F]}, HSMEM);
    }
    for (int rep_ = 0; rep_ < (int)(((PHMASK >> 7) & 1ull) + ((PHREP >> 7) & 1ull)); ++rep_) {
    gemm_phase(L + 192, 384, W + W_A2B, 64, NTOK, 512, 64, EpiI{(u16*)(p.ws + O_SIB), p.in[I_A0B]}, HSMEM);
    }
    for (int rep_ = 0; rep_ < (int)(((PHMASK >> 8) & 1ull) + ((PHREP >> 8) & 1ull)); ++rep_) {
    gemm_phase(L + 256, 384, W + W_G2, 128, NTOK, 512, 128, EpiStore{(u16*)((char*)p.out + DO_G), 512}, HSMEM);
    }
    for (int rep_ = 0; rep_ < (int)(((PHMASK >> 9) & 1ull) + ((PHREP >> 9) & 1ull)); ++rep_) {
    phase_ssd_prep(p);
    }
  }
  xcd_barrier(xb);
  for (int rep_ = 0; rep_ < (int)(((PHMASK >> 10) & 1ull) + ((PHREP >> 10) & 1ull)); ++rep_) {
  phase_rwkv(p, smem0);
  }
  xcd_barrier(xb);
  for (int rep_ = 0; rep_ < (int)(((PHMASK >> 11) & 1ull) + ((PHREP >> 11) & 1ull)); ++rep_) {
  phase_ssd_states(p, HSMEM);
  }
  xcd_barrier(xb);
  for (int rep_ = 0; rep_ < (int)(((PHMASK >> 12) & 1ull) + ((PHREP >> 12) & 1ull)); ++rep_) {
  phase_ssd_scan(p);
  }
  xcd_barrier(xb);
  for (int rep_ = 0; rep_ < (int)(((PHMASK >> 13) & 1ull) + ((PHREP >> 13) & 1ull)); ++rep_) {
  phase_ssd_out(p, HSMEM);
  }
  xcd_barrier(xb);
  for (int rep_ = 0; rep_ < (int)(((PHMASK >> 14) & 1ull) + ((PHREP >> 14) & 1ull)); ++rep_) {
  phase_finish(p);
  }
  xcd_barrier(xb);
  for (int rep_ = 0; rep_ < (int)(((PHMASK >> 15) & 1ull) + ((PHREP >> 15) & 1ull)); ++rep_) {
  big_gemm((const u16*)(p.ws + O_MIXED), 1024, W + W_EVOUT, NTOK, 1024, 1024,
             EpiRes{p.in[I_CTX], p.in[I_X], ctxr, p.out, modv, 2, 0}, smem0);
  }
  xcd_barrier(xb);
  for (int rep_ = 0; rep_ < (int)(((PHMASK >> 16) & 1ull) + ((PHREP >> 16) & 1ull)); ++rep_) {
  phase_norm(ctxr, p.out, p.in[I_N2G], modv, 3, 4, hx, 0, NTOK);
  }
  xcd_barrier(xb);
  for (int rep_ = 0; rep_ < (int)(((PHMASK >> 17) & 1ull) + ((PHREP >> 17) & 1ull)); ++rep_) {
  big_gemm(hx, 1024, W + W_UP0, NTOK, 5632, 1024, EpiStore{(u16*)(p.ws + O_GV), 5632}, smem0);
  }
  xcd_barrier(xb);
  for (int rep_ = 0; rep_ < (int)(((PHMASK >> 18) & 1ull) + ((PHREP >> 18) & 1ull)); ++rep_) {
  phase_ffnconv(p, 0, 0);
  }
  xcd_barrier(xb);
  for (int rep_ = 0; rep_ < (int)(((PHMASK >> 19) & 1ull) + ((PHREP >> 19) & 1ull)); ++rep_) {
  big_gemm((const u16*)(p.ws + O_GV) + 2816, 5632, W + W_DN0, NTOK, 1024, 2816,
             EpiRes{ctxr, p.out, ctxr, p.out, modv, 5, 0}, smem0);
  }
  xcd_barrier(xb);
  const float* modv1 = modv + 9 * 6144;
  for (int rep_ = 0; rep_ < (int)(((PHMASK >> 20) & 1ull) + ((PHREP >> 20) & 1ull)); ++rep_) {
  phase_norm(ctxr, p.out, p.in[I_N1G] + 1024, modv1, 0, 1, hx, 0, NTOK);
  }
  xcd_barrier(xb);
  for (int rep_ = 0; rep_ < (int)(((PHMASK >> 21) & 1ull) + ((PHREP >> 21) & 1ull)); ++rep_) {
  big_gemm(hx, 1024, W + W_RIN, NTOK, 4096, 1024, EpiQKV{(u16*)(p.ws + O_QKV)}, smem0);
  }
  xcd_barrier(xb);
  for (int rep_ = 0; rep_ < (int)(((PHMASK >> 22) & 1ull) + ((PHREP >> 22) & 1ull)); ++rep_) {
  phase_rope(p);
  }
  xcd_barrier(xb);
  for (int rep_ = 0; rep_ < (int)(((PHMASK >> 23) & 1ull) + ((PHREP >> 23) & 1ull)); ++rep_) {
  phase_retention(p, smem0);
  }
  xcd_barrier(xb);
  for (int rep_ = 0; rep_ < (int)(((PHMASK >> 24) & 1ull) + ((PHREP >> 24) & 1ull)); ++rep_) {
  phase_ynorm(p);
  }
  xcd_barrier(xb);
  for (int rep_ = 0; rep_ < (int)(((PHMASK >> 25) & 1ull) + ((PHREP >> 25) & 1ull)); ++rep_) {
  big_gemm(hx + (size_t)NCTX * 1024, 1024, W + W_RIN + 4096ull * 1024, NLAT, 2048, 1024,
             EpiGate{(u16*)(p.ws + O_Y), (const float*)(p.ws + O_RSTD)}, smem0);
  }
  xcd_barrier(xb);
  for (int rep_ = 0; rep_ < (int)(((PHMASK >> 26) & 1ull) + ((PHREP >> 26) & 1ull)); ++rep_) {
  big_gemm((const u16*)(p.ws + O_Y), 2048, W + W_ROUT, NLAT, 1024, 2048,
             EpiRes{ctxr, p.out, ctxr, p.out, modv1, 2, NCTX}, smem0);
  }
  xcd_barrier(xb);
  for (int rep_ = 0; rep_ < (int)(((PHMASK >> 27) & 1ull) + ((PHREP >> 27) & 1ull)); ++rep_) {
  phase_norm(ctxr, p.out, p.in[I_N2G] + 1024, modv1, 3, 4, hx, NCTX, NTOK);
  }
  xcd_barrier(xb);
  for (int rep_ = 0; rep_ < (int)(((PHMASK >> 28) & 1ull) + ((PHREP >> 28) & 1ull)); ++rep_) {
  big_gemm(hx + (size_t)NCTX * 1024, 1024, W + W_UP1, NLAT, 5632, 1024,
             EpiStore{(u16*)(p.ws + O_GV) + (size_t)NCTX * 5632, 5632}, smem0);
  }
  xcd_barrier(xb);
  for (int rep_ = 0; rep_ < (int)(((PHMASK >> 29) & 1ull) + ((PHREP >> 29) & 1ull)); ++rep_) {
  phase_ffnconv(p, 1, NCTX);
  }
  xcd_barrier(xb);
  for (int rep_ = 0; rep_ < (int)(((PHMASK >> 30) & 1ull) + ((PHREP >> 30) & 1ull)); ++rep_) {
  big_gemm((const u16*)(p.ws + O_GV) + (size_t)NCTX * 5632 + 2816, 5632, W + W_DN1, NLAT, 1024, 2816,
             EpiRes{ctxr, p.out, ctxr, p.out, modv1, 5, NCTX}, smem0);
  }
  xcd_barrier(xb);
  for (int rep_ = 0; rep_ < (int)(((PHMASK >> 31) & 1ull) + ((PHREP >> 31) & 1ull)); ++rep_) {
  phase_final(p);
  }
}

extern "C" void kernel_launch(void* const* d_in, const int* in_sizes, int n_in, void* d_out, int out_size, void* d_ws,
                              size_t ws_size, hipStream_t stream) {
  static int grid_blocks = 0;
  if (!grid_blocks) {
    int dev = 0, cus = 0, per_cu = 0;
    hipGetDevice(&dev);
    hipDeviceGetAttribute(&cus, hipDeviceAttributeMultiprocessorCount, dev);
    hipFuncSetAttribute((const void*)mega, hipFuncAttributeMaxDynamicSharedMemorySize, LDS_BYTES + 16);
    hipOccupancyMaxActiveBlocksPerMultiprocessor(&per_cu, (const void*)mega, 512, LDS_BYTES + 16);
    if (per_cu < 1) per_cu = 1;
    if (per_cu > 1) per_cu = 1;
    grid_blocks = cus * per_cu;
    fprintf(stderr, "mega: cus=%d per_cu=%d grid=%d ws=%zu\n", cus, per_cu, grid_blocks, ws_size);
  }
  Params p{};
  for (int i = 0; i < N_IN; ++i) p.in[i] = (const float*)d_in[i];
  p.out = (float*)d_out;
  p.ws = (char*)d_ws;
  hipMemsetAsync((char*)d_ws + O_BAR, 0, XCD_BAR_WORDS * 4, stream);
  void* args[] = {&p};
  hipError_t e = hipLaunchCooperativeKernel((const void*)mega, dim3(grid_blocks), dim3(512), args, LDS_BYTES + 16, stream);
  if (e != hipSuccess) fprintf(stderr, "cooperative launch failed: %s (grid %d)\n", hipGetErrorString(e), grid_blocks);
}
```

```cpp
#include <hip/hip_runtime.h>
#include <hip/hip_cooperative_groups.h>
#include <cstdio>
namespace cg = cooperative_groups;

typedef unsigned short u16;
using bf16x8 = __attribute__((ext_vector_type(8))) short;
using f32x4 = __attribute__((ext_vector_type(4))) float;
using u32x4 = __attribute__((ext_vector_type(4))) unsigned int;

#define NTOK 67584
#define NCTX 2048
#define NLAT 65536
#define PW 3472
#define LDS_BYTES 147456
#define HALF_LDS 73728
#define LTID ((int)(TT & 255))
#define VBID ((int)(blockIdx.x * 2 + (TT >> 8)))
__device__ __forceinline__ int opaque_tid() { int t = threadIdx.x; asm volatile("" : "+v"(t)); return t; }
#define VGRID ((int)(gridDim.x * 2))

enum { I_X = 0, I_C, I_CTX, I_CCTX, I_MODW, I_MODB, I_N1G, I_N2G, I_FUP, I_FCW, I_FCB, I_FDN,
       I_EVIN, I_MUP, I_MUN, I_W0F, I_W0B, I_W2F, I_W2B, I_A0F, I_A0B, I_A2F, I_A2B, I_G2, I_KK, I_KA, I_RK,
       I_LNW, I_LNB, I_SCW, I_SCB, I_DTBF, I_DTBB, I_ALF, I_ALB, I_SD, I_SNW, I_EVOUT, I_RIN, I_L2F, I_L2B, I_ROUT, I_FNG, N_IN };

struct Params { const float* in[N_IN]; float* out; char* ws; };

#define MiB (1024ull * 1024ull)
#define W_EVIN   0ull
#define W_EVOUT  (W_EVIN + 3472ull * 1024)
#define W_UP0    (W_EVOUT + 1024ull * 1024)
#define W_UP1    (W_UP0 + 5632ull * 1024)
#define W_DN0    (W_UP1 + 5632ull * 1024)
#define W_DN1    (W_DN0 + 1024ull * 2816)
#define W_RIN    (W_DN1 + 1024ull * 2816)
#define W_ROUT   (W_RIN + 6144ull * 1024)
#define W_W2F    (W_ROUT + 1024ull * 2048)
#define W_W2B    (W_W2F + 512ull * 64)
#define W_A2F    (W_W2B + 512ull * 64)
#define W_A2B    (W_A2F + 512ull * 64)
#define W_G2     (W_A2B + 512ull * 64)
#define O_SMALL  (64 * MiB)
#define O_MODV   (O_SMALL)
#define O_ROPE   (O_MODV + 2ull * 9 * 6144 * 4)
#define O_CTXR   (O_SMALL + 1 * MiB)
#define O_RN     (O_CTXR + 8 * MiB)
#define O_BONUS  (O_RN + 2162688ull)
#define O_DT     (O_BONUS + 2162688ull)
#define O_CS     (O_DT + 2 * 2162688ull)
#define O_RSTD   (O_CS + 2 * 2162688ull)
#define O_BAR    (O_RSTD + 2097152ull)
#define O_BIG    (96 * MiB)
#define SZ_TOK512 (69206016ull)
#define O_P      (O_BIG)
#define O_S      (544 * MiB)
#define O_SR     (O_S)
#define O_SK     (O_S + SZ_TOK512)
#define O_SV     (O_S + 2 * SZ_TOK512)
#define O_SEF    (O_S + 3 * SZ_TOK512)
#define O_SEB    (O_S + 4 * SZ_TOK512)
#define O_SIF    (O_S + 5 * SZ_TOK512)
#define O_SIB    (O_S + 6 * SZ_TOK512)
#define O_STATES (O_SEF)
#define O_MIXED  (O_SR)
#define O_HX     (O_BIG)
#define O_GV     (228 * MiB)
#define O_QKV    (228 * MiB)
#define O_Y      (756 * MiB)
#define DO_HX    0ull
#define DO_L     (138412032ull)
#define DO_G     (DO_L + 51904512ull)

__device__ __forceinline__ unsigned pack2(float a, float b) {
  unsigned r;
  asm("v_cvt_pk_bf16_f32 %0, %1, %2" : "=v"(r) : "v"(a), "v"(b));
  return r;
}
__device__ __forceinline__ u16 f2bf(float f) { return (u16)(pack2(f, f) & 0xffffu); }
__device__ __forceinline__ float bf2f(u16 h) { return __uint_as_float(((unsigned)h) << 16); }
__device__ __forceinline__ uint2 pack4(float a, float b, float c, float d) { return make_uint2(pack2(a, b), pack2(c, d)); }
__device__ __forceinline__ float sigmoidf_(float x) { return __builtin_amdgcn_rcpf(1.f + __expf(-x)); }
__device__ __forceinline__ float siluf_(float x) { return x * __builtin_amdgcn_rcpf(1.f + __expf(-x)); }
__device__ __forceinline__ float tanhf_(float x) { return 1.f - 2.f * __builtin_amdgcn_rcpf(__expf(2.f * x) + 1.f); }
__device__ __forceinline__ float softplusf_(float x) { return x > 20.f ? x : log1pf(__expf(x)); }
__device__ __forceinline__ float geluf_(float x) { return 0.5f * x * (1.f + tanhf_(0.7978845608028654f * (x + 0.044715f * x * x * x))); }
__device__ __forceinline__ float wave_sum(float v) {
#pragma unroll
  for (int o = 32; o; o >>= 1) v += __shfl_xor(v, o);
  return v;
}
template <int C> __device__ __forceinline__ float dppf(float v) {
  return __int_as_float(__builtin_amdgcn_update_dpp(0, __float_as_int(v), C, 0xF, 0xF, true));
}
__device__ __forceinline__ float red16(float v) {
  v += dppf<0xB1>(v);
  v += dppf<0x4E>(v);
  v += dppf<0x141>(v);
  v += dppf<0x140>(v);
  return v;
}
__device__ __forceinline__ bool has_prev(int m) { return m < NCTX ? (m & 255) != 0 : ((m - NCTX) & 8191) != 0; }
__device__ __forceinline__ bool has_next(int m) { return m < NCTX ? (m & 255) != 255 : ((m - NCTX) & 8191) != 8191; }
__device__ __forceinline__ int mod_row(int m) { return m < NCTX ? 8 : ((m - NCTX) >> 13); }
__device__ __forceinline__ int scan_tok(int dir, int b, int s) {
  if (s < 256) return b * 256 + (dir ? 255 - s : s);
  int t = s - 256;
  return NCTX + b * 8192 + (dir ? 8191 - t : t);
}
__device__ __forceinline__ bf16x8 ldfrag(const u16* base, int stride, int row0, int k0, int lane) {
  return *(const bf16x8*)(base + (row0 + (lane & 15)) * stride + k0 + (lane >> 4) * 8);
}
__device__ __forceinline__ f32x4 mma(bf16x8 afrag, bf16x8 bfrag, f32x4 acc) {
  return __builtin_amdgcn_mfma_f32_16x16x32_bf16(bfrag, afrag, acc, 0, 0, 0);
}

template <class Epi> __forceinline__
__device__ __forceinline__ void gemm_phase(const u16* __restrict__ A, int lda, const u16* __restrict__ Bt, int ldb, int M, int N, int K,
                           Epi epi, char* smem_) {
  const int TT = opaque_tid();
  u16* As = (u16*)smem_;
  u16* Bs = As + 128 * 72;
  const int tid = LTID, lane = tid & 63, wave = tid >> 6;
  const int wm = (wave >> 1) * 64, wn = (wave & 1) * 64;
  const int tiles_n = (N + 127) >> 7, tiles_m = (M + 127) >> 7;
  const int ntiles = tiles_m * tiles_n;
  const int lrow = tid >> 3, lkc = (tid & 7) * 8;
  for (int vb = VBID; vb < ntiles; vb += VGRID) {
    const int tm = vb / tiles_n, tn = vb - tm * tiles_n;
    const int m0 = tm * 128, n0 = tn * 128;
    f32x4 acc[4][4];
#pragma unroll
    for (int i = 0; i < 4; ++i)
#pragma unroll
      for (int j = 0; j < 4; ++j) acc[i][j] = (f32x4){0.f, 0.f, 0.f, 0.f};
    u32x4 ra[4], rb[4];
    const u16* ap[4];
    const u16* bp[4];
#pragma unroll
    for (int i = 0; i < 4; ++i) {
      int row = lrow + i * 32;
      int am = min(m0 + row, M - 1), bn = min(n0 + row, N - 1);
      ap[i] = A + (size_t)am * lda + lkc;
      bp[i] = Bt + (size_t)bn * ldb + lkc;
    }
#pragma unroll
    for (int i = 0; i < 4; ++i) { ra[i] = *(const u32x4*)(ap[i]); rb[i] = *(const u32x4*)(bp[i]); }
    for (int k0 = 0; k0 < K; k0 += 64) {
      __syncthreads();
#pragma unroll
      for (int i = 0; i < 4; ++i) {
        *(u32x4*)(As + (lrow + i * 32) * 72 + lkc) = ra[i];
        *(u32x4*)(Bs + (lrow + i * 32) * 72 + lkc) = rb[i];
      }
      __syncthreads();
      if (k0 + 64 < K) {
#pragma unroll
        for (int i = 0; i < 4; ++i) { ra[i] = *(const u32x4*)(ap[i] + k0 + 64); rb[i] = *(const u32x4*)(bp[i] + k0 + 64); }
      }
#pragma unroll
      for (int kk = 0; kk < 64; kk += 32) {
        bf16x8 af[4], bfr[4];
#pragma unroll
        for (int i = 0; i < 4; ++i) af[i] = ldfrag(As, 72, wm + i * 16, kk, lane);
#pragma unroll
        for (int j = 0; j < 4; ++j) bfr[j] = ldfrag(Bs, 72, wn + j * 16, kk, lane);
#pragma unroll
        for (int i = 0; i < 4; ++i)
#pragma unroll
          for (int j = 0; j < 4; ++j) acc[i][j] = mma(af[i], bfr[j], acc[i][j]);
      }
    }
#pragma unroll
    for (int i = 0; i < 4; ++i)
#pragma unroll
      for (int j = 0; j < 4; ++j) {
        int m = m0 + wm + i * 16 + (lane & 15);
        int n = n0 + wn + j * 16 + (lane >> 4) * 4;
        if (m < M && n < N) epi(m, n, acc[i][j]);
      }
  }
}

struct EpiStore { static constexpr bool PERM = true; u16* C; int ldc;
  __device__ void store8(int m, int n, f32x4 a, f32x4 b) const { u32x4 o = {pack2(a[0], a[1]), pack2(a[2], a[3]), pack2(b[0], b[1]), pack2(b[2], b[3])}; *(u32x4*)(C + (size_t)m * ldc + n) = o; }
  __device__ void operator()(int m, int n, f32x4 v) const { *(uint2*)(C + (size_t)m * ldc + n) = pack4(v[0], v[1], v[2], v[3]); } };
struct EpiE { static constexpr bool PERM = false; u16* C; const float* w0;
  __device__ void operator()(int m, int n, f32x4 v) const {
    float4 w = *(const float4*)(w0 + n);
    *(uint2*)(C + (size_t)m * 512 + n) = pack4(sigmoidf_(w.x + v[0]) * 0.6065306597126334f, sigmoidf_(w.y + v[1]) * 0.6065306597126334f,
                                              sigmoidf_(w.z + v[2]) * 0.6065306597126334f, sigmoidf_(w.w + v[3]) * 0.6065306597126334f); } };
struct EpiI { static constexpr bool PERM = false; u16* C; const float* a0;
  __device__ void operator()(int m, int n, f32x4 v) const {
    float4 w = *(const float4*)(a0 + n);
    *(uint2*)(C + (size_t)m * 512 + n) = pack4(sigmoidf_(w.x + v[0]), sigmoidf_(w.y + v[1]), sigmoidf_(w.z + v[2]), sigmoidf_(w.w + v[3])); } };
struct EpiRes { static constexpr bool PERM = false; const float* src_c; const float* src_l; float* dst_c; float* dst_l; const float* modv_l; int gi; int moff;
  __device__ void operator()(int m_, int n, f32x4 v) const {
    int m = m_ + moff;
    const float* g = modv_l + (mod_row(m) * 6 + gi) * 1024 + n;
    float4 gg = *(const float4*)g;
    const float* s; float* d;
    if (m < NCTX) { s = src_c + (size_t)m * 1024 + n; d = dst_c + (size_t)m * 1024 + n; }
    else { s = src_l + (size_t)(m - NCTX) * 1024 + n; d = dst_l + (size_t)(m - NCTX) * 1024 + n; }
    float4 x = *(const float4*)s;
    x.x += gg.x * v[0]; x.y += gg.y * v[1]; x.z += gg.z * v[2]; x.w += gg.w * v[3];
    *(float4*)d = x; } };
struct EpiQKV { static constexpr bool PERM = true; u16* C;
  __device__ void store8(int m, int n, f32x4 a, f32x4 b) const {
    float sc_ = (n >= 1024 && n < 2048) ? 0.08838834764831845f : 1.f;
    u32x4 o = {pack2(a[0] * sc_, a[1] * sc_), pack2(a[2] * sc_, a[3] * sc_), pack2(b[0] * sc_, b[1] * sc_), pack2(b[2] * sc_, b[3] * sc_)};
    *(u32x4*)(C + (size_t)m * 4096 + n) = o; }
  __device__ void operator()(int m, int n, f32x4 v) const {
    float s = (n >= 1024 && n < 2048) ? 0.08838834764831845f : 1.f;
    *(uint2*)(C + (size_t)m * 4096 + n) = pack4(v[0] * s, v[1] * s, v[2] * s, v[3] * s); } };
struct EpiGate { static constexpr bool PERM = true; u16* Y; const float* rstd;
  __device__ void store8(int m, int n, f32x4 a, f32x4 b) const {
    u16* yp = Y + (size_t)m * 2048 + n;
    u32x4 yy = *(const u32x4*)yp;
    float r = rstd[m * 8 + (n >> 8)];
    float g[8] = {a[0], a[1], a[2], a[3], b[0], b[1], b[2], b[3]};
    float o[8];
#pragma unroll
    for (int i = 0; i < 4; ++i) {
      o[2 * i] = siluf_(g[2 * i]) * bf2f((u16)(yy[i] & 0xffff)) * r;
      o[2 * i + 1] = siluf_(g[2 * i + 1]) * bf2f((u16)(yy[i] >> 16)) * r;
    }
    u32x4 ov = {pack2(o[0], o[1]), pack2(o[2], o[3]), pack2(o[4], o[5]), pack2(o[6], o[7])};
    *(u32x4*)yp = ov; }
  __device__ void operator()(int m, int n, f32x4 v) const {
    u16* yp = Y + (size_t)m * 2048 + n;
    uint2 yy = *(const uint2*)yp;
    float r = rstd[m * 8 + (n >> 8)];
    float y0 = bf2f((u16)(yy.x & 0xffff)), y1 = bf2f((u16)(yy.x >> 16)), y2 = bf2f((u16)(yy.y & 0xffff)), y3 = bf2f((u16)(yy.y >> 16));
    *(uint2*)yp = pack4(siluf_(v[0]) * y0 * r, siluf_(v[1]) * y1 * r, siluf_(v[2]) * y2 * r, siluf_(v[3]) * y3 * r); } };

__device__ __forceinline__ void transpose_job(const float* __restrict__ src, u16* __restrict__ dst, int K, int N, char* smem) {
  const int TT = opaque_tid();
  float* tile = (float*)smem;
  const int tid = LTID;
  const int tk = K >> 6, tn = (N + 63) >> 6;
  const int ntiles = tk * tn;
  for (int vb = VBID; vb < ntiles; vb += VGRID) {
    const int k0 = (vb / tn) * 64, n0 = (vb % tn) * 64;
    __syncthreads();
#pragma unroll
    for (int i = 0; i < 4; ++i) {
      int r = (tid >> 4) + i * 16, c4 = (tid & 15) * 4;
      float4 v = make_float4(0.f, 0.f, 0.f, 0.f);
      if (n0 + c4 < N) v = *(const float4*)(src + (size_t)(k0 + r) * N + n0 + c4);
      tile[r * 65 + c4] = v.x; tile[r * 65 + c4 + 1] = v.y; tile[r * 65 + c4 + 2] = v.z; tile[r * 65 + c4 + 3] = v.w;
    }
    __syncthreads();
#pragma unroll
    for (int i = 0; i < 2; ++i) {
      int item = tid + i * 256; int kc = item & 7, n = item >> 3;
      if (n0 + n < N) {
        float v[8];
#pragma unroll
        for (int j = 0; j < 8; ++j) v[j] = tile[(kc * 8 + j) * 65 + n];
        u32x4 o = {pack2(v[0], v[1]), pack2(v[2], v[3]), pack2(v[4], v[5]), pack2(v[6], v[7])};
        *(u32x4*)(dst + (size_t)(n0 + n) * K + k0 + kc * 8) = o;
      }
    }
  }
}

__device__ __forceinline__ void phase_prep(const Params& p, char* smem) {
  const int TT = opaque_tid();
  u16* W = (u16*)p.ws;
  transpose_job(p.in[I_EVIN], W + W_EVIN, 1024, 3472, smem);
  transpose_job(p.in[I_W2F], W + W_W2F, 64, 512, smem);
  transpose_job(p.in[I_W2B], W + W_W2B, 64, 512, smem);
  transpose_job(p.in[I_A2F], W + W_A2F, 64, 512, smem);
  transpose_job(p.in[I_A2B], W + W_A2B, 64, 512, smem);
  transpose_job(p.in[I_G2], W + W_G2, 128, 512, smem);
  {
    float* rope = (float*)(p.ws + O_ROPE);
    for (int idx = VBID * 256 + LTID; idx < (128 + 64) * 32; idx += VGRID * 256) {
      int j = idx & 31, pos = idx >> 5;
      bool isrow = pos < 128;
      int pp = isrow ? pos : pos - 128;
      float inv = powf(10000.f, -(float)j / 32.f);
      float ang = (float)pp * inv;
      double a = (double)ang;
      double kq = rint(a * 0.15915494309189535);
      double r = a - kq * 6.283185307179586476925;
      double r2 = r * r;
      double sn = r, cs = 1.0, ts = r, tc = 1.0;
#pragma unroll 1
      for (int it = 1; it <= 14; ++it) {
        tc = -tc * r2 / (double)((2 * it - 1) * (2 * it));
        ts = -ts * r2 / (double)((2 * it) * (2 * it + 1));
        cs += tc; sn += ts;
      }
      if (isrow) { rope[pp * 32 + j] = (float)cs; rope[4096 + pp * 32 + j] = (float)sn; }
      else { rope[8192 + pp * 32 + j] = (float)cs; rope[8192 + 2048 + pp * 32 + j] = (float)sn; }
    }
  }
  {
    float* sc = (float*)smem;
    float* red = sc + 9 * 1024;
    float* modv = (float*)(p.ws + O_MODV);
    bool loaded = false;
    __syncthreads();
    for (int vb = VBID; vb < 384; vb += VGRID) {
      if (!loaded) {
        for (int i = LTID; i < 9 * 1024; i += 256) {
          int r = i >> 10, k = i & 1023;
          float cv = r < 8 ? p.in[I_C][r * 1024 + k] : p.in[I_CCTX][k];
          sc[i] = cv / (1.f + expf(-cv));
        }
        loaded = true;
        __syncthreads();
      }
      int l = vb / 192, jb = vb % 192;
      int jj = LTID & 31, kc = LTID >> 5;
      int j = jb * 32 + jj;
      const float* w = p.in[I_MODW] + ((size_t)l * 1024 + kc * 128) * 6144 + j;
      float acc[9];
#pragma unroll
      for (int r = 0; r < 9; ++r) acc[r] = 0.f;
#pragma unroll 16
      for (int k = 0; k < 128; ++k) {
        float wv = w[(size_t)k * 6144];
#pragma unroll
        for (int r = 0; r < 9; ++r) acc[r] += sc[r * 1024 + kc * 128 + k] * wv;
      }
      __syncthreads();
#pragma unroll
      for (int r = 0; r < 9; ++r) red[(kc * 9 + r) * 32 + jj] = acc[r];
      __syncthreads();
      if (kc == 0) {
        float mb = p.in[I_MODB][l * 6144 + j];
#pragma unroll
        for (int r = 0; r < 9; ++r) {
          float sum = 0.f;
#pragma unroll
          for (int q = 0; q < 8; ++q) sum += red[(q * 9 + r) * 32 + jj];
          modv[((size_t)l * 9 + r) * 6144 + j] = sum + mb;
        }
      }
    }
    __syncthreads();
  }
}

__device__ __forceinline__ void phase_norm(const float* src_c, const float* src_l, const float* g, const float* modv_l, int si, int sci,
                           u16* hx, int r0, int r1) {
  const int TT = opaque_tid();
  const int lane = LTID & 63, wv = LTID >> 6;
  for (int m = r0 + (VBID * 4 + wv) * 2; m < r1; m += VGRID * 8) {
    float4 v[2][4];
    float ss[2] = {0.f, 0.f};
#pragma unroll
    for (int q = 0; q < 2; ++q) {
      const int mm = m + q;
      const float* src = mm < NCTX ? src_c + (size_t)mm * 1024 : src_l + (size_t)(mm - NCTX) * 1024;
#pragma unroll
      for (int i = 0; i < 4; ++i) v[q][i] = *(const float4*)(src + i * 256 + lane * 4);
    }
#pragma unroll
    for (int q = 0; q < 2; ++q) {
#pragma unroll
      for (int i = 0; i < 4; ++i) ss[q] += v[q][i].x * v[q][i].x + v[q][i].y * v[q][i].y + v[q][i].z * v[q][i].z + v[q][i].w * v[q][i].w;
      ss[q] = wave_sum(ss[q]);
    }
#pragma unroll
    for (int q = 0; q < 2; ++q) {
      const int mm = m + q;
      const int r = mod_row(mm);
      const float* sh = modv_l + (r * 6 + si) * 1024;
      const float* scl = modv_l + (r * 6 + sci) * 1024;
      const float rstd = rsqrtf(ss[q] * (1.f / 1024.f) + 1e-6f);
#pragma unroll
      for (int i = 0; i < 4; ++i) {
        int c = i * 256 + lane * 4;
        float4 gg = *(const float4*)(g + c), s1 = *(const float4*)(scl + c), s0 = *(const float4*)(sh + c);
        float y0 = v[q][i].x * rstd * gg.x * (1.f + s1.x) + s0.x;
        float y1 = v[q][i].y * rstd * gg.y * (1.f + s1.y) + s0.y;
        float y2 = v[q][i].z * rstd * gg.z * (1.f + s1.z) + s0.z;
        float y3 = v[q][i].w * rstd * gg.w * (1.f + s1.w) + s0.w;
        *(uint2*)(hx + (size_t)mm * 1024 + c) = pack4(y0, y1, y2, y3);
      }
    }
  }
}

__device__ __forceinline__ float red8(float v) {
  v += dppf<0xB1>(v);
  v += dppf<0x4E>(v);
  v += dppf<0x141>(v);
  return v;
}
__device__ __forceinline__ void unpack8(u32x4 q, float* o) {
#pragma unroll
  for (int e = 0; e < 4; ++e) { o[2 * e] = bf2f((u16)(q[e] & 0xffff)); o[2 * e + 1] = bf2f((u16)(q[e] >> 16)); }
}
__device__ __forceinline__ u32x4 pack8(const float* o) {
  u32x4 r = {pack2(o[0], o[1]), pack2(o[2], o[3]), pack2(o[4], o[5]), pack2(o[6], o[7])};
  return r;
}
__device__ __forceinline__ void load8f(const float* p, float* o) {
  float4 a = *(const float4*)p, b = *(const float4*)(p + 4);
  o[0] = a.x; o[1] = a.y; o[2] = a.z; o[3] = a.w; o[4] = b.x; o[5] = b.y; o[6] = b.z; o[7] = b.w;
}
__device__ __forceinline__ void shifted8(const u16* row, int col, bool hp, bool hn, const float* mup, const float* mun, float* o) {
  const u32x4 z4 = {0u, 0u, 0u, 0u};
  u32x4 cur = *(const u32x4*)(row + col);
  u32x4 prv = *(const u32x4*)(row + col - (hp ? PW : 0));
  u32x4 nxt = *(const u32x4*)(row + col + (hn ? PW : 0));
  prv = hp ? prv : z4; nxt = hn ? nxt : z4;
  float u[8], pv[8], nx[8], mp[8], mn[8];
  unpack8(cur, u); unpack8(prv, pv); unpack8(nxt, nx);
  load8f(mup + col, mp); load8f(mun + col, mn);
#pragma unroll
  for (int i = 0; i < 8; ++i) o[i] = u[i] + mp[i] * (pv[i] - u[i]) + mn[i] * (nx[i] - u[i]);
}
__device__ __forceinline__ void phase_feat(const Params& p) {
  const int TT = opaque_tid();
  const u16* __restrict__ P = (const u16*)(p.ws + O_P);
  u16* __restrict__ Sr = (u16*)(p.ws + O_SR); u16* __restrict__ Sk = (u16*)(p.ws + O_SK); u16* __restrict__ Sv = (u16*)(p.ws + O_SV);
  float* __restrict__ rn = (float*)(p.ws + O_RN); float* __restrict__ bonus = (float*)(p.ws + O_BONUS);
  u16* __restrict__ L = (u16*)((char*)p.out + DO_L);
  const float* __restrict__ mup = p.in[I_MUP]; const float* __restrict__ mun = p.in[I_MUN];
  const int lane = LTID & 63, wv = LTID >> 6;
  const int h = lane >> 3, c = h * 64 + (lane & 7) * 8;
  float kkw[8], rkw[8];
  load8f(p.in[I_KK] + c, kkw); load8f(p.in[I_RK] + c, rkw);
#pragma unroll 2
  for (int m = VBID * 4 + wv; m < NTOK; m += VGRID * 4) {
    const bool hp = has_prev(m), hn = has_next(m);
    const u16* row = P + (size_t)m * PW;
    float r[8], k[8], v[8];
    shifted8(row, c, hp, hn, mup, mun, r);
    shifted8(row, 512 + c, hp, hn, mup, mun, k);
    shifted8(row, 1024 + c, hp, hn, mup, mun, v);
    *(u32x4*)(Sr + (size_t)m * 512 + c) = pack8(r);
    *(u32x4*)(Sk + (size_t)m * 512 + c) = pack8(k);
    *(u32x4*)(Sv + (size_t)m * 512 + c) = pack8(v);
    float s1 = 0.f, s2 = 0.f;
#pragma unroll
    for (int i = 0; i < 8; ++i) { float kk = k[i] * kkw[i]; s1 += kk * kk; s2 += r[i] * k[i] * rkw[i]; }
    s1 = red8(s1); s2 = red8(s2);
    if ((lane & 7) == 0) {
      rn[m * 8 + h] = 1.f / fmaxf(sqrtf(s1), 1e-12f);
      bonus[m * 8 + h] = s2;
    }
    if (lane < 48) {
      float o[8];
      shifted8(row, 1536 + lane * 8, hp, hn, mup, mun, o);
      const int g = lane >> 3;
#pragma unroll
      for (int i = 0; i < 8; ++i) o[i] = g < 2 ? tanhf_(o[i]) : (g < 4 ? o[i] : sigmoidf_(o[i]));
      *(u32x4*)(L + (size_t)m * 384 + lane * 8) = pack8(o);
    }
  }
}

__device__ __forceinline__ void transpose_item(const float* __restrict__ src, u16* __restrict__ dst, int K, int N, int idx) {
  const int n = idx % N, kb = idx / N;
  const float* sp = src + (size_t)kb * 8 * N + n;
  float v[8];
#pragma unroll
  for (int i = 0; i < 8; ++i) v[i] = sp[(size_t)i * N];
  u32x4 o = {pack2(v[0], v[1]), pack2(v[2], v[3]), pack2(v[4], v[5]), pack2(v[6], v[7])};
  *(u32x4*)(dst + (size_t)n * K + kb * 8) = o;
}
#define LATE_ITEMS 3342336
__device__ __forceinline__ void late_weight_item(const Params& p, int idx) {
  u16* W = (u16*)p.ws;
  if (idx < 131072) { transpose_item(p.in[I_EVOUT], W + W_EVOUT, 1024, 1024, idx); return; }
  idx -= 131072;
  if (idx < 720896) { transpose_item(p.in[I_FUP], W + W_UP0, 1024, 5632, idx); return; }
  idx -= 720896;
  if (idx < 720896) { transpose_item(p.in[I_FUP] + 1024ull * 5632, W + W_UP1, 1024, 5632, idx); return; }
  idx -= 720896;
  if (idx < 360448) { transpose_item(p.in[I_FDN], W + W_DN0, 2816, 1024, idx); return; }
  idx -= 360448;
  if (idx < 360448) { transpose_item(p.in[I_FDN] + 2816ull * 1024, W + W_DN1, 2816, 1024, idx); return; }
  idx -= 360448;
  if (idx < 786432) { transpose_item(p.in[I_RIN], W + W_RIN, 1024, 6144, idx); return; }
  idx -= 786432;
  if (idx < 262144) { transpose_item(p.in[I_ROUT], W + W_ROUT, 2048, 1024, idx); return; }
}

using f32x2 = __attribute__((ext_vector_type(2))) float;
__device__ __forceinline__ void phase_rwkv(const Params& p, char* smem) {
  const u16* Sr = (const u16*)(p.ws + O_SR); const u16* Sk = (const u16*)(p.ws + O_SK); const u16* Sv = (const u16*)(p.ws + O_SV);
  const float* rn = (const float*)(p.ws + O_RN);
  u16* P = (u16*)(p.ws + O_P);
  constexpr int CH = 32;
  constexpr int NCH = 8448 / CH;
  float* buf = (float*)smem;
  float* vbuf = buf + 2 * 5 * CH * 64;
  const int tid = opaque_tid(), lane = tid & 63, wave = tid >> 6;
  const bool producer = tid >= 256;
  const int pt = tid & 255;
  const int ch = pt & 63, st0 = pt >> 6;
  const int rg = lane >> 4, ls = lane & 15;
  const int r0 = (wave & 3) * 8 + rg * 2;
  for (int vb = blockIdx.x; vb < 256; vb += gridDim.x) {
    const int seq = (vb & 7) * 16 + (vb >> 4), hh = (vb >> 3) & 1;
    const int dir = seq >> 6, b = (seq >> 3) & 7, h = seq & 7;
    const u16* Se = (const u16*)(p.ws + (dir ? O_SEB : O_SEF));
    const u16* Si = (const u16*)(p.ws + (dir ? O_SIB : O_SIF));
    const float kkc = p.in[I_KK][h * 64 + ch], kac = p.in[I_KA][h * 64 + ch];
    f32x2 s00 = {0.f, 0.f}, s01 = {0.f, 0.f}, s10 = {0.f, 0.f}, s11 = {0.f, 0.f};
    u16 gr[CH / 4], gk[CH / 4], ge[CH / 4], gi[CH / 4]; float grn[CH / 4]; u16 gv[CH / 8];
    auto gload = [&](int c) {
#pragma unroll
      for (int i = 0; i < CH / 4; ++i) {
        int m = scan_tok(dir, b, c * CH + st0 + i * 4);
        size_t o = (size_t)m * 512 + h * 64 + ch;
        gr[i] = Sr[o]; gk[i] = Sk[o]; ge[i] = Se[o]; gi[i] = Si[o]; grn[i] = rn[m * 8 + h];
      }
#pragma unroll
      for (int i = 0; i < CH / 8; ++i) {
        int item = pt + i * 256;
        int mv = scan_tok(dir, b, c * CH + (item >> 5));
        gv[i] = Sv[(size_t)mv * 512 + h * 64 + hh * 32 + (item & 31)];
      }
    };
    auto sstore = [&](int bi) {
      float* B = buf + bi * (5 * CH * 64);
#pragma unroll
      for (int i = 0; i < CH / 4; ++i) {
        int st = st0 + i * 4;
        float r = bf2f(gr[i]), k = bf2f(gk[i]), e = bf2f(ge[i]), ic = bf2f(gi[i]);
        float kk = k * kkc * grn[i];
        B[(0 * CH + st) * 64 + ch] = -kk;
        B[(1 * CH + st) * 64 + ch] = kk * ic;
        B[(2 * CH + st) * 64 + ch] = k * (1.f + (ic - 1.f) * kac);
        B[(3 * CH + st) * 64 + ch] = __expf(-e);
        B[(4 * CH + st) * 64 + ch] = r;
      }
#pragma unroll
      for (int i = 0; i < CH / 8; ++i) vbuf[bi * (CH * 32) + pt + i * 256] = bf2f(gv[i]);
    };
    __syncthreads();
    if (producer) { gload(0); sstore(0); gload(1); }
    __syncthreads();
    for (int c = 0; c < NCH; ++c) {
      if (producer) {
        if (c + 1 < NCH) { sstore((c + 1) & 1); if (c + 2 < NCH) gload(c + 2); }
        {
          const int li = c * ((int)gridDim.x * 256) + blockIdx.x * 256 + pt;
          if (li < LATE_ITEMS && vb == (int)blockIdx.x) late_weight_item(p, li);
        }
      } else {
        const float* B = buf + (c & 1) * (5 * CH * 64);
        const float* VB = vbuf + (c & 1) * (CH * 32);
        f32x2 ykeep = {0.f, 0.f}, ykeep2 = {0.f, 0.f};
#pragma unroll
        for (int st = 0; st < CH; ++st) {
          f32x4 a = *(const f32x4*)(B + (0 * CH + st) * 64 + ls * 4);
          f32x4 bb = *(const f32x4*)(B + (1 * CH + st) * 64 + ls * 4);
          f32x4 kd = *(const f32x4*)(B + (2 * CH + st) * 64 + ls * 4);
          f32x4 w = *(const f32x4*)(B + (3 * CH + st) * 64 + ls * 4);
          f32x4 r = *(const f32x4*)(B + (4 * CH + st) * 64 + ls * 4);
          f32x2 vv = *(const f32x2*)(VB + st * 32 + r0);
          f32x2 alo = {a[0], a[1]}, ahi = {a[2], a[3]}, blo = {bb[0], bb[1]}, bhi = {bb[2], bb[3]};
          f32x2 klo = {kd[0], kd[1]}, khi = {kd[2], kd[3]}, wlo = {w[0], w[1]}, whi = {w[2], w[3]};
          f32x2 rlo = {r[0], r[1]}, rhi = {r[2], r[3]};
          f32x2 t0 = s00 * alo + s01 * ahi;
          f32x2 t1 = s10 * alo + s11 * ahi;
          float sa0 = red16(t0[0] + t0[1]);
          float sa1 = red16(t1[0] + t1[1]);
          f32x2 sa0v = {sa0, sa0}, sa1v = {sa1, sa1}, v0v = {vv[0], vv[0]}, v1v = {vv[1], vv[1]};
          s00 = s00 * wlo + sa0v * blo + v0v * klo;
          s01 = s01 * whi + sa0v * bhi + v0v * khi;
          s10 = s10 * wlo + sa1v * blo + v1v * klo;
          s11 = s11 * whi + sa1v * bhi + v1v * khi;
          f32x2 u0 = s00 * rlo + s01 * rhi;
          f32x2 u1 = s10 * rlo + s11 * rhi;
          float y0 = red16(u0[0] + u0[1]);
          float y1 = red16(u1[0] + u1[1]);
          if (st < 16) { ykeep[0] = (ls == st) ? y0 : ykeep[0]; ykeep[1] = (ls == st) ? y1 : ykeep[1]; }
          else { ykeep2[0] = (ls == st - 16) ? y0 : ykeep2[0]; ykeep2[1] = (ls == st - 16) ? y1 : ykeep2[1]; }
        }
#pragma unroll
        for (int half_ = 0; half_ < 2; ++half_) {
          const int sidx = c * CH + half_ * 16 + ls;
          const int tt = sidx - 256;
          const int mctx = b * 256 + (dir ? 255 - sidx : sidx);
          const int mlat = NCTX + b * 8192 + (dir ? 8191 - tt : tt);
          const int m = sidx < 256 ? mctx : mlat;
          const f32x2 yk = half_ ? ykeep2 : ykeep;
          *(unsigned*)(P + (size_t)m * PW + dir * 512 + h * 64 + hh * 32 + r0) = pack2(yk[0], yk[1]);
        }
      }
      __syncthreads();
    }
  }
}

__device__ __forceinline__ float xbc_conv(const u16* P, int m, int cx, const float* cw, const float* cb, bool hp, bool hn) {
  const u16* q = P + (size_t)m * PW + 2432 + cx;
  float v = cb[cx] + cw[1024 + cx] * bf2f(q[0]);
  if (hp) v += cw[cx] * bf2f(q[-PW]);
  if (hn) v += cw[2048 + cx] * bf2f(q[PW]);
  return siluf_(v);
}

#define XLO(w) bf2f((u16)((w) & 0xffff))
#define XHI(w) bf2f((u16)((w) >> 16))
__device__ __forceinline__ void phase_xbc(const Params& p) {
  const int TT = opaque_tid();
  const u16* __restrict__ P = (const u16*)(p.ws + O_P);
  u16* __restrict__ X = (u16*)((char*)p.out + DO_HX);
  const float* __restrict__ cw = p.in[I_SCW]; const float* __restrict__ cb = p.in[I_SCB];
  const int total = NTOK * 128;
#pragma unroll 2
  for (int idx = VBID * 256 + LTID; idx < total; idx += VGRID * 256) {
    const int m = idx >> 7, c = (idx & 127) * 8;
    const u16* q = P + (size_t)m * PW + 2432 + c;
    const u32x4 z4 = {0u, 0u, 0u, 0u};
    const bool hp = has_prev(m), hn = has_next(m);
    u32x4 cur = *(const u32x4*)q;
    u32x4 prv = *(const u32x4*)(q - (hp ? PW : 0));
    u32x4 nxt = *(const u32x4*)(q + (hn ? PW : 0));
    prv = hp ? prv : z4; nxt = hn ? nxt : z4;
    float o[8];
#pragma unroll
    for (int e = 0; e < 4; ++e) {
      int c0 = c + 2 * e, c1 = c0 + 1;
      float v0 = cb[c0] + cw[c0] * XLO(prv[e]) + cw[1024 + c0] * XLO(cur[e]) + cw[2048 + c0] * XLO(nxt[e]);
      float v1 = cb[c1] + cw[c1] * XHI(prv[e]) + cw[1024 + c1] * XHI(cur[e]) + cw[2048 + c1] * XHI(nxt[e]);
      o[2 * e] = siluf_(v0); o[2 * e + 1] = siluf_(v1);
    }
    u32x4 ov = {pack2(o[0], o[1]), pack2(o[2], o[3]), pack2(o[4], o[5]), pack2(o[6], o[7])};
    *(u32x4*)(X + (size_t)m * 1024 + c) = ov;
  }
}

__device__ __forceinline__ void phase_ssd_prep(const Params& p) {
  const int TT = opaque_tid();
  const u16* __restrict__ P = (const u16*)(p.ws + O_P);
  float* __restrict__ dtb = (float*)(p.ws + O_DT); float* __restrict__ csb = (float*)(p.ws + O_CS);
  for (int idx = VBID * 256 + LTID; idx < 528 * 16; idx += VGRID * 256) {
    int cidx = idx >> 4, dir = (idx >> 3) & 1, h = idx & 7;
    float bias = dir ? p.in[I_DTBB][h] : p.in[I_DTBF][h];
    float A = -expf(dir ? p.in[I_ALB][h] : p.in[I_ALF][h]);
    float cs = 0.f;
#pragma unroll 16
    for (int i = 0; i < 128; ++i) {
      int l = dir ? 127 - i : i;
      int m = cidx * 128 + l;
      float dtr = bf2f(P[(size_t)m * PW + 3456 + dir * 8 + h]);
      float dt = softplusf_(dtr + bias);
      cs += dt * A;
      dtb[((size_t)dir * NTOK + m) * 8 + h] = dt;
      csb[((size_t)dir * NTOK + m) * 8 + h] = cs;
    }
  }
}

__device__ __forceinline__ void phase_ssd_states(const Params& p, char* smem) {
  const int TT = opaque_tid();
  const u16* P = (const u16*)(p.ws + O_P);
  const float* dtb = (const float*)(p.ws + O_DT); const float* csb = (const float*)(p.ws + O_CS);
  float* states = (float*)(p.ws + O_STATES);
  const float* cw = p.in[I_SCW]; const float* cb = p.in[I_SCB];
  const u16* X = (const u16*)((const char*)p.out + DO_HX);
  u16* XTf = (u16*)smem; u16* XTb = XTf + 64 * 136; u16* BT = XTb + 64 * 136;
  float* wf = (float*)(BT + 128 * 136);
  const int tid = LTID, lane = tid & 63, wave = tid >> 6;
  for (int vb = VBID; vb < 528 * 8; vb += VGRID) {
    const int cidx = vb >> 3, h = vb & 7, g = h >> 2;
    const int mb = cidx * 128;
    __syncthreads();
    {
      int d = tid >> 7, l = tid & 127;
      float tot = csb[((size_t)d * NTOK + mb + (d ? 0 : 127)) * 8 + h];
      size_t o = ((size_t)d * NTOK + mb + l) * 8 + h;
      wf[d * 128 + l] = dtb[o] * __expf(tot - csb[o]);
    }
    __syncthreads();
#pragma unroll
    for (int i = 0; i < 2; ++i) {
      int item = tid + i * 256; int lp = item & 63, cg = item >> 6;
      int l0 = 2 * lp;
      const u16* xp = X + (size_t)(mb + l0) * 1024 + h * 64 + cg * 8;
      u32x4 x0 = *(const u32x4*)xp, x1 = *(const u32x4*)(xp + 1024);
      float f0 = wf[l0], f1 = wf[l0 + 1], b0 = wf[128 + l0], b1 = wf[128 + l0 + 1];
#pragma unroll
      for (int e = 0; e < 4; ++e) {
        float a0 = XLO(x0[e]), a1 = XLO(x1[e]), c0 = XHI(x0[e]), c1 = XHI(x1[e]);
        *(unsigned*)(XTf + (cg * 8 + 2 * e) * 136 + l0) = pack2(a0 * f0, a1 * f1);
        *(unsigned*)(XTf + (cg * 8 + 2 * e + 1) * 136 + l0) = pack2(c0 * f0, c1 * f1);
        *(unsigned*)(XTb + (cg * 8 + 2 * e) * 136 + l0) = pack2(a0 * b0, a1 * b1);
        *(unsigned*)(XTb + (cg * 8 + 2 * e + 1) * 136 + l0) = pack2(c0 * b0, c1 * b1);
      }
    }
#pragma unroll
    for (int i = 0; i < 4; ++i) {
      int item = tid + i * 256; int lp = item & 63, cg = item >> 6;
      int l0 = 2 * lp;
      const u16* xp = X + (size_t)(mb + l0) * 1024 + 512 + g * 128 + cg * 8;
      u32x4 x0 = *(const u32x4*)xp, x1 = *(const u32x4*)(xp + 1024);
#pragma unroll
      for (int e = 0; e < 4; ++e) {
        *(unsigned*)(BT + (cg * 8 + 2 * e) * 136 + l0) = (x0[e] & 0xffffu) | (x1[e] << 16);
        *(unsigned*)(BT + (cg * 8 + 2 * e + 1) * 136 + l0) = (x0[e] >> 16) | (x1[e] & 0xffff0000u);
      }
    }
    __syncthreads();
#pragma unroll
    for (int d = 0; d < 2; ++d) {
      const u16* XT = d ? XTb : XTf;
      f32x4 acc[4][2];
#pragma unroll
      for (int i = 0; i < 4; ++i) { acc[i][0] = (f32x4){0, 0, 0, 0}; acc[i][1] = (f32x4){0, 0, 0, 0}; }
#pragma unroll
      for (int kk = 0; kk < 128; kk += 32) {
        bf16x8 af[4], bfr[2];
#pragma unroll
        for (int i = 0; i < 4; ++i) af[i] = ldfrag(XT, 136, i * 16, kk, lane);
#pragma unroll
        for (int j = 0; j < 2; ++j) bfr[j] = ldfrag(BT, 136, wave * 32 + j * 16, kk, lane);
#pragma unroll
        for (int i = 0; i < 4; ++i)
#pragma unroll
          for (int j = 0; j < 2; ++j) acc[i][j] = mma(af[i], bfr[j], acc[i][j]);
      }
      float* so = states + (((size_t)d * 528 + cidx) * 8 + h) * 8192;
#pragma unroll
      for (int i = 0; i < 4; ++i)
#pragma unroll
        for (int j = 0; j < 2; ++j) {
          int pp = i * 16 + (lane & 15), n = wave * 32 + j * 16 + (lane >> 4) * 4;
          *(float4*)(so + pp * 128 + n) = make_float4(acc[i][j][0], acc[i][j][1], acc[i][j][2], acc[i][j][3]);
        }
    }
  }
}

__device__ __forceinline__ int ssd_chunk_seq(int d, int b, int j) {
  if (j < 2) return 2 * b + (d ? 1 - j : j);
  int t = j - 2;
  return 16 + b * 64 + (d ? 63 - t : t);
}

__device__ __forceinline__ void phase_ssd_scan(const Params& p) {
  const int TT = opaque_tid();
  float* states = (float*)(p.ws + O_STATES);
  const float* csb = (const float*)(p.ws + O_CS);
  for (int idx = VBID * 256 + LTID; idx < 2 * 8 * 8 * 2048; idx += VGRID * 256) {
    const int q = idx & 2047, h = (idx >> 11) & 7, b = (idx >> 14) & 7, d = idx >> 17;
    auto sptr = [&](int j) -> f32x4* {
      int cidx = ssd_chunk_seq(d, b, j);
      return (f32x4*)(states + (((size_t)d * 528 + cidx) * 8 + h) * 8192) + q;
    };
    auto totof = [&](int j) -> float {
      int cidx = ssd_chunk_seq(d, b, j);
      return csb[((size_t)d * NTOK + cidx * 128 + (d ? 0 : 127)) * 8 + h];
    };
    f32x4 hh = {0.f, 0.f, 0.f, 0.f};
    f32x4 sv[4]; float tv[4];
#pragma unroll
    for (int u = 0; u < 4; ++u) { sv[u] = *sptr(u); tv[u] = totof(u); }
#pragma unroll 1
    for (int j0 = 0; j0 < 64; j0 += 4) {
      f32x4 sn[4]; float tn[4];
#pragma unroll
      for (int u = 0; u < 4; ++u) {
        const int jn = j0 + 4 + u;
        const int jc = jn < 66 ? jn : 65;
        sn[u] = *sptr(jc); tn[u] = totof(jc);
      }
#pragma unroll
      for (int u = 0; u < 4; ++u) {
        *sptr(j0 + u) = hh;
        hh = hh * __expf(tv[u]) + sv[u];
      }
#pragma unroll
      for (int u = 0; u < 4; ++u) { sv[u] = sn[u]; tv[u] = tn[u]; }
    }
#pragma unroll
    for (int u = 0; u < 2; ++u) {
      *sptr(64 + u) = hh;
      hh = hh * __expf(tv[u]) + sv[u];
    }
  }
}

__device__ __forceinline__ void phase_ssd_out(const Params& p, char* smem) {
  const int TT = opaque_tid();
  u16* P = (u16*)(p.ws + O_P);
  const float* dtb = (const float*)(p.ws + O_DT); const float* csb = (const float*)(p.ws + O_CS);
  const float* states = (const float*)(p.ws + O_STATES);
  const float* cw = p.in[I_SCW]; const float* cb = p.in[I_SCB];
  const u16* X = (const u16*)((const char*)p.out + DO_HX);
  u16* Cs = (u16*)smem;
  u16* Bs = Cs + 64 * 136;
  u16* Gs = Bs; u16* Hs = Bs + 64 * 136;
  u16* XT = Bs + 128 * 136;
  float* csf = (float*)(XT + 64 * 136);
  float* csbk = csf + 128; float* dtf = csbk + 128; float* dtbk = dtf + 128;
  const int tid = LTID, lane = tid & 63, wave = tid >> 6;
  for (int vb = VBID; vb < 528 * 16; vb += VGRID) {
    const int lh = vb & 1, h = (vb >> 1) & 7, cidx = vb >> 4, g = h >> 2;
    const int mb = cidx * 128;
    f32x4 hv[2][8];
#pragma unroll
    for (int d = 0; d < 2; ++d) {
      const float* hp = states + (((size_t)d * 528 + cidx) * 8 + h) * 8192;
#pragma unroll
      for (int i = 0; i < 8; ++i) { int item = tid + i * 256; hv[d][i] = *(const f32x4*)(hp + (item >> 5) * 128 + (item & 31) * 4); }
    }
    __syncthreads();
    if (tid < 128) {
      size_t o0 = ((size_t)0 * NTOK + mb + tid) * 8 + h, o1 = ((size_t)1 * NTOK + mb + tid) * 8 + h;
      csf[tid] = csb[o0]; csbk[tid] = csb[o1]; dtf[tid] = dtb[o0]; dtbk[tid] = dtb[o1];
    }
#pragma unroll
    for (int i = 0; i < 4; ++i) {
      int item = tid + i * 256; int cg = item & 15, l = item >> 4;
      *(u32x4*)(Cs + l * 136 + cg * 8) = *(const u32x4*)(X + (size_t)(mb + lh * 64 + l) * 1024 + 768 + g * 128 + cg * 8);
    }
#pragma unroll
    for (int i = 0; i < 8; ++i) {
      int item = tid + i * 256; int cg = item & 15, sidx = item >> 4;
      *(u32x4*)(Bs + sidx * 136 + cg * 8) = *(const u32x4*)(X + (size_t)(mb + sidx) * 1024 + 512 + g * 128 + cg * 8);
    }
#pragma unroll
    for (int i = 0; i < 2; ++i) {
      int item = tid + i * 256; int lp = item & 63, cg = item >> 6;
      int l0 = 2 * lp;
      const u16* xp = X + (size_t)(mb + l0) * 1024 + h * 64 + cg * 8;
      u32x4 x0 = *(const u32x4*)xp, x1 = *(const u32x4*)(xp + 1024);
#pragma unroll
      for (int e = 0; e < 4; ++e) {
        *(unsigned*)(XT + (cg * 8 + 2 * e) * 136 + l0) = (x0[e] & 0xffffu) | (x1[e] << 16);
        *(unsigned*)(XT + (cg * 8 + 2 * e + 1) * 136 + l0) = (x0[e] >> 16) | (x1[e] & 0xffff0000u);
      }
    }
    __syncthreads();
    f32x4 cbacc[8];
#pragma unroll
    for (int t = 0; t < 8; ++t) cbacc[t] = (f32x4){0, 0, 0, 0};
#pragma unroll 1
    for (int kk = 0; kk < 128; kk += 32) {
      bf16x8 af = ldfrag(Cs, 136, wave * 16, kk, lane);
#pragma unroll
      for (int t = 0; t < 8; ++t) cbacc[t] = mma(af, ldfrag(Bs, 136, t * 16, kk, lane), cbacc[t]);
    }
    __syncthreads();
    const int lloc = wave * 16 + (lane & 15);
    const int l = lh * 64 + lloc;
    const float cfl = csf[l], cbl = csbk[l];
#pragma unroll 2
    for (int t = 0; t < 8; ++t) {
      float gv[4];
#pragma unroll
      for (int j = 0; j < 4; ++j) {
        int s = t * 16 + (lane >> 4) * 4 + j;
        float f = 0.f;
        if (s <= l) f += __expf(cfl - csf[s]) * dtf[s];
        if (s >= l) f += __expf(cbl - csbk[s]) * dtbk[s];
        gv[j] = cbacc[t][j] * f;
      }
      *(uint2*)(Gs + lloc * 136 + t * 16 + (lane >> 4) * 4) = pack4(gv[0], gv[1], gv[2], gv[3]);
    }
    __syncthreads();
    f32x4 yacc[4];
#pragma unroll
    for (int t = 0; t < 4; ++t) yacc[t] = (f32x4){0, 0, 0, 0};
#pragma unroll 1
    for (int kk = 0; kk < 128; kk += 32) {
      bf16x8 af = ldfrag(Gs, 136, wave * 16, kk, lane);
#pragma unroll
      for (int t = 0; t < 4; ++t) yacc[t] = mma(af, ldfrag(XT, 136, t * 16, kk, lane), yacc[t]);
    }
#pragma unroll
    for (int d = 0; d < 2; ++d) {
      __syncthreads();
#pragma unroll
      for (int i = 0; i < 8; ++i) {
        int item = tid + i * 256;
        int pp = item >> 5, n4 = (item & 31) * 4;
        *(uint2*)(Hs + pp * 136 + n4) = pack4(hv[d][i][0], hv[d][i][1], hv[d][i][2], hv[d][i][3]);
      }
      __syncthreads();
      f32x4 ia[4];
#pragma unroll
      for (int t = 0; t < 4; ++t) ia[t] = (f32x4){0, 0, 0, 0};
#pragma unroll 1
      for (int kk = 0; kk < 128; kk += 32) {
        bf16x8 af = ldfrag(Cs, 136, wave * 16, kk, lane);
#pragma unroll
        for (int t = 0; t < 4; ++t) ia[t] = mma(af, ldfrag(Hs, 136, t * 16, kk, lane), ia[t]);
      }
      float sc = __expf(d ? cbl : cfl);
#pragma unroll
      for (int t = 0; t < 4; ++t)
#pragma unroll
        for (int j = 0; j < 4; ++j) yacc[t][j] += sc * ia[t][j];
    }
    const float Dh = p.in[I_SD][h];
    const int m = mb + l;
#pragma unroll
    for (int t = 0; t < 4; ++t) {
      int p0 = t * 16 + (lane >> 4) * 4;
      float o[4];
#pragma unroll
      for (int j = 0; j < 4; ++j) o[j] = yacc[t][j] + Dh * bf2f(XT[(p0 + j) * 136 + l]);
      *(uint2*)(P + (size_t)m * PW + 1024 + h * 64 + p0) = pack4(o[0], o[1], o[2], o[3]);
    }
  }
}

__device__ __forceinline__ void phase_finish(const Params& p) {
  const int TT = opaque_tid();
  const u16* __restrict__ P = (const u16*)(p.ws + O_P);
  const u16* __restrict__ Sv = (const u16*)(p.ws + O_SV);
  const u16* __restrict__ G = (const u16*)((const char*)p.out + DO_G);
  const float* __restrict__ bonus = (const float*)(p.ws + O_BONUS);
  u16* __restrict__ mixed = (u16*)(p.ws + O_MIXED);
  const int lane = LTID & 63, wv = LTID >> 6;
  const int h = lane >> 3, c = h * 64 + (lane & 7) * 8;
  float lnw[8], lnb[8], nw[8];
  load8f(p.in[I_LNW] + c, lnw); load8f(p.in[I_LNB] + c, lnb); load8f(p.in[I_SNW] + c, nw);
#pragma unroll 2
  for (int m = VBID * 4 + wv; m < NTOK; m += VGRID * 4) {
    const u16* row = P + (size_t)m * PW;
    float yf[8], yb[8], sv[8], gg[8], ys[8], z[8];
    unpack8(*(const u32x4*)(row + c), yf);
    unpack8(*(const u32x4*)(row + 512 + c), yb);
    unpack8(*(const u32x4*)(Sv + (size_t)m * 512 + c), sv);
    unpack8(*(const u32x4*)(G + (size_t)m * 512 + c), gg);
    unpack8(*(const u32x4*)(row + 1024 + c), ys);
    unpack8(*(const u32x4*)(row + 1920 + c), z);
    const float bn = bonus[m * 8 + h];
    float sum = 0.f;
#pragma unroll
    for (int i = 0; i < 8; ++i) { yf[i] += yb[i]; sum += yf[i]; }
    const float mean = red8(sum) * (1.f / 64.f);
    float vs = 0.f;
#pragma unroll
    for (int i = 0; i < 8; ++i) { yf[i] -= mean; vs += yf[i] * yf[i]; }
    const float rs = rsqrtf(red8(vs) * (1.f / 64.f) + 64e-5f);
    float o1[8], t[8]; float ss = 0.f;
#pragma unroll
    for (int i = 0; i < 8; ++i) {
      o1[i] = (yf[i] * rs * lnw[i] + lnb[i] + bn * sv[i]) * gg[i];
      t[i] = ys[i] * siluf_(z[i]);
      ss += t[i] * t[i];
    }
    ss = wave_sum(ss);
    const float rstd = rsqrtf(ss * (1.f / 512.f) + 1e-6f);
#pragma unroll
    for (int i = 0; i < 8; ++i) t[i] = t[i] * rstd * nw[i];
    *(u32x4*)(mixed + (size_t)m * 1024 + c) = pack8(o1);
    *(u32x4*)(mixed + (size_t)m * 1024 + 512 + c) = pack8(t);
  }
}

__device__ __forceinline__ void phase_ffnconv(const Params& p, int layer, int r0) {
  const int TT = opaque_tid();
  u16* GV = (u16*)(p.ws + O_GV);
  const float* cw = p.in[I_FCW] + (size_t)layer * 9 * 2816;
  const float* cb = p.in[I_FCB] + (size_t)layer * 2816;
  (void)TT;
  const int xcd = blockIdx.x & 7;
  const int lt = (int)(blockIdx.x >> 3) * 512 + (int)threadIdx.x;
  const int ngrp = (int)((gridDim.x >> 3) * 512) / 44;
  if (lt >= ngrp * 44) return;
  const int j = (xcd * 44 + lt % 44) * 8, tl = lt / 44;
  float w[9][8], bias[8];
#pragma unroll
  for (int k = 0; k < 9; ++k) load8f(cw + k * 2816 + j, w[k]);
  load8f(cb + j, bias);
  const u32x4 z4 = {0u, 0u, 0u, 0u};
#pragma unroll 1
  for (int m0 = r0 + tl; m0 < NTOK; m0 += 2 * ngrp) {
    u32x4 g[2][9]; u32x4 vq[2];
#pragma unroll
    for (int q = 0; q < 2; ++q) {
      const int m = (m0 + q * ngrp < NTOK) ? m0 + q * ngrp : m0;
      const bool isctx = m < NCTX;
      const int t = isctx ? (m & 255) : ((m - NCTX) & 8191);
      const int rr = t >> 6, cc = t & 63;
#pragma unroll
      for (int dy = -1; dy <= 1; ++dy)
#pragma unroll
        for (int dx = -1; dx <= 1; ++dx) {
          const int k = (dy + 1) * 3 + dx + 1;
          const bool valid = isctx ? (dy == 0 && t + dx >= 0 && t + dx < 256)
                                   : (rr + dy >= 0 && rr + dy < 128 && cc + dx >= 0 && cc + dx < 64);
          const int mm = valid ? m + dy * 64 + dx : m;
          u32x4 qv = *(const u32x4*)(GV + (size_t)mm * 5632 + j);
          g[q][k] = valid ? qv : z4;
        }
      vq[q] = *(const u32x4*)(GV + (size_t)m * 5632 + 2816 + j);
    }
    asm volatile("" ::: "memory");
#pragma unroll
    for (int q = 0; q < 2; ++q) {
      const int m = m0 + q * ngrp;
      if (m < NTOK) {
        float acc[8];
#pragma unroll
        for (int i = 0; i < 8; ++i) acc[i] = bias[i];
#pragma unroll
        for (int k = 0; k < 9; ++k)
#pragma unroll
          for (int e = 0; e < 4; ++e) {
            acc[2 * e] += w[k][2 * e] * XLO(g[q][k][e]);
            acc[2 * e + 1] += w[k][2 * e + 1] * XHI(g[q][k][e]);
          }
        float o[8];
#pragma unroll
        for (int e = 0; e < 4; ++e) {
          o[2 * e] = geluf_(acc[2 * e]) * XLO(vq[q][e]);
          o[2 * e + 1] = geluf_(acc[2 * e + 1]) * XHI(vq[q][e]);
        }
        *(u32x4*)(GV + (size_t)m * 5632 + 2816 + j) = pack8(o);
      }
    }
  }
}

__device__ __forceinline__ void phase_rope(const Params& p) {
  const int TT = opaque_tid();
  u16* QKV = (u16*)(p.ws + O_QKV);
  const float* rope = (const float*)(p.ws + O_ROPE);
  const int total = NLAT * 128;
  const int nthr = VGRID * 256;
  for (int idx0 = VBID * 256 + LTID; idx0 < total; idx0 += nthr * 4) {
    u32x4 a[4], bq[4];
#pragma unroll
    for (int u = 0; u < 4; ++u) {
      const int idx = idx0 + u * nthr;
      if (idx >= total) continue;
      const int t = idx >> 7, r = idx & 127;
      const int jg = r & 7, hh = (r >> 3) & 7, qk = r >> 6;
      const u16* base = QKV + (size_t)(NCTX + t) * 4096 + qk * 1024 + hh * 128 + jg * 8;
      a[u] = *(const u32x4*)base; bq[u] = *(const u32x4*)(base + 64);
    }
    asm volatile("" ::: "memory");
#pragma unroll
    for (int u = 0; u < 4; ++u) {
      const int idx = idx0 + u * nthr;
      if (idx >= total) continue;
      const int t = idx >> 7, r = idx & 127;
      const int jg = r & 7, hh = (r >> 3) & 7, qk = r >> 6;
      const int pos = t & 8191, prow = pos >> 6, pcol = pos & 63;
      const int j = jg * 8;
      u16* base = QKV + (size_t)(NCTX + t) * 4096 + qk * 1024 + hh * 128 + j;
      float x1[8], x2[8], o1[8], o2[8];
      unpack8(a[u], x1); unpack8(bq[u], x2);
      const float* ct = j < 32 ? rope + prow * 32 + j : rope + 8192 + pcol * 32 + j - 32;
      const float* stb = j < 32 ? rope + 4096 + prow * 32 + j : rope + 8192 + 2048 + pcol * 32 + j - 32;
      float cs[8], sn[8];
      load8f(ct, cs); load8f(stb, sn);
#pragma unroll
      for (int i = 0; i < 8; ++i) { o1[i] = x1[i] * cs[i] - x2[i] * sn[i]; o2[i] = x2[i] * cs[i] + x1[i] * sn[i]; }
      *(u32x4*)base = pack8(o1);
      *(u32x4*)(base + 64) = pack8(o2);
    }
  }
}

typedef short s16x4 __attribute__((ext_vector_type(4)));
__device__ __forceinline__ bf16x8 ldfrag_tr(const u16* X, int stride, int row0, int k0, int lane) {
  const int li = lane & 15, g = lane >> 4;
  const u16* pp = X + (k0 + g * 8 + (li >> 2)) * stride + row0 + (li & 3) * 4;
  const s16x4 lo = __builtin_amdgcn_ds_read_tr16_b64_v4i16((__attribute__((address_space(3))) s16x4*)pp);
  const s16x4 hi = __builtin_amdgcn_ds_read_tr16_b64_v4i16((__attribute__((address_space(3))) s16x4*)(pp + 4 * stride));
  return (bf16x8){lo[0], lo[1], lo[2], lo[3], hi[0], hi[1], hi[2], hi[3]};
}
__device__ __forceinline__ bf16x8 ldfrag_tr_acc(const u16* X, int stride, int row0, int k0, int lane) {
  const int li = lane & 15, g = lane >> 4;
  const u16* pp = X + (k0 + g * 4 + (li >> 2)) * stride + row0 + (li & 3) * 4;
  const s16x4 lo = __builtin_amdgcn_ds_read_tr16_b64_v4i16((__attribute__((address_space(3))) s16x4*)pp);
  const s16x4 hi = __builtin_amdgcn_ds_read_tr16_b64_v4i16((__attribute__((address_space(3))) s16x4*)(pp + 16 * stride));
  return (bf16x8){lo[0], lo[1], lo[2], lo[3], hi[0], hi[1], hi[2], hi[3]};
}
__device__ __forceinline__ void phase_retention(const Params& p, char* smem) {
  const u16* QKV = (const u16*)(p.ws + O_QKV);
  u16* Y = (u16*)(p.ws + O_Y);
  u16* Qs = (u16*)smem;
  u16* Ks = Qs + 64 * 136;
  u16* Vs = Ks + 64 * 136;
  u16* Vs2 = Vs + 64 * 72;
  u16* Sb = Vs2 + 64 * 72;
  u16* Pm = Sb + 64 * 136;
  const int tid = opaque_tid(), lane = tid & 63, wave = tid >> 6;
  const int quad = lane >> 4, l16 = lane & 15;
  const int rt = wave & 3, chf = wave >> 2;
  for (int vb = blockIdx.x; vb < 256; vb += gridDim.x) {
    const int xq_ = vb >> 3, bh_ = (vb & 7) * 8 + (xq_ >> 2);
    const int b = bh_ >> 3, h = bh_ & 7, sl = xq_ & 3;
#pragma unroll 1
    for (int d = 0; d < 2; ++d) {
      const float l2 = d ? p.in[I_L2B][h] : p.in[I_L2F][h];
      const float lg = log1pf(-exp2f(-l2));
      const float gC = __expf(lg * 64.f);
      f32x4 st[4];
#pragma unroll
      for (int t = 0; t < 4; ++t) st[t] = (f32x4){0, 0, 0, 0};
      u32x4 rqA[2], rkA[2], rvA, rqB[2], rkB[2], rvB;
      auto chunk_m0 = [&](int cs_) { return d ? scan_tok(1, b, cs_ * 64 + 63) : scan_tok(0, b, cs_ * 64); };
      auto gload = [&](int cs_, u32x4 (&rq)[2], u32x4 (&rk)[2], u32x4& rv) {
        int m0 = chunk_m0(cs_);
#pragma unroll
        for (int i = 0; i < 2; ++i) {
          int item = tid + i * 512; int row = item & 63, c8 = (item >> 6) * 8;
          const u16* bp = QKV + (size_t)(m0 + row) * 4096 + h * 128 + c8;
          rq[i] = *(const u32x4*)bp;
          rk[i] = *(const u32x4*)(bp + 1024);
        }
        {
          int row = tid & 63, c8 = (tid >> 6) * 8;
          rv = *(const u32x4*)(QKV + (size_t)(m0 + row) * 4096 + 2048 + h * 256 + sl * 64 + c8);
        }
      };
      auto sstore = [&](const u32x4 (&rq)[2], const u32x4 (&rk)[2], const u32x4& rv) {
#pragma unroll
        for (int i = 0; i < 2; ++i) {
          int item = tid + i * 512; int row = item & 63, c8 = (item >> 6) * 8;
          *(u32x4*)(Qs + row * 136 + c8) = rq[i];
          *(u32x4*)(Ks + row * 136 + c8) = rk[i];
        }
        {
          int row = tid & 63, c8 = (tid >> 6) * 8;
          const float ke = __expf(lg * (float)(d ? row : 63 - row));
          *(u32x4*)(Vs + row * 72 + c8) = rv;
          u32x4 sv_;
#pragma unroll
          for (int e = 0; e < 4; ++e) sv_[e] = pack2(bf2f((u16)(rv[e] & 0xffff)) * ke, bf2f((u16)(rv[e] >> 16)) * ke);
          *(u32x4*)(Vs2 + row * 72 + c8) = sv_;
        }
#pragma unroll
        for (int t = 0; t < 4; ++t)
          *(uint2*)(Sb + (rt * 16 + l16) * 136 + (4 * chf + t) * 16 + quad * 4) = pack4(st[t][0], st[t][1], st[t][2], st[t][3]);
      };
      gload(0, rqA, rkA, rvA);
      gload(1, rqB, rkB, rvB);
      auto body = [&](int cs_, u32x4 (&rq)[2], u32x4 (&rk)[2], u32x4& rv) {
        const int m0 = chunk_m0(cs_);
        __syncthreads();
        sstore(rq, rk, rv);
        __syncthreads();
        u16* const ypb = Y + (size_t)(m0 + rt * 16 + l16 - NCTX) * 2048 + h * 256 + sl * 64 + quad * 4;
        uint2 yprev[2] = {make_uint2(0u, 0u), make_uint2(0u, 0u)};
        if (d && m0 >= NCTX) {
#pragma unroll
          for (int t = 0; t < 2; ++t) yprev[t] = *(const uint2*)(ypb + (2 * chf + t) * 16);
        }
        if (cs_ + 2 < 132) gload(cs_ + 2, rq, rk, rv);
        f32x4 sc[4];
#pragma unroll
        for (int t = 0; t < 4; ++t) sc[t] = (f32x4){0, 0, 0, 0};
#pragma unroll
        for (int kk = 0; kk < 128; kk += 32) {
          bf16x8 af = ldfrag(Qs, 136, rt * 16, kk, lane);
#pragma unroll
          for (int t = 0; t < 4; ++t) sc[t] = mma(af, ldfrag(Ks, 136, t * 16, kk, lane), sc[t]);
        }
        const int l = rt * 16 + l16;
        unsigned pk[4][2];
#pragma unroll
        for (int t = 0; t < 4; ++t) {
          float pv[4];
#pragma unroll
          for (int j = 0; j < 4; ++j) {
            int s_ = t * 16 + quad * 4 + j;
            int dist = d ? s_ - l : l - s_;
            pv[j] = dist >= 0 ? sc[t][j] * __expf(lg * (float)dist) : 0.f;
          }
          pk[t][0] = pack2(pv[0], pv[1]); pk[t][1] = pack2(pv[2], pv[3]);
        }
        f32x4 ya[2], yi[2];
#pragma unroll
        for (int t = 0; t < 2; ++t) { ya[t] = (f32x4){0, 0, 0, 0}; yi[t] = (f32x4){0, 0, 0, 0}; }
#pragma unroll
        for (int ks = 0; ks < 2; ++ks) {
          const u32x4 pw = {pk[2 * ks][0], pk[2 * ks][1], pk[2 * ks + 1][0], pk[2 * ks + 1][1]};
          bf16x8 af = __builtin_bit_cast(bf16x8, pw);
#pragma unroll
          for (int t = 0; t < 2; ++t) ya[t] = mma(af, ldfrag_tr_acc(Vs, 72, (2 * chf + t) * 16, ks * 32, lane), ya[t]);
        }
#pragma unroll
        for (int kk = 0; kk < 128; kk += 32) {
          bf16x8 af = ldfrag(Qs, 136, rt * 16, kk, lane);
#pragma unroll
          for (int t = 0; t < 2; ++t) yi[t] = mma(af, ldfrag(Sb, 136, (2 * chf + t) * 16, kk, lane), yi[t]);
        }
#pragma unroll
        for (int t = 0; t < 4; ++t) { st[t][0] *= gC; st[t][1] *= gC; st[t][2] *= gC; st[t][3] *= gC; }
#pragma unroll
        for (int kk = 0; kk < 64; kk += 32) {
          bf16x8 af = ldfrag_tr(Vs2, 72, rt * 16, kk, lane);
#pragma unroll
          for (int t = 0; t < 4; ++t) st[t] = mma(af, ldfrag_tr(Ks, 136, (4 * chf + t) * 16, kk, lane), st[t]);
        }
        if (m0 >= NCTX) {
          const float qd = __expf(lg * (float)(d ? 64 - l : l + 1));
          u16* yp = Y + (size_t)(m0 + l - NCTX) * 2048 + h * 256 + sl * 64 + quad * 4;
#pragma unroll
          for (int t = 0; t < 2; ++t) {
            float o[4];
#pragma unroll
            for (int j = 0; j < 4; ++j) o[j] = ya[t][j] + qd * yi[t][j];
            u16* yq = yp + (2 * chf + t) * 16;
            if (d) {
              const uint2 prev = yprev[t];
              o[0] += bf2f((u16)(prev.x & 0xffff)); o[1] += bf2f((u16)(prev.x >> 16));
              o[2] += bf2f((u16)(prev.y & 0xffff)); o[3] += bf2f((u16)(prev.y >> 16));
            }
            *(uint2*)yq = pack4(o[0], o[1], o[2], o[3]);
          }
        }
      };
#pragma unroll 1
      for (int cs_ = 0; cs_ < 132; cs_ += 2) {
        body(cs_, rqA, rkA, rvA);
        body(cs_ + 1, rqB, rkB, rvB);
      }
    }
  }
}

__device__ __forceinline__ void phase_ynorm(const Params& p) {
  const int TT = opaque_tid();
  const u16* __restrict__ Y = (const u16*)(p.ws + O_Y);
  float* __restrict__ rstd = (float*)(p.ws + O_RSTD);
  const int lane = LTID & 63, wv = LTID >> 6;
#pragma unroll 2
  for (int m = VBID * 4 + wv; m < NLAT; m += VGRID * 4) {
#pragma unroll
    for (int h = 0; h < 8; ++h) {
      uint2 q = *(const uint2*)(Y + (size_t)m * 2048 + h * 256 + lane * 4);
      float a = bf2f((u16)(q.x & 0xffff)), b2 = bf2f((u16)(q.x >> 16)), c = bf2f((u16)(q.y & 0xffff)), d = bf2f((u16)(q.y >> 16));
      float ss = wave_sum(a * a + b2 * b2 + c * c + d * d);
      if (lane == 0) rstd[m * 8 + h] = rsqrtf(ss * (1.f / 256.f) + 1e-6f);
    }
  }
}

__device__ __forceinline__ void phase_final(const Params& p) {
  const int TT = opaque_tid();
  const float* g = p.in[I_FNG];
  const int lane = LTID & 63, wv = LTID >> 6;
  for (int m = (VBID * 4 + wv) * 2; m < NLAT; m += VGRID * 8) {
    float4 v[2][4]; float ss[2] = {0.f, 0.f};
#pragma unroll
    for (int q = 0; q < 2; ++q)
#pragma unroll
      for (int i = 0; i < 4; ++i) v[q][i] = *(const float4*)(p.out + (size_t)(m + q) * 1024 + i * 256 + lane * 4);
#pragma unroll
    for (int q = 0; q < 2; ++q) {
#pragma unroll
      for (int i = 0; i < 4; ++i) ss[q] += v[q][i].x * v[q][i].x + v[q][i].y * v[q][i].y + v[q][i].z * v[q][i].z + v[q][i].w * v[q][i].w;
      ss[q] = wave_sum(ss[q]);
    }
#pragma unroll
    for (int q = 0; q < 2; ++q) {
      const float rstd = rsqrtf(ss[q] * (1.f / 1024.f) + 1e-6f);
#pragma unroll
      for (int i = 0; i < 4; ++i) {
        int c = i * 256 + lane * 4;
        float4 gg = *(const float4*)(g + c);
        *(float4*)(p.out + (size_t)(m + q) * 1024 + c) = make_float4(v[q][i].x * rstd * gg.x, v[q][i].y * rstd * gg.y, v[q][i].z * rstd * gg.z, v[q][i].w * rstd * gg.w);
      }
    }
  }
}

#define XB_TMO      128
#define XB_XCNT(j)  (256  + 64 * (j))
#define XB_XSUB(j)  (1280 + 64 * (j))
#define XB_XGEN(j)  (2304 + 64 * (j))
#define XB_TOP      3328
#define XB_TOPGEN   3392
#define XCD_BAR_WORDS 3456
#define XB_SPIN_CAP (1u << 22)
#define LAS __attribute__((address_space(3)))
__device__ __forceinline__ unsigned xb_ld(unsigned* p)              { return __hip_atomic_load(p, __ATOMIC_RELAXED, __HIP_MEMORY_SCOPE_AGENT); }
__device__ __forceinline__ unsigned xb_add(unsigned* p, unsigned v) { return __hip_atomic_fetch_add(p, v, __ATOMIC_RELAXED, __HIP_MEMORY_SCOPE_AGENT); }
__device__ __forceinline__ unsigned xb_xcc_id() { return (unsigned)__builtin_amdgcn_s_getreg((3 << 11) | 20) & 0xFu; }
#define XB_SPIN(cond, bar) do { unsigned _sp = 0; while (cond) { __builtin_amdgcn_s_sleep(1); \
    if ((++_sp & 255u) == 0u) { if (xb_ld(&(bar)[XB_TMO])) break; if (_sp > XB_SPIN_CAP) { atomicAdd(&(bar)[XB_TMO], 1u); break; } } } } while (0)
struct XcdBarrier { unsigned* bar; unsigned x; volatile LAS unsigned* st; };
__device__ __forceinline__ XcdBarrier xcd_barrier_post(unsigned* bar, volatile LAS unsigned* st) {
  XcdBarrier b; b.bar = bar; b.x = xb_xcc_id(); b.st = st;
  if (threadIdx.x == 0) (void)xb_add(&bar[XB_XCNT(b.x)], 1u);
  return b;
}
__device__ __forceinline__ void xcd_barrier_complete(unsigned* bar, unsigned x, unsigned& nloc, unsigned& nx) {
  const unsigned G = gridDim.x * gridDim.y * gridDim.z;
  unsigned sum, cnt, mine, sp = 0u;
  for (;;) {
    sum = 0u; cnt = 0u; mine = 0u;
#pragma unroll
    for (unsigned j = 0; j < 16; ++j) { const unsigned c = xb_ld(&bar[XB_XCNT(j)]); sum += c; cnt += (c > 0u) ? 1u : 0u; mine = (j == x) ? c : mine; }
    if (sum == G) break;
    __builtin_amdgcn_s_sleep(1);
    if ((++sp & 255u) == 0u) { if (xb_ld(&bar[XB_TMO])) break; if (sp > XB_SPIN_CAP) { atomicAdd(&bar[XB_TMO], 1u); break; } }
  }
  nloc = mine > 0u ? mine : 1u; nx = cnt > 0u ? cnt : 1u;
}
__device__ __forceinline__ void xcd_barrier(const XcdBarrier& b) {
  asm volatile("s_waitcnt vmcnt(0)" ::: "memory");
  __syncthreads();
  if (threadIdx.x == 0) {
    unsigned* bar = b.bar;
    __builtin_amdgcn_s_waitcnt(0);
    unsigned nloc = b.st[0], nx = b.st[1];
    if (nloc == 0u) { xcd_barrier_complete(bar, b.x, nloc, nx); b.st[0] = nloc; b.st[1] = nx; }
    const unsigned old = xb_add(&bar[XB_XSUB(b.x)], 1u);
    const unsigned gen = old / nloc;
    if (old + 1u == (gen + 1u) * nloc) {
      __builtin_amdgcn_fence(__ATOMIC_RELEASE, "agent");
      asm volatile("s_waitcnt vmcnt(0)" ::: "memory");
      const unsigned og = xb_add(&bar[XB_TOP], 1u);
      const unsigned tg = og / nx;
      if (og + 1u == (tg + 1u) * nx) xb_add(&bar[XB_TOPGEN], 1u);
      else XB_SPIN(xb_ld(&bar[XB_TOPGEN]) == tg, bar);
      __builtin_amdgcn_fence(__ATOMIC_ACQUIRE, "agent");
      xb_add(&bar[XB_XGEN(b.x)], 1u);
      asm volatile("s_waitcnt vmcnt(0)" ::: "memory");
    } else {
      XB_SPIN(xb_ld(&bar[XB_XGEN(b.x)]) == gen, bar);
      __builtin_amdgcn_fence(__ATOMIC_ACQUIRE, "agent");
      asm volatile("s_waitcnt vmcnt(0)" ::: "memory");
    }
  }
  __syncthreads();
}

#ifndef PHMASK
#define PHMASK 0xFFFFFFFFFFFFFFFFull
#endif
#ifndef PHREP
#define PHREP 0ull
#endif
namespace pg8 {
#define PG8_LAS __attribute__((address_space(3)))
constexpr int BM = 256, BK = 64, HALF = 128, HTB = HALF * BK * 2, STAGE_BYTES = 8 * HTB, NXCD = 8, WGM = 4;
__device__ __forceinline__ int lds_byte(int r, int c) { const int st = (r >> 4) * 2 + (c >> 5), rr = r & 15, cc = c & 31, ob = rr * 64 + cc * 2; return st * 1024 + (ob ^ (((ob >> 9) & 1) << 5)); }
__device__ __forceinline__ void stage_rc(int b, int& R, int& C) { const int st = b / 1024, sb = b % 1024, swz = sb ^ (((sb >> 9) & 1) << 5); R = (st >> 1) * 16 + swz / 64; C = (st & 1) * 32 + (swz % 64) / 2; }
__device__ __forceinline__ int perm32(int rho) { const int n = rho >> 4, i = rho & 15; return 8 * (i >> 2) + 4 * n + (i & 3); }
struct Unit { int pm, pn; };
struct Gemm { const u16* A; const u16* Bt; int M, N, K, lda; };
struct StaticOrder {
  int nM, nN, nwg, G, c;
  __device__ void init(int M, int N, int G_, int c_) { nM = M / BM; nN = N / BM; nwg = nM * nN; G = G_; c = c_; }
  __device__ bool next(int i, Unit& u) const {
    const long L = (long)i * G + c; if (L >= nwg) return false;
    int wgid = (int)L; { const int q = nwg / NXCD, r = nwg % NXCD, xcd = wgid % NXCD, off = wgid / NXCD; wgid = (xcd < r ? xcd * (q + 1) : r * (q + 1) + (xcd - r) * q) + off; }
    const int nig = WGM * nN, gid = wgid / nig, fm = gid * WGM, gsz = (nM - fm) < WGM ? (nM - fm) : WGM;
    u.pm = fm + ((wgid % nig) % gsz); u.pn = (wgid % nig) / gsz; return true;
  }
};
template <class Epi>
__device__ __forceinline__ void gemm_phase(PG8_LAS unsigned char* lds, const Gemm g, const StaticOrder& S, const Epi& E) {
  const int tid = opaque_tid(), wid = __builtin_amdgcn_readfirstlane(tid >> 6), lane = tid & 63, wr = wid >> 2, wc = wid & 3, fr = lane & 15, fq = lane >> 4;
  const int K = g.K, nt = K / BK;
  unsigned voffA[2], voffB[2];
#pragma unroll
  for (int i = 0; i < 2; ++i) { int R, C; stage_rc(tid * 16 + i * 8192, R, C);
    const int Rb = Epi::PERM ? ((R & ~31) + perm32(R & 31)) : R;
    voffA[i] = (unsigned)(R * g.lda + C) * 2u; voffB[i] = (unsigned)(Rb * K + C) * 2u; }
  const size_t kstep = (size_t)(BK * 2);
  const size_t hstepA = (size_t)HALF * g.lda * 2, hstepB = (size_t)HALF * K * 2;
  const size_t tstepA = 2 * hstepA, tstepB = 2 * hstepB;
  const unsigned ldsw = (unsigned)wid * 1024u;
  const int aoff = lds_byte(wr * 64 + fr, fq * 8), boff = lds_byte(wc * 32 + fr, fq * 8);
#define PG8_SA(b, h) (((b) * 2 + (h)) * HTB)
#define PG8_SB(b, h) ((4 + (b) * 2 + (h)) * HTB)
#define PG8_STAGE(bufoff, gbase, voff) do { _Pragma("unroll") for (int _i = 0; _i < 2; ++_i) \
        __builtin_amdgcn_global_load_lds((const unsigned*)((const char*)(gbase) + (voff)[_i]), (PG8_LAS unsigned*)(lds + (bufoff) + ldsw + _i * 8192), 16, 0, 0); } while (0)
#define PG8_LDA(dst, b, h) do { _Pragma("unroll") for (int m = 0; m < 4; ++m) _Pragma("unroll") for (int k = 0; k < 2; ++k) dst[m][k] = *(const PG8_LAS bf16x8*)(lds + PG8_SA(b, h) + aoff + m * 2048 + k * 1024); } while (0)
#define PG8_LDB(dst, b, h) do { _Pragma("unroll") for (int n = 0; n < 2; ++n) _Pragma("unroll") for (int k = 0; k < 2; ++k) dst[n][k] = *(const PG8_LAS bf16x8*)(lds + PG8_SB(b, h) + boff + n * 2048 + k * 1024); } while (0)
#define PG8_MMA(ai, bj, At, Bt) do { __builtin_amdgcn_s_setprio(1); _Pragma("unroll") for (int m = 0; m < 4; ++m) _Pragma("unroll") for (int n = 0; n < 2; ++n) _Pragma("unroll") for (int k = 0; k < 2; ++k) \
        acc[ai][bj][m][n] = __builtin_amdgcn_mfma_f32_16x16x32_bf16(Bt[n][k], At[m][k], acc[ai][bj][m][n], 0, 0, 0); __builtin_amdgcn_s_setprio(0); } while (0)
#define PG8_WAIT_V(n) asm volatile("s_waitcnt vmcnt(" #n ")" ::: "memory")
#define PG8_WAIT_L(n) asm volatile("s_waitcnt lgkmcnt(" #n ")" ::: "memory")
#define PG8_BAR __builtin_amdgcn_s_barrier()
#define PG8_SCHED __builtin_amdgcn_sched_barrier(0)
  Unit cur, nxt; int ui = 0;
  if (!S.next(0, cur)) return;
  f32x4 acc[2][2][4][2];
#pragma unroll
  for (int a = 0; a < 2; ++a)
#pragma unroll
    for (int b = 0; b < 2; ++b)
#pragma unroll
      for (int m = 0; m < 4; ++m)
#pragma unroll
        for (int n = 0; n < 2; ++n) acc[a][b][m][n] = (f32x4){0.f, 0.f, 0.f, 0.f};
  bf16x8 At[4][2], B0[2][2], B1[2][2];
  const char* cA = (const char*)g.A + (size_t)cur.pm * tstepA; const char* cB = (const char*)g.Bt + (size_t)cur.pn * tstepB;
  PG8_STAGE(PG8_SB(0, 0), cB, voffB); PG8_STAGE(PG8_SA(0, 0), cA, voffA); PG8_STAGE(PG8_SB(0, 1), cB + hstepB, voffB); PG8_STAGE(PG8_SA(0, 1), cA + hstepA, voffA);
  if (wr == 1) PG8_BAR;
  PG8_WAIT_V(4); PG8_BAR;
  PG8_STAGE(PG8_SB(1, 0), cB + kstep, voffB); PG8_STAGE(PG8_SA(1, 0), cA + kstep, voffA); PG8_STAGE(PG8_SB(1, 1), cB + hstepB + kstep, voffB);
  PG8_WAIT_V(6); PG8_BAR;
  for (;;) {
    const bool has_next = S.next(ui + 1, nxt);
    const char* nA = has_next ? (const char*)g.A + (size_t)nxt.pm * tstepA : cA; const char* nB = has_next ? (const char*)g.Bt + (size_t)nxt.pn * tstepB : cB;
    for (int t = 0; t < nt; t += 2) {
      const bool last = (t == nt - 2);
      const char* a1 = cA + (size_t)(t + 1) * kstep;
      const char* a2 = last ? nA : cA + (size_t)(t + 2) * kstep; const char* b2 = last ? nB : cB + (size_t)(t + 2) * kstep;
      const char* a3 = a2 + kstep; const char* b3 = b2 + kstep;
      PG8_LDB(B0, 0, 0); PG8_SCHED; PG8_LDA(At, 0, 0); PG8_STAGE(PG8_SA(1, 1), a1 + hstepA, voffA);
      PG8_WAIT_L(8); PG8_BAR; PG8_WAIT_L(0); PG8_MMA(0, 0, At, B0); PG8_BAR; PG8_SCHED;
      PG8_LDB(B1, 0, 1); PG8_STAGE(PG8_SB(0, 0), b2, voffB);
      PG8_BAR; PG8_WAIT_L(0); PG8_MMA(0, 1, At, B1); PG8_BAR;
      PG8_LDA(At, 0, 1); PG8_STAGE(PG8_SA(0, 0), a2, voffA);
      PG8_BAR; PG8_WAIT_L(0); PG8_MMA(1, 0, At, B0); PG8_BAR; PG8_SCHED;
      PG8_STAGE(PG8_SB(0, 1), b2 + hstepB, voffB);
      PG8_WAIT_V(6); PG8_BAR; PG8_MMA(1, 1, At, B1); PG8_BAR;
      PG8_LDB(B0, 1, 0); PG8_SCHED; PG8_LDA(At, 1, 0); PG8_STAGE(PG8_SA(0, 1), a2 + hstepA, voffA);
      PG8_WAIT_L(8); PG8_BAR; PG8_WAIT_L(0); PG8_MMA(0, 0, At, B0); PG8_BAR; PG8_SCHED;
      PG8_LDB(B1, 1, 1); PG8_STAGE(PG8_SB(1, 0), b3, voffB);
      PG8_BAR; PG8_WAIT_L(0); PG8_MMA(0, 1, At, B1); PG8_BAR;
      PG8_LDA(At, 1, 1); PG8_STAGE(PG8_SA(1, 0), a3, voffA);
      PG8_BAR; PG8_WAIT_L(0); PG8_MMA(1, 0, At, B0); PG8_BAR; PG8_SCHED;
      PG8_STAGE(PG8_SB(1, 1), b3 + hstepB, voffB);
      PG8_WAIT_V(6); PG8_BAR; PG8_MMA(1, 1, At, B1); PG8_BAR;
    }
    E(acc, cur, wr, wc, fr, fq);
    if (!has_next) break;
#pragma unroll
    for (int a = 0; a < 2; ++a)
#pragma unroll
      for (int b = 0; b < 2; ++b)
#pragma unroll
        for (int m = 0; m < 4; ++m)
#pragma unroll
          for (int n = 0; n < 2; ++n) acc[a][b][m][n] = (f32x4){0.f, 0.f, 0.f, 0.f};
    cur = nxt; cA = nA; cB = nB; ++ui;
  }
  PG8_WAIT_V(0);
  if (wr == 0) PG8_BAR;
  PG8_BAR;
#undef PG8_SA
#undef PG8_SB
#undef PG8_STAGE
#undef PG8_LDA
#undef PG8_LDB
#undef PG8_MMA
#undef PG8_WAIT_V
#undef PG8_WAIT_L
#undef PG8_BAR
#undef PG8_SCHED
}
}

template <class Epi> struct PgEpi {
  static constexpr bool PERM = Epi::PERM;
  Epi e; int nreal;
  __device__ __forceinline__ void operator()(const f32x4 (&acc)[2][2][4][2], const pg8::Unit& u, int wr, int wc, int fr, int fq) const {
#pragma unroll
    for (int ai = 0; ai < 2; ++ai)
#pragma unroll
      for (int m = 0; m < 4; ++m) {
        const int row = u.pm * 256 + ai * 128 + wr * 64 + m * 16 + fr;
#pragma unroll
        for (int bj = 0; bj < 2; ++bj) {
          if constexpr (Epi::PERM) {
            const int col = u.pn * 256 + bj * 128 + wc * 32 + 8 * fq;
            if (col < nreal) e.store8(row, col, acc[ai][bj][m][0], acc[ai][bj][m][1]);
          } else {
#pragma unroll
            for (int n = 0; n < 2; ++n) {
              const int col = u.pn * 256 + bj * 128 + wc * 32 + n * 16 + 4 * fq;
              if (col < nreal) e(row, col, acc[ai][bj][m][n]);
            }
          }
        }
      }
  }
};
template <> struct PgEpi<EpiRes> {
  static constexpr bool PERM = false;
  EpiRes e; int nreal;
  __device__ __forceinline__ void operator()(const f32x4 (&acc)[2][2][4][2], const pg8::Unit& u, int wr, int wc, int fr, int fq) const {
    const int row0 = u.pm * 256 + e.moff;
    const int col0 = u.pn * 256 + wc * 32 + 4 * fq;
    const float* g = e.modv_l + (mod_row(row0) * 6 + e.gi) * 1024 + col0;
    f32x4 gv[2][2];
#pragma unroll
    for (int bj = 0; bj < 2; ++bj)
#pragma unroll
      for (int n = 0; n < 2; ++n) gv[bj][n] = *(const f32x4*)(g + bj * 128 + n * 16);
    const bool isctx = row0 < NCTX;
    const float* sb = isctx ? e.src_c + (size_t)row0 * 1024 : e.src_l + (size_t)(row0 - NCTX) * 1024;
    float* db = isctx ? e.dst_c + (size_t)row0 * 1024 : e.dst_l + (size_t)(row0 - NCTX) * 1024;
#pragma unroll
    for (int ai = 0; ai < 2; ++ai)
#pragma unroll
      for (int mp = 0; mp < 2; ++mp) {
        f32x4 x[2][2][2];
#pragma unroll
        for (int mi = 0; mi < 2; ++mi) {
          const size_t off = (size_t)(ai * 128 + wr * 64 + (mp * 2 + mi) * 16 + fr) * 1024 + col0;
#pragma unroll
          for (int bj = 0; bj < 2; ++bj)
#pragma unroll
            for (int n = 0; n < 2; ++n) x[mi][bj][n] = *(const f32x4*)(sb + off + bj * 128 + n * 16);
        }
        asm volatile("" ::: "memory");
#pragma unroll
        for (int mi = 0; mi < 2; ++mi) {
          const size_t off = (size_t)(ai * 128 + wr * 64 + (mp * 2 + mi) * 16 + fr) * 1024 + col0;
#pragma unroll
          for (int bj = 0; bj < 2; ++bj)
#pragma unroll
            for (int n = 0; n < 2; ++n) *(f32x4*)(db + off + bj * 128 + n * 16) = x[mi][bj][n] + gv[bj][n] * acc[ai][bj][mp * 2 + mi][n];
        }
        asm volatile("" ::: "memory");
      }
  }
};
template <> struct PgEpi<EpiGate> {
  static constexpr bool PERM = true;
  EpiGate e; int nreal;
  __device__ __forceinline__ void operator()(const f32x4 (&acc)[2][2][4][2], const pg8::Unit& u, int wr, int wc, int fr, int fq) const {
    const int col0 = u.pn * 256 + wc * 32 + 8 * fq;
    u32x4 yv[2][4][2]; float rs[2][4];
#pragma unroll
    for (int ai = 0; ai < 2; ++ai)
#pragma unroll
      for (int m = 0; m < 4; ++m) {
        const int row = u.pm * 256 + ai * 128 + wr * 64 + m * 16 + fr;
        rs[ai][m] = e.rstd[row * 8 + u.pn];
#pragma unroll
        for (int bj = 0; bj < 2; ++bj) yv[ai][m][bj] = *(const u32x4*)(e.Y + (size_t)row * 2048 + col0 + bj * 128);
      }
    asm volatile("" ::: "memory");
#pragma unroll
    for (int ai = 0; ai < 2; ++ai)
#pragma unroll
      for (int m = 0; m < 4; ++m) {
        const int row = u.pm * 256 + ai * 128 + wr * 64 + m * 16 + fr;
#pragma unroll
        for (int bj = 0; bj < 2; ++bj) {
          const f32x4 a = acc[ai][bj][m][0], b = acc[ai][bj][m][1];
          const float r = rs[ai][m];
          const u32x4 yy = yv[ai][m][bj];
          float o[8];
          o[0] = siluf_(a[0]) * XLO(yy[0]) * r; o[1] = siluf_(a[1]) * XHI(yy[0]) * r;
          o[2] = siluf_(a[2]) * XLO(yy[1]) * r; o[3] = siluf_(a[3]) * XHI(yy[1]) * r;
          o[4] = siluf_(b[0]) * XLO(yy[2]) * r; o[5] = siluf_(b[1]) * XHI(yy[2]) * r;
          o[6] = siluf_(b[2]) * XLO(yy[3]) * r; o[7] = siluf_(b[3]) * XHI(yy[3]) * r;
          *(u32x4*)(e.Y + (size_t)row * 2048 + col0 + bj * 128) = pack8(o);
        }
      }
  }
};
template <class Epi>
__device__ __forceinline__ void big_gemm(const u16* A, int lda, const u16* Bt, int M, int N, int K, Epi epi, char* smem) {
  const int npad = (N + 255) & ~255;
  pg8::StaticOrder S; S.init(M, npad, gridDim.x, blockIdx.x);
  pg8::Gemm g{A, Bt, M, npad, K, lda};
  PgEpi<Epi> E{epi, N};
  pg8::gemm_phase((PG8_LAS unsigned char*)smem, g, S, E);
  __syncthreads();
}

__global__ void __launch_bounds__(512, 2) mega(Params p) {
  extern __shared__ __attribute__((aligned(16))) char smem0[];
#define HSMEM (smem0 + (opaque_tid() >> 8) * HALF_LDS)
  cg::grid_group grid = cg::this_grid();
  volatile LAS unsigned* xst = (volatile LAS unsigned*)(smem0 + LDS_BYTES);
  if (threadIdx.x == 0) { xst[0] = 0u; xst[1] = 0u; }
  __syncthreads();
  XcdBarrier xb = xcd_barrier_post((unsigned*)(p.ws + O_BAR), xst);
  u16* W = (u16*)p.ws;
  float* modv = (float*)(p.ws + O_MODV);
  float* ctxr = (float*)(p.ws + O_CTXR);
  u16* hx0 = (u16*)((char*)p.out + DO_HX);
  u16* hx = (u16*)(p.ws + O_HX);

  for (int rep_ = 0; rep_ < (int)(((PHMASK >> 0) & 1ull) + ((PHREP >> 0) & 1ull)); ++rep_) {
  phase_prep(p, HSMEM);
  }
  grid.sync();
  for (int rep_ = 0; rep_ < (int)(((PHMASK >> 1) & 1ull) + ((PHREP >> 1) & 1ull)); ++rep_) {
  phase_norm(p.in[I_CTX], p.in[I_X], p.in[I_N1G], modv, 0, 1, hx0, 0, NTOK);
  }
  xcd_barrier(xb);
  for (int rep_ = 0; rep_ < (int)(((PHMASK >> 2) & 1ull) + ((PHREP >> 2) & 1ull)); ++rep_) {
  big_gemm(hx0, 1024, W + W_EVIN, NTOK, PW, 1024, EpiStore{(u16*)(p.ws + O_P), PW}, smem0);
  }
  xcd_barrier(xb);
  for (int rep_ = 0; rep_ < (int)(((PHMASK >> 3) & 1ull) + ((PHREP >> 3) & 1ull)); ++rep_) {
  phase_feat(p);
  phase_xbc(p);
  }
  xcd_barrier(xb);
  {
    const u16* L = (const u16*)((const char*)p.out + DO_L);
    for (int rep_ = 0; rep_ < (int)(((PHMASK >> 4) & 1ull) + ((PHREP >> 4) & 1ull)); ++rep_) {
    gemm_phase(L + 0, 384, W + W_W2F, 64, NTOK, 512, 64, EpiE{(u16*)(p.ws + O_SEF), p.in[I_W0F]}, HSMEM);
    }
    for (int rep_ = 0; rep_ < (int)(((PHMASK >> 5) & 1ull) + ((PHREP >> 5) & 1ull)); ++rep_) {
    gemm_phase(L + 64, 384, W + W_W2B, 64, NTOK, 512, 64, EpiE{(u16*)(p.ws + O_SEB), p.in[I_W0B]}, HSMEM);
    }
    for (int rep_ = 0; rep_ < (int)(((PHMASK >> 6) & 1ull) + ((PHREP >> 6) & 1ull)); ++rep_) {
    gemm_phase(L + 128, 384, W + W_A2F, 64, NTOK, 512, 64, EpiI{(u16*)(p.ws + O_SIF), p.in[I_A0F]}, HSMEM);
    }
    for (int rep_ = 0; rep_ < (int)(((PHMASK >> 7) & 1ull) + ((PHREP >> 7) & 1ull)); ++rep_) {
    gemm_phase(L + 192, 384, W + W_A2B, 64, NTOK, 512, 64, EpiI{(u16*)(p.ws + O_SIB), p.in[I_A0B]}, HSMEM);
    }
    for (int rep_ = 0; rep_ < (int)(((PHMASK >> 8) & 1ull) + ((PHREP >> 8) & 1ull)); ++rep_) {
    gemm_phase(L + 256, 384, W + W_G2, 128, NTOK, 512, 128, EpiStore{(u16*)((char*)p.out + DO_G), 512}, HSMEM);
    }
    for (int rep_ = 0; rep_ < (int)(((PHMASK >> 9) & 1ull) + ((PHREP >> 9) & 1ull)); ++rep_) {
    phase_ssd_prep(p);
    }
  }
  xcd_barrier(xb);
  for (int rep_ = 0; rep_ < (int)(((PHMASK >> 10) & 1ull) + ((PHREP >> 10) & 1ull)); ++rep_) {
  phase_rwkv(p, smem0);
  }
  xcd_barrier(xb);
  for (int rep_ = 0; rep_ < (int)(((PHMASK >> 11) & 1ull) + ((PHREP >> 11) & 1ull)); ++rep_) {
  phase_ssd_states(p, HSMEM);
  }
  xcd_barrier(xb);
  for (int rep_ = 0; rep_ < (int)(((PHMASK >> 12) & 1ull) + ((PHREP >> 12) & 1ull)); ++rep_) {
  phase_ssd_scan(p);
  }
  xcd_barrier(xb);
  for (int rep_ = 0; rep_ < (int)(((PHMASK >> 13) & 1ull) + ((PHREP >> 13) & 1ull)); ++rep_) {
  phase_ssd_out(p, HSMEM);
  }
  xcd_barrier(xb);
  for (int rep_ = 0; rep_ < (int)(((PHMASK >> 14) & 1ull) + ((PHREP >> 14) & 1ull)); ++rep_) {
  phase_finish(p);
  }
  xcd_barrier(xb);
  for (int rep_ = 0; rep_ < (int)(((PHMASK >> 15) & 1ull) + ((PHREP >> 15) & 1ull)); ++rep_) {
  big_gemm((const u16*)(p.ws + O_MIXED), 1024, W + W_EVOUT, NTOK, 1024, 1024,
             EpiRes{p.in[I_CTX], p.in[I_X], ctxr, p.out, modv, 2, 0}, smem0);
  }
  xcd_barrier(xb);
  for (int rep_ = 0; rep_ < (int)(((PHMASK >> 16) & 1ull) + ((PHREP >> 16) & 1ull)); ++rep_) {
  phase_norm(ctxr, p.out, p.in[I_N2G], modv, 3, 4, hx, 0, NTOK);
  }
  xcd_barrier(xb);
  for (int rep_ = 0; rep_ < (int)(((PHMASK >> 17) & 1ull) + ((PHREP >> 17) & 1ull)); ++rep_) {
  big_gemm(hx, 1024, W + W_UP0, NTOK, 5632, 1024, EpiStore{(u16*)(p.ws + O_GV), 5632}, smem0);
  }
  xcd_barrier(xb);
  for (int rep_ = 0; rep_ < (int)(((PHMASK >> 18) & 1ull) + ((PHREP >> 18) & 1ull)); ++rep_) {
  phase_ffnconv(p, 0, 0);
  }
  xcd_barrier(xb);
  for (int rep_ = 0; rep_ < (int)(((PHMASK >> 19) & 1ull) + ((PHREP >> 19) & 1ull)); ++rep_) {
  big_gemm((const u16*)(p.ws + O_GV) + 2816, 5632, W + W_DN0, NTOK, 1024, 2816,
             EpiRes{ctxr, p.out, ctxr, p.out, modv, 5, 0}, smem0);
  }
  xcd_barrier(xb);
  const float* modv1 = modv + 9 * 6144;
  for (int rep_ = 0; rep_ < (int)(((PHMASK >> 20) & 1ull) + ((PHREP >> 20) & 1ull)); ++rep_) {
  phase_norm(ctxr, p.out, p.in[I_N1G] + 1024, modv1, 0, 1, hx, 0, NTOK);
  }
  xcd_barrier(xb);
  for (int rep_ = 0; rep_ < (int)(((PHMASK >> 21) & 1ull) + ((PHREP >> 21) & 1ull)); ++rep_) {
  big_gemm(hx, 1024, W + W_RIN, NTOK, 4096, 1024, EpiQKV{(u16*)(p.ws + O_QKV)}, smem0);
  }
  xcd_barrier(xb);
  for (int rep_ = 0; rep_ < (int)(((PHMASK >> 22) & 1ull) + ((PHREP >> 22) & 1ull)); ++rep_) {
  phase_rope(p);
  }
  xcd_barrier(xb);
  for (int rep_ = 0; rep_ < (int)(((PHMASK >> 23) & 1ull) + ((PHREP >> 23) & 1ull)); ++rep_) {
  phase_retention(p, smem0);
  }
  xcd_barrier(xb);
  for (int rep_ = 0; rep_ < (int)(((PHMASK >> 24) & 1ull) + ((PHREP >> 24) & 1ull)); ++rep_) {
  phase_ynorm(p);
  }
  xcd_barrier(xb);
  for (int rep_ = 0; rep_ < (int)(((PHMASK >> 25) & 1ull) + ((PHREP >> 25) & 1ull)); ++rep_) {
  big_gemm(hx + (size_t)NCTX * 1024, 1024, W + W_RIN + 4096ull * 1024, NLAT, 2048, 1024,
             EpiGate{(u16*)(p.ws + O_Y), (const float*)(p.ws + O_RSTD)}, smem0);
  }
  xcd_barrier(xb);
  for (int rep_ = 0; rep_ < (int)(((PHMASK >> 26) & 1ull) + ((PHREP >> 26) & 1ull)); ++rep_) {
  big_gemm((const u16*)(p.ws + O_Y), 2048, W + W_ROUT, NLAT, 1024, 2048,
             EpiRes{ctxr, p.out, ctxr, p.out, modv1, 2, NCTX}, smem0);
  }
  xcd_barrier(xb);
  for (int rep_ = 0; rep_ < (int)(((PHMASK >> 27) & 1ull) + ((PHREP >> 27) & 1ull)); ++rep_) {
  phase_norm(ctxr, p.out, p.in[I_N2G] + 1024, modv1, 3, 4, hx, NCTX, NTOK);
  }
  xcd_barrier(xb);
  for (int rep_ = 0; rep_ < (int)(((PHMASK >> 28) & 1ull) + ((PHREP >> 28) & 1ull)); ++rep_) {
  big_gemm(hx + (size_t)NCTX * 1024, 1024, W + W_UP1, NLAT, 5632, 1024,
             EpiStore{(u16*)(p.ws + O_GV) + (size_t)NCTX * 5632, 5632}, smem0);
  }
  xcd_barrier(xb);
  for (int rep_ = 0; rep_ < (int)(((PHMASK >> 29) & 1ull) + ((PHREP >> 29) & 1ull)); ++rep_) {
  phase_ffnconv(p, 1, NCTX);
  }
  xcd_barrier(xb);
  for (int rep_ = 0; rep_ < (int)(((PHMASK >> 30) & 1ull) + ((PHREP >> 30) & 1ull)); ++rep_) {
  big_gemm((const u16*)(p.ws + O_GV) + (size_t)NCTX * 5632 + 2816, 5632, W + W_DN1, NLAT, 1024, 2816,
             EpiRes{ctxr, p.out, ctxr, p.out, modv1, 5, NCTX}, smem0);
  }
  xcd_barrier(xb);
  for (int rep_ = 0; rep_ < (int)(((PHMASK >> 31) & 1ull) + ((PHREP >> 31) & 1ull)); ++rep_) {
  phase_final(p);
  }
}

extern "C" void kernel_launch(void* const* d_in, const int* in_sizes, int n_in, void* d_out, int out_size, void* d_ws,
                              size_t ws_size, hipStream_t stream) {
  static int grid_blocks = 0;
  if (!grid_blocks) {
    int dev = 0, cus = 0, per_cu = 0;
    hipGetDevice(&dev);
    hipDeviceGetAttribute(&cus, hipDeviceAttributeMultiprocessorCount, dev);
    hipFuncSetAttribute((const void*)mega, hipFuncAttributeMaxDynamicSharedMemorySize, LDS_BYTES + 16);
    hipOccupancyMaxActiveBlocksPerMultiprocessor(&per_cu, (const void*)mega, 512, LDS_BYTES + 16);
    if (per_cu < 1) per_cu = 1;
    if (per_cu > 1) per_cu = 1;
    grid_blocks = cus * per_cu;
    fprintf(stderr, "mega: cus=%d per_cu=%d grid=%d ws=%zu\n", cus, per_cu, grid_blocks, ws_size);
  }
  Params p{};
  for (int i = 0; i < N_IN; ++i) p.in[i] = (const float*)d_in[i];
  p.out = (float*)d_out;
  p.ws = (char*)d_ws;
  hipMemsetAsync((char*)d_ws + O_BAR, 0, XCD_BAR_WORDS * 4, stream);
  void* args[] = {&p};
  hipError_t e = hipLaunchCooperativeKernel((const void*)mega, dim3(grid_blocks), dim3(512), args, LDS_BYTES + 16, stream);
  if (e != hipSuccess) fprintf(stderr, "cooperative launch failed: %s (grid %d)\n", hipGetErrorString(e), grid_blocks);
}
```

```cpp
#include <hip/hip_runtime.h>
#include <hip/hip_cooperative_groups.h>
#include <cstdio>
namespace cg = cooperative_groups;

typedef unsigned short u16;
using bf16x8 = __attribute__((ext_vector_type(8))) short;
using f32x4 = __attribute__((ext_vector_type(4))) float;
using u32x4 = __attribute__((ext_vector_type(4))) unsigned int;

#define NTOK 67584
#define NCTX 2048
#define NLAT 65536
#define PW 3472
#define LDS_BYTES 147456
#define HALF_LDS 73728
#define LTID ((int)(TT & 255))
#define VBID ((int)(blockIdx.x * 2 + (TT >> 8)))
__device__ __forceinline__ int opaque_tid() { int t = threadIdx.x; asm volatile("" : "+v"(t)); return t; }
#define VGRID ((int)(gridDim.x * 2))

enum { I_X = 0, I_C, I_CTX, I_CCTX, I_MODW, I_MODB, I_N1G, I_N2G, I_FUP, I_FCW, I_FCB, I_FDN,
       I_EVIN, I_MUP, I_MUN, I_W0F, I_W0B, I_W2F, I_W2B, I_A0F, I_A0B, I_A2F, I_A2B, I_G2, I_KK, I_KA, I_RK,
       I_LNW, I_LNB, I_SCW, I_SCB, I_DTBF, I_DTBB, I_ALF, I_ALB, I_SD, I_SNW, I_EVOUT, I_RIN, I_L2F, I_L2B, I_ROUT, I_FNG, N_IN };

struct Params { const float* in[N_IN]; float* out; char* ws; };

#define MiB (1024ull * 1024ull)
#define W_EVIN   0ull
#define W_EVOUT  (W_EVIN + 3472ull * 1024)
#define W_UP0    (W_EVOUT + 1024ull * 1024)
#define W_UP1    (W_UP0 + 5632ull * 1024)
#define W_DN0    (W_UP1 + 5632ull * 1024)
#define W_DN1    (W_DN0 + 1024ull * 2816)
#define W_RIN    (W_DN1 + 1024ull * 2816)
#define W_ROUT   (W_RIN + 6144ull * 1024)
#define W_W2F    (W_ROUT + 1024ull * 2048)
#define W_W2B    (W_W2F + 512ull * 64)
#define W_A2F    (W_W2B + 512ull * 64)
#define W_A2B    (W_A2F + 512ull * 64)
#define W_G2     (W_A2B + 512ull * 64)
#define O_SMALL  (64 * MiB)
#define O_MODV   (O_SMALL)
#define O_ROPE   (O_MODV + 2ull * 9 * 6144 * 4)
#define O_CTXR   (O_SMALL + 1 * MiB)
#define O_RN     (O_CTXR + 8 * MiB)
#define O_BONUS  (O_RN + 2162688ull)
#define O_DT     (O_BONUS + 2162688ull)
#define O_CS     (O_DT + 2 * 2162688ull)
#define O_RSTD   (O_CS + 2 * 2162688ull)
#define O_BAR    (O_RSTD + 2097152ull)
#define O_BIG    (96 * MiB)
#define SZ_TOK512 (69206016ull)
#define O_P      (O_BIG)
#define O_S      (544 * MiB)
#define O_SR     (O_S)
#define O_SK     (O_S + SZ_TOK512)
#define O_SV     (O_S + 2 * SZ_TOK512)
#define O_SEF    (O_S + 3 * SZ_TOK512)
#define O_SEB    (O_S + 4 * SZ_TOK512)
#define O_SIF    (O_S + 5 * SZ_TOK512)
#define O_SIB    (O_S + 6 * SZ_TOK512)
#define O_STATES (O_SEF)
#define O_MIXED  (O_SR)
#define O_HX     (O_BIG)
#define O_GV     (228 * MiB)
#define O_QKV    (228 * MiB)
#define O_Y      (756 * MiB)
#define DO_HX    0ull
#define DO_L     (138412032ull)
#define DO_G     (DO_L + 51904512ull)

__device__ __forceinline__ unsigned pack2(float a, float b) {
  unsigned r;
  asm("v_cvt_pk_bf16_f32 %0, %1, %2" : "=v"(r) : "v"(a), "v"(b));
  return r;
}
__device__ __forceinline__ u16 f2bf(float f) { return (u16)(pack2(f, f) & 0xffffu); }
__device__ __forceinline__ float bf2f(u16 h) { return __uint_as_float(((unsigned)h) << 16); }
__device__ __forceinline__ uint2 pack4(float a, float b, float c, float d) { return make_uint2(pack2(a, b), pack2(c, d)); }
__device__ __forceinline__ float sigmoidf_(float x) { return __builtin_amdgcn_rcpf(1.f + __expf(-x)); }
__device__ __forceinline__ float siluf_(float x) { return x * __builtin_amdgcn_rcpf(1.f + __expf(-x)); }
__device__ __forceinline__ float tanhf_(float x) { return 1.f - 2.f * __builtin_amdgcn_rcpf(__expf(2.f * x) + 1.f); }
__device__ __forceinline__ float softplusf_(float x) { return x > 20.f ? x : log1pf(__expf(x)); }
__device__ __forceinline__ float geluf_(float x) { return 0.5f * x * (1.f + tanhf_(0.7978845608028654f * (x + 0.044715f * x * x * x))); }
__device__ __forceinline__ float wave_sum(float v) {
#pragma unroll
  for (int o = 32; o; o >>= 1) v += __shfl_xor(v, o);
  return v;
}
template <int C> __device__ __forceinline__ float dppf(float v) {
  return __int_as_float(__builtin_amdgcn_update_dpp(0, __float_as_int(v), C, 0xF, 0xF, true));
}
__device__ __forceinline__ float red16(float v) {
  v += dppf<0xB1>(v);
  v += dppf<0x4E>(v);
  v += dppf<0x141>(v);
  v += dppf<0x140>(v);
  return v;
}
__device__ __forceinline__ bool has_prev(int m) { return m < NCTX ? (m & 255) != 0 : ((m - NCTX) & 8191) != 0; }
__device__ __forceinline__ bool has_next(int m) { return m < NCTX ? (m & 255) != 255 : ((m - NCTX) & 8191) != 8191; }
__device__ __forceinline__ int mod_row(int m) { return m < NCTX ? 8 : ((m - NCTX) >> 13); }
__device__ __forceinline__ int scan_tok(int dir, int b, int s) {
  if (s < 256) return b * 256 + (dir ? 255 - s : s);
  int t = s - 256;
  return NCTX + b * 8192 + (dir ? 8191 - t : t);
}
__device__ __forceinline__ bf16x8 ldfrag(const u16* base, int stride, int row0, int k0, int lane) {
  return *(const bf16x8*)(base + (row0 + (lane & 15)) * stride + k0 + (lane >> 4) * 8);
}
__device__ __forceinline__ f32x4 mma(bf16x8 afrag, bf16x8 bfrag, f32x4 acc) {
  return __builtin_amdgcn_mfma_f32_16x16x32_bf16(bfrag, afrag, acc, 0, 0, 0);
}

template <class Epi> __forceinline__
__device__ __forceinline__ void gemm_phase(const u16* __restrict__ A, int lda, const u16* __restrict__ Bt, int ldb, int M, int N, int K,
                           Epi epi, char* smem_) {
  const int TT = opaque_tid();
  u16* As = (u16*)smem_;
  u16* Bs = As + 128 * 72;
  const int tid = LTID, lane = tid & 63, wave = tid >> 6;
  const int wm = (wave >> 1) * 64, wn = (wave & 1) * 64;
  const int tiles_n = (N + 127) >> 7, tiles_m = (M + 127) >> 7;
  const int ntiles = tiles_m * tiles_n;
  const int lrow = tid >> 3, lkc = (tid & 7) * 8;
  for (int vb = VBID; vb < ntiles; vb += VGRID) {
    const int tm = vb / tiles_n, tn = vb - tm * tiles_n;
    const int m0 = tm * 128, n0 = tn * 128;
    f32x4 acc[4][4];
#pragma unroll
    for (int i = 0; i < 4; ++i)
#pragma unroll
      for (int j = 0; j < 4; ++j) acc[i][j] = (f32x4){0.f, 0.f, 0.f, 0.f};
    u32x4 ra[4], rb[4];
    const u16* ap[4];
    const u16* bp[4];
#pragma unroll
    for (int i = 0; i < 4; ++i) {
      int row = lrow + i * 32;
      int am = min(m0 + row, M - 1), bn = min(n0 + row, N - 1);
      ap[i] = A + (size_t)am * lda + lkc;
      bp[i] = Bt + (size_t)bn * ldb + lkc;
    }
#pragma unroll
    for (int i = 0; i < 4; ++i) { ra[i] = *(const u32x4*)(ap[i]); rb[i] = *(const u32x4*)(bp[i]); }
    for (int k0 = 0; k0 < K; k0 += 64) {
      __syncthreads();
#pragma unroll
      for (int i = 0; i < 4; ++i) {
        *(u32x4*)(As + (lrow + i * 32) * 72 + lkc) = ra[i];
        *(u32x4*)(Bs + (lrow + i * 32) * 72 + lkc) = rb[i];
      }
      __syncthreads();
      if (k0 + 64 < K) {
#pragma unroll
        for (int i = 0; i < 4; ++i) { ra[i] = *(const u32x4*)(ap[i] + k0 + 64); rb[i] = *(const u32x4*)(bp[i] + k0 + 64); }
      }
#pragma unroll
      for (int kk = 0; kk < 64; kk += 32) {
        bf16x8 af[4], bfr[4];
#pragma unroll
        for (int i = 0; i < 4; ++i) af[i] = ldfrag(As, 72, wm + i * 16, kk, lane);
#pragma unroll
        for (int j = 0; j < 4; ++j) bfr[j] = ldfrag(Bs, 72, wn + j * 16, kk, lane);
#pragma unroll
        for (int i = 0; i < 4; ++i)
#pragma unroll
          for (int j = 0; j < 4; ++j) acc[i][j] = mma(af[i], bfr[j], acc[i][j]);
      }
    }
#pragma unroll
    for (int i = 0; i < 4; ++i)
#pragma unroll
      for (int j = 0; j < 4; ++j) {
        int m = m0 + wm + i * 16 + (lane & 15);
        int n = n0 + wn + j * 16 + (lane >> 4) * 4;
        if (m < M && n < N) epi(m, n, acc[i][j]);
      }
  }
}

struct EpiStore { static constexpr bool PERM = true; u16* C; int ldc;
  __device__ void store8(int m, int n, f32x4 a, f32x4 b) const { u32x4 o = {pack2(a[0], a[1]), pack2(a[2], a[3]), pack2(b[0], b[1]), pack2(b[2], b[3])}; *(u32x4*)(C + (size_t)m * ldc + n) = o; }
  __device__ void operator()(int m, int n, f32x4 v) const { *(uint2*)(C + (size_t)m * ldc + n) = pack4(v[0], v[1], v[2], v[3]); } };
struct EpiE { static constexpr bool PERM = false; u16* C; const float* w0;
  __device__ void operator()(int m, int n, f32x4 v) const {
    float4 w = *(const float4*)(w0 + n);
    *(uint2*)(C + (size_t)m * 512 + n) = pack4(sigmoidf_(w.x + v[0]) * 0.6065306597126334f, sigmoidf_(w.y + v[1]) * 0.6065306597126334f,
                                              sigmoidf_(w.z + v[2]) * 0.6065306597126334f, sigmoidf_(w.w + v[3]) * 0.6065306597126334f); } };
struct EpiI { static constexpr bool PERM = false; u16* C; const float* a0;
  __device__ void operator()(int m, int n, f32x4 v) const {
    float4 w = *(const float4*)(a0 + n);
    *(uint2*)(C + (size_t)m * 512 + n) = pack4(sigmoidf_(w.x + v[0]), sigmoidf_(w.y + v[1]), sigmoidf_(w.z + v[2]), sigmoidf_(w.w + v[3])); } };
struct EpiRes { static constexpr bool PERM = false; const float* src_c; const float* src_l; float* dst_c; float* dst_l; const float* modv_l; int gi; int moff;
  __device__ void operator()(int m_, int n, f32x4 v) const {
    int m = m_ + moff;
    const float* g = modv_l + (mod_row(m) * 6 + gi) * 1024 + n;
    float4 gg = *(const float4*)g;
    const float* s; float* d;
    if (m < NCTX) { s = src_c + (size_t)m * 1024 + n; d = dst_c + (size_t)m * 1024 + n; }
    else { s = src_l + (size_t)(m - NCTX) * 1024 + n; d = dst_l + (size_t)(m - NCTX) * 1024 + n; }
    float4 x = *(const float4*)s;
    x.x += gg.x * v[0]; x.y += gg.y * v[1]; x.z += gg.z * v[2]; x.w += gg.w * v[3];
    *(float4*)d = x; } };
struct EpiQKV { static constexpr bool PERM = true; u16* C;
  __device__ void store8(int m, int n, f32x4 a, f32x4 b) const {
    float sc_ = (n >= 1024 && n < 2048) ? 0.08838834764831845f : 1.f;
    u32x4 o = {pack2(a[0] * sc_, a[1] * sc_), pack2(a[2] * sc_, a[3] * sc_), pack2(b[0] * sc_, b[1] * sc_), pack2(b[2] * sc_, b[3] * sc_)};
    *(u32x4*)(C + (size_t)m * 4096 + n) = o; }
  __device__ void operator()(int m, int n, f32x4 v) const {
    float s = (n >= 1024 && n < 2048) ? 0.08838834764831845f : 1.f;
    *(uint2*)(C + (size_t)m * 4096 + n) = pack4(v[0] * s, v[1] * s, v[2] * s, v[3] * s); } };
struct EpiGate { static constexpr bool PERM = true; u16* Y; const float* rstd;
  __device__ void store8(int m, int n, f32x4 a, f32x4 b) const {
    u16* yp = Y + (size_t)m * 2048 + n;
    u32x4 yy = *(const u32x4*)yp;
    float r = rstd[m * 8 + (n >> 8)];
    float g[8] = {a[0], a[1], a[2], a[3], b[0], b[1], b[2], b[3]};
    float o[8];
#pragma unroll
    for (int i = 0; i < 4; ++i) {
      o[2 * i] = siluf_(g[2 * i]) * bf2f((u16)(yy[i] & 0xffff)) * r;
      o[2 * i + 1] = siluf_(g[2 * i + 1]) * bf2f((u16)(yy[i] >> 16)) * r;
    }
    u32x4 ov = {pack2(o[0], o[1]), pack2(o[2], o[3]), pack2(o[4], o[5]), pack2(o[6], o[7])};
    *(u32x4*)yp = ov; }
  __device__ void operator()(int m, int n, f32x4 v) const {
    u16* yp = Y + (size_t)m * 2048 + n;
    uint2 yy = *(const uint2*)yp;
    float r = rstd[m * 8 + (n >> 8)];
    float y0 = bf2f((u16)(yy.x & 0xffff)), y1 = bf2f((u16)(yy.x >> 16)), y2 = bf2f((u16)(yy.y & 0xffff)), y3 = bf2f((u16)(yy.y >> 16));
    *(uint2*)yp = pack4(siluf_(v[0]) * y0 * r, siluf_(v[1]) * y1 * r, siluf_(v[2]) * y2 * r, siluf_(v[3]) * y3 * r); } };

__device__ __forceinline__ void transpose_job(const float* __restrict__ src, u16* __restrict__ dst, int K, int N, char* smem) {
  const int TT = opaque_tid();
  float* tile = (float*)smem;
  const int tid = LTID;
  const int tk = K >> 6, tn = (N + 63) >> 6;
  const int ntiles = tk * tn;
  for (int vb = VBID; vb < ntiles; vb += VGRID) {
    const int k0 = (vb / tn) * 64, n0 = (vb % tn) * 64;
    __syncthreads();
#pragma unroll
    for (int i = 0; i < 4; ++i) {
      int r = (tid >> 4) + i * 16, c4 = (tid & 15) * 4;
      float4 v = make_float4(0.f, 0.f, 0.f, 0.f);
      if (n0 + c4 < N) v = *(const float4*)(src + (size_t)(k0 + r) * N + n0 + c4);
      tile[r * 65 + c4] = v.x; tile[r * 65 + c4 + 1] = v.y; tile[r * 65 + c4 + 2] = v.z; tile[r * 65 + c4 + 3] = v.w;
    }
    __syncthreads();
#pragma unroll
    for (int i = 0; i < 2; ++i) {
      int item = tid + i * 256; int kc = item & 7, n = item >> 3;
      if (n0 + n < N) {
        float v[8];
#pragma unroll
        for (int j = 0; j < 8; ++j) v[j] = tile[(kc * 8 + j) * 65 + n];
        u32x4 o = {pack2(v[0], v[1]), pack2(v[2], v[3]), pack2(v[4], v[5]), pack2(v[6], v[7])};
        *(u32x4*)(dst + (size_t)(n0 + n) * K + k0 + kc * 8) = o;
      }
    }
  }
}

__device__ __forceinline__ void phase_prep(const Params& p, char* smem) {
  const int TT = opaque_tid();
  u16* W = (u16*)p.ws;
  transpose_job(p.in[I_EVIN], W + W_EVIN, 1024, 3472, smem);
  transpose_job(p.in[I_W2F], W + W_W2F, 64, 512, smem);
  transpose_job(p.in[I_W2B], W + W_W2B, 64, 512, smem);
  transpose_job(p.in[I_A2F], W + W_A2F, 64, 512, smem);
  transpose_job(p.in[I_A2B], W + W_A2B, 64, 512, smem);
  transpose_job(p.in[I_G2], W + W_G2, 128, 512, smem);
  {
    float* rope = (float*)(p.ws + O_ROPE);
    for (int idx = VBID * 256 + LTID; idx < (128 + 64) * 32; idx += VGRID * 256) {
      int j = idx & 31, pos = idx >> 5;
      bool isrow = pos < 128;
      int pp = isrow ? pos : pos - 128;
      float inv = powf(10000.f, -(float)j / 32.f);
      float ang = (float)pp * inv;
      double a = (double)ang;
      double kq = rint(a * 0.15915494309189535);
      double r = a - kq * 6.283185307179586476925;
      double r2 = r * r;
      double sn = r, cs = 1.0, ts = r, tc = 1.0;
#pragma unroll 1
      for (int it = 1; it <= 14; ++it) {
        tc = -tc * r2 / (double)((2 * it - 1) * (2 * it));
        ts = -ts * r2 / (double)((2 * it) * (2 * it + 1));
        cs += tc; sn += ts;
      }
      if (isrow) { rope[pp * 32 + j] = (float)cs; rope[4096 + pp * 32 + j] = (float)sn; }
      else { rope[8192 + pp * 32 + j] = (float)cs; rope[8192 + 2048 + pp * 32 + j] = (float)sn; }
    }
  }
  {
    float* sc = (float*)smem;
    float* red = sc + 9 * 1024;
    float* modv = (float*)(p.ws + O_MODV);
    bool loaded = false;
    __syncthreads();
    for (int vb = VBID; vb < 384; vb += VGRID) {
      if (!loaded) {
        for (int i = LTID; i < 9 * 1024; i += 256) {
          int r = i >> 10, k = i & 1023;
          float cv = r < 8 ? p.in[I_C][r * 1024 + k] : p.in[I_CCTX][k];
          sc[i] = cv / (1.f + expf(-cv));
        }
        loaded = true;
        __syncthreads();
      }
      int l = vb / 192, jb = vb % 192;
      int jj = LTID & 31, kc = LTID >> 5;
      int j = jb * 32 + jj;
      const float* w = p.in[I_MODW] + ((size_t)l * 1024 + kc * 128) * 6144 + j;
      float acc[9];
#pragma unroll
      for (int r = 0; r < 9; ++r) acc[r] = 0.f;
#pragma unroll 16
      for (int k = 0; k < 128; ++k) {
        float wv = w[(size_t)k * 6144];
#pragma unroll
        for (int r = 0; r < 9; ++r) acc[r] += sc[r * 1024 + kc * 128 + k] * wv;
      }
      __syncthreads();
#pragma unroll
      for (int r = 0; r < 9; ++r) red[(kc * 9 + r) * 32 + jj] = acc[r];
      __syncthreads();
      if (kc == 0) {
        float mb = p.in[I_MODB][l * 6144 + j];
#pragma unroll
        for (int r = 0; r < 9; ++r) {
          float sum = 0.f;
#pragma unroll
          for (int q = 0; q < 8; ++q) sum += red[(q * 9 + r) * 32 + jj];
          modv[((size_t)l * 9 + r) * 6144 + j] = sum + mb;
        }
      }
    }
    __syncthreads();
  }
}

__device__ __forceinline__ void phase_norm(const float* src_c, const float* src_l, const float* g, const float* modv_l, int si, int sci,
                           u16* hx, int r0, int r1) {
  const int TT = opaque_tid();
  const int lane = LTID & 63, wv = LTID >> 6;
  for (int m = r0 + (VBID * 4 + wv) * 2; m < r1; m += VGRID * 8) {
    float4 v[2][4];
    float ss[2] = {0.f, 0.f};
#pragma unroll
    for (int q = 0; q < 2; ++q) {
      const int mm = m + q;
      const float* src = mm < NCTX ? src_c + (size_t)mm * 1024 : src_l + (size_t)(mm - NCTX) * 1024;
#pragma unroll
      for (int i = 0; i < 4; ++i) v[q][i] = *(const float4*)(src + i * 256 + lane * 4);
    }
#pragma unroll
    for (int q = 0; q < 2; ++q) {
#pragma unroll
      for (int i = 0; i < 4; ++i) ss[q] += v[q][i].x * v[q][i].x + v[q][i].y * v[q][i].y + v[q][i].z * v[q][i].z + v[q][i].w * v[q][i].w;
      ss[q] = wave_sum(ss[q]);
    }
#pragma unroll
    for (int q = 0; q < 2; ++q) {
      const int mm = m + q;
      const int r = mod_row(mm);
      const float* sh = modv_l + (r * 6 + si) * 1024;
      const float* scl = modv_l + (r * 6 + sci) * 1024;
      const float rstd = rsqrtf(ss[q] * (1.f / 1024.f) + 1e-6f);
#pragma unroll
      for (int i = 0; i < 4; ++i) {
        int c = i * 256 + lane * 4;
        float4 gg = *(const float4*)(g + c), s1 = *(const float4*)(scl + c), s0 = *(const float4*)(sh + c);
        float y0 = v[q][i].x * rstd * gg.x * (1.f + s1.x) + s0.x;
        float y1 = v[q][i].y * rstd * gg.y * (1.f + s1.y) + s0.y;
        float y2 = v[q][i].z * rstd * gg.z * (1.f + s1.z) + s0.z;
        float y3 = v[q][i].w * rstd * gg.w * (1.f + s1.w) + s0.w;
        *(uint2*)(hx + (size_t)mm * 1024 + c) = pack4(y0, y1, y2, y3);
      }
    }
  }
}

__device__ __forceinline__ float red8(float v) {
  v += dppf<0xB1>(v);
  v += dppf<0x4E>(v);
  v += dppf<0x141>(v);
  return v;
}
__device__ __forceinline__ void unpack8(u32x4 q, float* o) {
#pragma unroll
  for (int e = 0; e < 4; ++e) { o[2 * e] = bf2f((u16)(q[e] & 0xffff)); o[2 * e + 1] = bf2f((u16)(q[e] >> 16)); }
}
__device__ __forceinline__ u32x4 pack8(const float* o) {
  u32x4 r = {pack2(o[0], o[1]), pack2(o[2], o[3]), pack2(o[4], o[5]), pack2(o[6], o[7])};
  return r;
}
__device__ __forceinline__ void load8f(const float* p, float* o) {
  float4 a = *(const float4*)p, b = *(const float4*)(p + 4);
  o[0] = a.x; o[1] = a.y; o[2] = a.z; o[3] = a.w; o[4] = b.x; o[5] = b.y; o[6] = b.z; o[7] = b.w;
}
__device__ __forceinline__ void shifted8(const u16* row, int col, bool hp, bool hn, const float* mup, const float* mun, float* o) {
  const u32x4 z4 = {0u, 0u, 0u, 0u};
  u32x4 cur = *(const u32x4*)(row + col);
  u32x4 prv = *(const u32x4*)(row + col - (hp ? PW : 0));
  u32x4 nxt = *(const u32x4*)(row + col + (hn ? PW : 0));
  prv = hp ? prv : z4; nxt = hn ? nxt : z4;
  float u[8], pv[8], nx[8], mp[8], mn[8];
  unpack8(cur, u); unpack8(prv, pv); unpack8(nxt, nx);
  load8f(mup + col, mp); load8f(mun + col, mn);
#pragma unroll
  for (int i = 0; i < 8; ++i) o[i] = u[i] + mp[i] * (pv[i] - u[i]) + mn[i] * (nx[i] - u[i]);
}
__device__ __forceinline__ void phase_feat(const Params& p) {
  const int TT = opaque_tid();
  const u16* __restrict__ P = (const u16*)(p.ws + O_P);
  u16* __restrict__ Sr = (u16*)(p.ws + O_SR); u16* __restrict__ Sk = (u16*)(p.ws + O_SK); u16* __restrict__ Sv = (u16*)(p.ws + O_SV);
  float* __restrict__ rn = (float*)(p.ws + O_RN); float* __restrict__ bonus = (float*)(p.ws + O_BONUS);
  u16* __restrict__ L = (u16*)((char*)p.out + DO_L);
  const float* __restrict__ mup = p.in[I_MUP]; const float* __restrict__ mun = p.in[I_MUN];
  const int lane = LTID & 63, wv = LTID >> 6;
  const int h = lane >> 3, c = h * 64 + (lane & 7) * 8;
  float kkw[8], rkw[8];
  load8f(p.in[I_KK] + c, kkw); load8f(p.in[I_RK] + c, rkw);
#pragma unroll 2
  for (int m = VBID * 4 + wv; m < NTOK; m += VGRID * 4) {
    const bool hp = has_prev(m), hn = has_next(m);
    const u16* row = P + (size_t)m * PW;
    float r[8], k[8], v[8];
    shifted8(row, c, hp, hn, mup, mun, r);
    shifted8(row, 512 + c, hp, hn, mup, mun, k);
    shifted8(row, 1024 + c, hp, hn, mup, mun, v);
    *(u32x4*)(Sr + (size_t)m * 512 + c) = pack8(r);
    *(u32x4*)(Sk + (size_t)m * 512 + c) = pack8(k);
    *(u32x4*)(Sv + (size_t)m * 512 + c) = pack8(v);
    float s1 = 0.f, s2 = 0.f;
#pragma unroll
    for (int i = 0; i < 8; ++i) { float kk = k[i] * kkw[i]; s1 += kk * kk; s2 += r[i] * k[i] * rkw[i]; }
    s1 = red8(s1); s2 = red8(s2);
    if ((lane & 7) == 0) {
      rn[m * 8 + h] = 1.f / fmaxf(sqrtf(s1), 1e-12f);
      bonus[m * 8 + h] = s2;
    }
    if (lane < 48) {
      float o[8];
      shifted8(row, 1536 + lane * 8, hp, hn, mup, mun, o);
      const int g = lane >> 3;
#pragma unroll
      for (int i = 0; i < 8; ++i) o[i] = g < 2 ? tanhf_(o[i]) : (g < 4 ? o[i] : sigmoidf_(o[i]));
      *(u32x4*)(L + (size_t)m * 384 + lane * 8) = pack8(o);
    }
  }
}

__device__ __forceinline__ void transpose_item(const float* __restrict__ src, u16* __restrict__ dst, int K, int N, int idx) {
  const int n = idx % N, kb = idx / N;
  const float* sp = src + (size_t)kb * 8 * N + n;
  float v[8];
#pragma unroll
  for (int i = 0; i < 8; ++i) v[i] = sp[(size_t)i * N];
  u32x4 o = {pack2(v[0], v[1]), pack2(v[2], v[3]), pack2(v[4], v[5]), pack2(v[6], v[7])};
  *(u32x4*)(dst + (size_t)n * K + kb * 8) = o;
}
#define LATE_ITEMS 3342336
__device__ __forceinline__ void late_weight_item(const Params& p, int idx) {
  u16* W = (u16*)p.ws;
  if (idx < 131072) { transpose_item(p.in[I_EVOUT], W + W_EVOUT, 1024, 1024, idx); return; }
  idx -= 131072;
  if (idx < 720896) { transpose_item(p.in[I_FUP], W + W_UP0, 1024, 5632, idx); return; }
  idx -= 720896;
  if (idx < 720896) { transpose_item(p.in[I_FUP] + 1024ull * 5632, W + W_UP1, 1024, 5632, idx); return; }
  idx -= 720896;
  if (idx < 360448) { transpose_item(p.in[I_FDN], W + W_DN0, 2816, 1024, idx); return; }
  idx -= 360448;
  if (idx < 360448) { transpose_item(p.in[I_FDN] + 2816ull * 1024, W + W_DN1, 2816, 1024, idx); return; }
  idx -= 360448;
  if (idx < 786432) { transpose_item(p.in[I_RIN], W + W_RIN, 1024, 6144, idx); return; }
  idx -= 786432;
  if (idx < 262144) { transpose_item(p.in[I_ROUT], W + W_ROUT, 2048, 1024, idx); return; }
}

using f32x2 = __attribute__((ext_vector_type(2))) float;
__device__ __forceinline__ void phase_rwkv(const Params& p, char* smem) {
  const u16* Sr = (const u16*)(p.ws + O_SR); const u16* Sk = (const u16*)(p.ws + O_SK); const u16* Sv = (const u16*)(p.ws + O_SV);
  const float* rn = (const float*)(p.ws + O_RN);
  u16* P = (u16*)(p.ws + O_P);
  constexpr int CH = 32;
  constexpr int NCH = 8448 / CH;
  float* buf = (float*)smem;
  float* vbuf = buf + 2 * 5 * CH * 64;
  const int tid = opaque_tid(), lane = tid & 63, wave = tid >> 6;
  const bool producer = tid >= 256;
  const int pt = tid & 255;
  const int ch = pt & 63, st0 = pt >> 6;
  const int rg = lane >> 4, ls = lane & 15;
  const int r0 = (wave & 3) * 8 + rg * 2;
  for (int vb = blockIdx.x; vb < 256; vb += gridDim.x) {
    const int seq = (vb & 7) * 16 + (vb >> 4), hh = (vb >> 3) & 1;
    const int dir = seq >> 6, b = (seq >> 3) & 7, h = seq & 7;
    const u16* Se = (const u16*)(p.ws + (dir ? O_SEB : O_SEF));
    const u16* Si = (const u16*)(p.ws + (dir ? O_SIB : O_SIF));
    const float kkc = p.in[I_KK][h * 64 + ch], kac = p.in[I_KA][h * 64 + ch];
    f32x2 s00 = {0.f, 0.f}, s01 = {0.f, 0.f}, s10 = {0.f, 0.f}, s11 = {0.f, 0.f};
    u16 gr[CH / 4], gk[CH / 4], ge[CH / 4], gi[CH / 4]; float grn[CH / 4]; u16 gv[CH / 8];
    auto gload = [&](int c) {
#pragma unroll
      for (int i = 0; i < CH / 4; ++i) {
        int m = scan_tok(dir, b, c * CH + st0 + i * 4);
        size_t o = (size_t)m * 512 + h * 64 + ch;
        gr[i] = Sr[o]; gk[i] = Sk[o]; ge[i] = Se[o]; gi[i] = Si[o]; grn[i] = rn[m * 8 + h];
      }
#pragma unroll
      for (int i = 0; i < CH / 8; ++i) {
        int item = pt + i * 256;
        int mv = scan_tok(dir, b, c * CH + (item >> 5));
        gv[i] = Sv[(size_t)mv * 512 + h * 64 + hh * 32 + (item & 31)];
      }
    };
    auto sstore = [&](int bi) {
      float* B = buf + bi * (5 * CH * 64);
#pragma unroll
      for (int i = 0; i < CH / 4; ++i) {
        int st = st0 + i * 4;
        float r = bf2f(gr[i]), k = bf2f(gk[i]), e = bf2f(ge[i]), ic = bf2f(gi[i]);
        float kk = k * kkc * grn[i];
        B[(0 * CH + st) * 64 + ch] = -kk;
        B[(1 * CH + st) * 64 + ch] = kk * ic;
        B[(2 * CH + st) * 64 + ch] = k * (1.f + (ic - 1.f) * kac);
        B[(3 * CH + st) * 64 + ch] = __expf(-e);
        B[(4 * CH + st) * 64 + ch] = r;
      }
#pragma unroll
      for (int i = 0; i < CH / 8; ++i) vbuf[bi * (CH * 32) + pt + i * 256] = bf2f(gv[i]);
    };
    __syncthreads();
    if (producer) { gload(0); sstore(0); gload(1); }
    __syncthreads();
    for (int c = 0; c < NCH; ++c) {
      if (producer) {
        if (c + 1 < NCH) { sstore((c + 1) & 1); if (c + 2 < NCH) gload(c + 2); }
        {
          const int li = c * ((int)gridDim.x * 256) + blockIdx.x * 256 + pt;
          if (li < LATE_ITEMS && vb == (int)blockIdx.x) late_weight_item(p, li);
        }
      } else {
        const float* B = buf + (c & 1) * (5 * CH * 64);
        const float* VB = vbuf + (c & 1) * (CH * 32);
        f32x2 ykeep = {0.f, 0.f}, ykeep2 = {0.f, 0.f};
#pragma unroll
        for (int st = 0; st < CH; ++st) {
          f32x4 a = *(const f32x4*)(B + (0 * CH + st) * 64 + ls * 4);
          f32x4 bb = *(const f32x4*)(B + (1 * CH + st) * 64 + ls * 4);
          f32x4 kd = *(const f32x4*)(B + (2 * CH + st) * 64 + ls * 4);
          f32x4 w = *(const f32x4*)(B + (3 * CH + st) * 64 + ls * 4);
          f32x4 r = *(const f32x4*)(B + (4 * CH + st) * 64 + ls * 4);
          f32x2 vv = *(const f32x2*)(VB + st * 32 + r0);
          f32x2 alo = {a[0], a[1]}, ahi = {a[2], a[3]}, blo = {bb[0], bb[1]}, bhi = {bb[2], bb[3]};
          f32x2 klo = {kd[0], kd[1]}, khi = {kd[2], kd[3]}, wlo = {w[0], w[1]}, whi = {w[2], w[3]};
          f32x2 rlo = {r[0], r[1]}, rhi = {r[2], r[3]};
          f32x2 t0 = s00 * alo + s01 * ahi;
          f32x2 t1 = s10 * alo + s11 * ahi;
          float sa0 = red16(t0[0] + t0[1]);
          float sa1 = red16(t1[0] + t1[1]);
          f32x2 sa0v = {sa0, sa0}, sa1v = {sa1, sa1}, v0v = {vv[0], vv[0]}, v1v = {vv[1], vv[1]};
          s00 = s00 * wlo + sa0v * blo + v0v * klo;
          s01 = s01 * whi + sa0v * bhi + v0v * khi;
          s10 = s10 * wlo + sa1v * blo + v1v * klo;
          s11 = s11 * whi + sa1v * bhi + v1v * khi;
          f32x2 u0 = s00 * rlo + s01 * rhi;
          f32x2 u1 = s10 * rlo + s11 * rhi;
          float y0 = red16(u0[0] + u0[1]);
          float y1 = red16(u1[0] + u1[1]);
          if (st < 16) { ykeep[0] = (ls == st) ? y0 : ykeep[0]; ykeep[1] = (ls == st) ? y1 : ykeep[1]; }
          else { ykeep2[0] = (ls == st - 16) ? y0 : ykeep2[0]; ykeep2[1] = (ls == st - 16) ? y1 : ykeep2[1]; }
        }
#pragma unroll
        for (int half_ = 0; half_ < 2; ++half_) {
          const int sidx = c * CH + half_ * 16 + ls;
          const int tt = sidx - 256;
          const int mctx = b * 256 + (dir ? 255 - sidx : sidx);
          const int mlat = NCTX + b * 8192 + (dir ? 8191 - tt : tt);
          const int m = sidx < 256 ? mctx : mlat;
          const f32x2 yk = half_ ? ykeep2 : ykeep;
          *(unsigned*)(P + (size_t)m * PW + dir * 512 + h * 64 + hh * 32 + r0) = pack2(yk[0], yk[1]);
        }
      }
      __syncthreads();
    }
  }
}

__device__ __forceinline__ float xbc_conv(const u16* P, int m, int cx, const float* cw, const float* cb, bool hp, bool hn) {
  const u16* q = P + (size_t)m * PW + 2432 + cx;
  float v = cb[cx] + cw[1024 + cx] * bf2f(q[0]);
  if (hp) v += cw[cx] * bf2f(q[-PW]);
  if (hn) v += cw[2048 + cx] * bf2f(q[PW]);
  return siluf_(v);
}

#define XLO(w) bf2f((u16)((w) & 0xffff))
#define XHI(w) bf2f((u16)((w) >> 16))
__device__ __forceinline__ void phase_xbc(const Params& p) {
  const int TT = opaque_tid();
  const u16* __restrict__ P = (const u16*)(p.ws + O_P);
  u16* __restrict__ X = (u16*)((char*)p.out + DO_HX);
  const float* __restrict__ cw = p.in[I_SCW]; const float* __restrict__ cb = p.in[I_SCB];
  const int total = NTOK * 128;
#pragma unroll 2
  for (int idx = VBID * 256 + LTID; idx < total; idx += VGRID * 256) {
    const int m = idx >> 7, c = (idx & 127) * 8;
    const u16* q = P + (size_t)m * PW + 2432 + c;
    const u32x4 z4 = {0u, 0u, 0u, 0u};
    const bool hp = has_prev(m), hn = has_next(m);
    u32x4 cur = *(const u32x4*)q;
    u32x4 prv = *(const u32x4*)(q - (hp ? PW : 0));
    u32x4 nxt = *(const u32x4*)(q + (hn ? PW : 0));
    prv = hp ? prv : z4; nxt = hn ? nxt : z4;
    float o[8];
#pragma unroll
    for (int e = 0; e < 4; ++e) {
      int c0 = c + 2 * e, c1 = c0 + 1;
      float v0 = cb[c0] + cw[c0] * XLO(prv[e]) + cw[1024 + c0] * XLO(cur[e]) + cw[2048 + c0] * XLO(nxt[e]);
      float v1 = cb[c1] + cw[c1] * XHI(prv[e]) + cw[1024 + c1] * XHI(cur[e]) + cw[2048 + c1] * XHI(nxt[e]);
      o[2 * e] = siluf_(v0); o[2 * e + 1] = siluf_(v1);
    }
    u32x4 ov = {pack2(o[0], o[1]), pack2(o[2], o[3]), pack2(o[4], o[5]), pack2(o[6], o[7])};
    *(u32x4*)(X + (size_t)m * 1024 + c) = ov;
  }
}

__device__ __forceinline__ void phase_ssd_prep(const Params& p) {
  const int TT = opaque_tid();
  const u16* __restrict__ P = (const u16*)(p.ws + O_P);
  float* __restrict__ dtb = (float*)(p.ws + O_DT); float* __restrict__ csb = (float*)(p.ws + O_CS);
  for (int idx = VBID * 256 + LTID; idx < 528 * 16; idx += VGRID * 256) {
    int cidx = idx >> 4, dir = (idx >> 3) & 1, h = idx & 7;
    float bias = dir ? p.in[I_DTBB][h] : p.in[I_DTBF][h];
    float A = -expf(dir ? p.in[I_ALB][h] : p.in[I_ALF][h]);
    float cs = 0.f;
#pragma unroll 16
    for (int i = 0; i < 128; ++i) {
      int l = dir ? 127 - i : i;
      int m = cidx * 128 + l;
      float dtr = bf2f(P[(size_t)m * PW + 3456 + dir * 8 + h]);
      float dt = softplusf_(dtr + bias);
      cs += dt * A;
      dtb[((size_t)dir * NTOK + m) * 8 + h] = dt;
      csb[((size_t)dir * NTOK + m) * 8 + h] = cs;
    }
  }
}

__device__ __forceinline__ void phase_ssd_states(const Params& p, char* smem) {
  const int TT = opaque_tid();
  const u16* P = (const u16*)(p.ws + O_P);
  const float* dtb = (const float*)(p.ws + O_DT); const float* csb = (const float*)(p.ws + O_CS);
  float* states = (float*)(p.ws + O_STATES);
  const float* cw = p.in[I_SCW]; const float* cb = p.in[I_SCB];
  const u16* X = (const u16*)((const char*)p.out + DO_HX);
  u16* XTf = (u16*)smem; u16* XTb = XTf + 64 * 136; u16* BT = XTb + 64 * 136;
  float* wf = (float*)(BT + 128 * 136);
  const int tid = LTID, lane = tid & 63, wave = tid >> 6;
  for (int vb = VBID; vb < 528 * 8; vb += VGRID) {
    const int cidx = vb >> 3, h = vb & 7, g = h >> 2;
    const int mb = cidx * 128;
    __syncthreads();
    {
      int d = tid >> 7, l = tid & 127;
      float tot = csb[((size_t)d * NTOK + mb + (d ? 0 : 127)) * 8 + h];
      size_t o = ((size_t)d * NTOK + mb + l) * 8 + h;
      wf[d * 128 + l] = dtb[o] * __expf(tot - csb[o]);
    }
    __syncthreads();
#pragma unroll
    for (int i = 0; i < 2; ++i) {
      int item = tid + i * 256; int lp = item & 63, cg = item >> 6;
      int l0 = 2 * lp;
      const u16* xp = X + (size_t)(mb + l0) * 1024 + h * 64 + cg * 8;
      u32x4 x0 = *(const u32x4*)xp, x1 = *(const u32x4*)(xp + 1024);
      float f0 = wf[l0], f1 = wf[l0 + 1], b0 = wf[128 + l0], b1 = wf[128 + l0 + 1];
#pragma unroll
      for (int e = 0; e < 4; ++e) {
        float a0 = XLO(x0[e]), a1 = XLO(x1[e]), c0 = XHI(x0[e]), c1 = XHI(x1[e]);
        *(unsigned*)(XTf + (cg * 8 + 2 * e) * 136 + l0) = pack2(a0 * f0, a1 * f1);
        *(unsigned*)(XTf + (cg * 8 + 2 * e + 1) * 136 + l0) = pack2(c0 * f0, c1 * f1);
        *(unsigned*)(XTb + (cg * 8 + 2 * e) * 136 + l0) = pack2(a0 * b0, a1 * b1);
        *(unsigned*)(XTb + (cg * 8 + 2 * e + 1) * 136 + l0) = pack2(c0 * b0, c1 * b1);
      }
    }
#pragma unroll
    for (int i = 0; i < 4; ++i) {
      int item = tid + i * 256; int lp = item & 63, cg = item >> 6;
      int l0 = 2 * lp;
      const u16* xp = X + (size_t)(mb + l0) * 1024 + 512 + g * 128 + cg * 8;
      u32x4 x0 = *(const u32x4*)xp, x1 = *(const u32x4*)(xp + 1024);
#pragma unroll
      for (int e = 0; e < 4; ++e) {
        *(unsigned*)(BT + (cg * 8 + 2 * e) * 136 + l0) = (x0[e] & 0xffffu) | (x1[e] << 16);
        *(unsigned*)(BT + (cg * 8 + 2 * e + 1) * 136 + l0) = (x0[e] >> 16) | (x1[e] & 0xffff0000u);
      }
    }
    __syncthreads();
#pragma unroll
    for (int d = 0; d < 2; ++d) {
      const u16* XT = d ? XTb : XTf;
      f32x4 acc[4][2];
#pragma unroll
      for (int i = 0; i < 4; ++i) { acc[i][0] = (f32x4){0, 0, 0, 0}; acc[i][1] = (f32x4){0, 0, 0, 0}; }
#pragma unroll
      for (int kk = 0; kk < 128; kk += 32) {
        bf16x8 af[4], bfr[2];
#pragma unroll
        for (int i = 0; i < 4; ++i) af[i] = ldfrag(XT, 136, i * 16, kk, lane);
#pragma unroll
        for (int j = 0; j < 2; ++j) bfr[j] = ldfrag(BT, 136, wave * 32 + j * 16, kk, lane);
#pragma unroll
        for (int i = 0; i < 4; ++i)
#pragma unroll
          for (int j = 0; j < 2; ++j) acc[i][j] = mma(af[i], bfr[j], acc[i][j]);
      }
      float* so = states + (((size_t)d * 528 + cidx) * 8 + h) * 8192;
#pragma unroll
      for (int i = 0; i < 4; ++i)
#pragma unroll
        for (int j = 0; j < 2; ++j) {
          int pp = i * 16 + (lane & 15), n = wave * 32 + j * 16 + (lane >> 4) * 4;
          *(float4*)(so + pp * 128 + n) = make_float4(acc[i][j][0], acc[i][j][1], acc[i][j][2], acc[i][j][3]);
        }
    }
  }
}

__device__ __forceinline__ int ssd_chunk_seq(int d, int b, int j) {
  if (j < 2) return 2 * b + (d ? 1 - j : j);
  int t = j - 2;
  return 16 + b * 64 + (d ? 63 - t : t);
}

__device__ __forceinline__ void phase_ssd_scan(const Params& p) {
  const int TT = opaque_tid();
  float* states = (float*)(p.ws + O_STATES);
  const float* csb = (const float*)(p.ws + O_CS);
  for (int idx = VBID * 256 + LTID; idx < 2 * 8 * 8 * 2048; idx += VGRID * 256) {
    const int q = idx & 2047, h = (idx >> 11) & 7, b = (idx >> 14) & 7, d = idx >> 17;
    auto sptr = [&](int j) -> f32x4* {
      int cidx = ssd_chunk_seq(d, b, j);
      return (f32x4*)(states + (((size_t)d * 528 + cidx) * 8 + h) * 8192) + q;
    };
    auto totof = [&](int j) -> float {
      int cidx = ssd_chunk_seq(d, b, j);
      return csb[((size_t)d * NTOK + cidx * 128 + (d ? 0 : 127)) * 8 + h];
    };
    f32x4 hh = {0.f, 0.f, 0.f, 0.f};
    f32x4 sv[4]; float tv[4];
#pragma unroll
    for (int u = 0; u < 4; ++u) { sv[u] = *sptr(u); tv[u] = totof(u); }
#pragma unroll 1
    for (int j0 = 0; j0 < 64; j0 += 4) {
      f32x4 sn[4]; float tn[4];
#pragma unroll
      for (int u = 0; u < 4; ++u) {
        const int jn = j0 + 4 + u;
        const int jc = jn < 66 ? jn : 65;
        sn[u] = *sptr(jc); tn[u] = totof(jc);
      }
#pragma unroll
      for (int u = 0; u < 4; ++u) {
        *sptr(j0 + u) = hh;
        hh = hh * __expf(tv[u]) + sv[u];
      }
#pragma unroll
      for (int u = 0; u < 4; ++u) { sv[u] = sn[u]; tv[u] = tn[u]; }
    }
#pragma unroll
    for (int u = 0; u < 2; ++u) {
      *sptr(64 + u) = hh;
      hh = hh * __expf(tv[u]) + sv[u];
    }
  }
}

__device__ __forceinline__ void phase_ssd_out(const Params& p, char* smem) {
  const int TT = opaque_tid();
  u16* P = (u16*)(p.ws + O_P);
  const float* dtb = (const float*)(p.ws + O_DT); const float* csb = (const float*)(p.ws + O_CS);
  const float* states = (const float*)(p.ws + O_STATES);
  const float* cw = p.in[I_SCW]; const float* cb = p.in[I_SCB];
  const u16* X = (const u16*)((const char*)p.out + DO_HX);
  u16* Cs = (u16*)smem;
  u16* Bs = Cs + 64 * 136;
  u16* Gs = Bs; u16* Hs = Bs + 64 * 136;
  u16* XT = Bs + 128 * 136;
  float* csf = (float*)(XT + 64 * 136);
  float* csbk = csf + 128; float* dtf = csbk + 128; float* dtbk = dtf + 128;
  const int tid = LTID, lane = tid & 63, wave = tid >> 6;
  const int lv_ = (int)(blockIdx.x >> 3) * 2 + (VBID & 1);
  for (int vq = lv_; vq < 66 * 16; vq += (int)(gridDim.x >> 3) * 2) {
    const int vb = (((int)(blockIdx.x & 7) + 8 * (vq >> 4)) << 4) + (vq & 15);
    const int lh = vb & 1, h = (vb >> 1) & 7, cidx = vb >> 4, g = h >> 2;
    const int mb = cidx * 128;
    f32x4 hv[2][8];
#pragma unroll
    for (int d = 0; d < 2; ++d) {
      const float* hp = states + (((size_t)d * 528 + cidx) * 8 + h) * 8192;
#pragma unroll
      for (int i = 0; i < 8; ++i) { int item = tid + i * 256; hv[d][i] = *(const f32x4*)(hp + (item >> 5) * 128 + (item & 31) * 4); }
    }
    __syncthreads();
    if (tid < 128) {
      size_t o0 = ((size_t)0 * NTOK + mb + tid) * 8 + h, o1 = ((size_t)1 * NTOK + mb + tid) * 8 + h;
      csf[tid] = csb[o0]; csbk[tid] = csb[o1]; dtf[tid] = dtb[o0]; dtbk[tid] = dtb[o1];
    }
#pragma unroll
    for (int i = 0; i < 4; ++i) {
      int item = tid + i * 256; int cg = item & 15, l = item >> 4;
      *(u32x4*)(Cs + l * 136 + cg * 8) = *(const u32x4*)(X + (size_t)(mb + lh * 64 + l) * 1024 + 768 + g * 128 + cg * 8);
    }
#pragma unroll
    for (int i = 0; i < 8; ++i) {
      int item = tid + i * 256; int cg = item & 15, sidx = item >> 4;
      *(u32x4*)(Bs + sidx * 136 + cg * 8) = *(const u32x4*)(X + (size_t)(mb + sidx) * 1024 + 512 + g * 128 + cg * 8);
    }
#pragma unroll
    for (int i = 0; i < 2; ++i) {
      int item = tid + i * 256; int lp = item & 63, cg = item >> 6;
      int l0 = 2 * lp;
      const u16* xp = X + (size_t)(mb + l0) * 1024 + h * 64 + cg * 8;
      u32x4 x0 = *(const u32x4*)xp, x1 = *(const u32x4*)(xp + 1024);
#pragma unroll
      for (int e = 0; e < 4; ++e) {
        *(unsigned*)(XT + (cg * 8 + 2 * e) * 136 + l0) = (x0[e] & 0xffffu) | (x1[e] << 16);
        *(unsigned*)(XT + (cg * 8 + 2 * e + 1) * 136 + l0) = (x0[e] >> 16) | (x1[e] & 0xffff0000u);
      }
    }
    __syncthreads();
    f32x4 cbacc[8];
#pragma unroll
    for (int t = 0; t < 8; ++t) cbacc[t] = (f32x4){0, 0, 0, 0};
#pragma unroll 1
    for (int kk = 0; kk < 128; kk += 32) {
      bf16x8 af = ldfrag(Cs, 136, wave * 16, kk, lane);
#pragma unroll
      for (int t = 0; t < 8; ++t) cbacc[t] = mma(af, ldfrag(Bs, 136, t * 16, kk, lane), cbacc[t]);
    }
    __syncthreads();
    const int lloc = wave * 16 + (lane & 15);
    const int l = lh * 64 + lloc;
    const float cfl = csf[l], cbl = csbk[l];
#pragma unroll 2
    for (int t = 0; t < 8; ++t) {
      float gv[4];
#pragma unroll
      for (int j = 0; j < 4; ++j) {
        int s = t * 16 + (lane >> 4) * 4 + j;
        float f = 0.f;
        if (s <= l) f += __expf(cfl - csf[s]) * dtf[s];
        if (s >= l) f += __expf(cbl - csbk[s]) * dtbk[s];
        gv[j] = cbacc[t][j] * f;
      }
      *(uint2*)(Gs + lloc * 136 + t * 16 + (lane >> 4) * 4) = pack4(gv[0], gv[1], gv[2], gv[3]);
    }
    __syncthreads();
    f32x4 yacc[4];
#pragma unroll
    for (int t = 0; t < 4; ++t) yacc[t] = (f32x4){0, 0, 0, 0};
#pragma unroll 1
    for (int kk = 0; kk < 128; kk += 32) {
      bf16x8 af = ldfrag(Gs, 136, wave * 16, kk, lane);
#pragma unroll
      for (int t = 0; t < 4; ++t) yacc[t] = mma(af, ldfrag(XT, 136, t * 16, kk, lane), yacc[t]);
    }
#pragma unroll
    for (int d = 0; d < 2; ++d) {
      __syncthreads();
#pragma unroll
      for (int i = 0; i < 8; ++i) {
        int item = tid + i * 256;
        int pp = item >> 5, n4 = (item & 31) * 4;
        *(uint2*)(Hs + pp * 136 + n4) = pack4(hv[d][i][0], hv[d][i][1], hv[d][i][2], hv[d][i][3]);
      }
      __syncthreads();
      f32x4 ia[4];
#pragma unroll
      for (int t = 0; t < 4; ++t) ia[t] = (f32x4){0, 0, 0, 0};
#pragma unroll 1
      for (int kk = 0; kk < 128; kk += 32) {
        bf16x8 af = ldfrag(Cs, 136, wave * 16, kk, lane);
#pragma unroll
        for (int t = 0; t < 4; ++t) ia[t] = mma(af, ldfrag(Hs, 136, t * 16, kk, lane), ia[t]);
      }
      float sc = __expf(d ? cbl : cfl);
#pragma unroll
      for (int t = 0; t < 4; ++t)
#pragma unroll
        for (int j = 0; j < 4; ++j) yacc[t][j] += sc * ia[t][j];
    }
    const float Dh = p.in[I_SD][h];
    const int m = mb + l;
#pragma unroll
    for (int t = 0; t < 4; ++t) {
      int p0 = t * 16 + (lane >> 4) * 4;
      float o[4];
#pragma unroll
      for (int j = 0; j < 4; ++j) o[j] = yacc[t][j] + Dh * bf2f(XT[(p0 + j) * 136 + l]);
      *(uint2*)(P + (size_t)m * PW + 1024 + h * 64 + p0) = pack4(o[0], o[1], o[2], o[3]);
    }
  }
}

__device__ __forceinline__ void phase_finish(const Params& p) {
  const int TT = opaque_tid();
  const u16* __restrict__ P = (const u16*)(p.ws + O_P);
  const u16* __restrict__ Sv = (const u16*)(p.ws + O_SV);
  const u16* __restrict__ G = (const u16*)((const char*)p.out + DO_G);
  const float* __restrict__ bonus = (const float*)(p.ws + O_BONUS);
  u16* __restrict__ mixed = (u16*)(p.ws + O_MIXED);
  const int lane = LTID & 63, wv = LTID >> 6;
  const int h = lane >> 3, c = h * 64 + (lane & 7) * 8;
  float lnw[8], lnb[8], nw[8];
  load8f(p.in[I_LNW] + c, lnw); load8f(p.in[I_LNB] + c, lnb); load8f(p.in[I_SNW] + c, nw);
#pragma unroll 2
  for (int m = VBID * 4 + wv; m < NTOK; m += VGRID * 4) {
    const u16* row = P + (size_t)m * PW;
    float yf[8], yb[8], sv[8], gg[8], ys[8], z[8];
    unpack8(*(const u32x4*)(row + c), yf);
    unpack8(*(const u32x4*)(row + 512 + c), yb);
    unpack8(*(const u32x4*)(Sv + (size_t)m * 512 + c), sv);
    unpack8(*(const u32x4*)(G + (size_t)m * 512 + c), gg);
    unpack8(*(const u32x4*)(row + 1024 + c), ys);
    unpack8(*(const u32x4*)(row + 1920 + c), z);
    const float bn = bonus[m * 8 + h];
    float sum = 0.f;
#pragma unroll
    for (int i = 0; i < 8; ++i) { yf[i] += yb[i]; sum += yf[i]; }
    const float mean = red8(sum) * (1.f / 64.f);
    float vs = 0.f;
#pragma unroll
    for (int i = 0; i < 8; ++i) { yf[i] -= mean; vs += yf[i] * yf[i]; }
    const float rs = rsqrtf(red8(vs) * (1.f / 64.f) + 64e-5f);
    float o1[8], t[8]; float ss = 0.f;
#pragma unroll
    for (int i = 0; i < 8; ++i) {
      o1[i] = (yf[i] * rs * lnw[i] + lnb[i] + bn * sv[i]) * gg[i];
      t[i] = ys[i] * siluf_(z[i]);
      ss += t[i] * t[i];
    }
    ss = wave_sum(ss);
    const float rstd = rsqrtf(ss * (1.f / 512.f) + 1e-6f);
#pragma unroll
    for (int i = 0; i < 8; ++i) t[i] = t[i] * rstd * nw[i];
    *(u32x4*)(mixed + (size_t)m * 1024 + c) = pack8(o1);
    *(u32x4*)(mixed + (size_t)m * 1024 + 512 + c) = pack8(t);
  }
}

__device__ __forceinline__ void phase_ffnconv(const Params& p, int layer, int r0) {
  const int TT = opaque_tid();
  u16* GV = (u16*)(p.ws + O_GV);
  const float* cw = p.in[I_FCW] + (size_t)layer * 9 * 2816;
  const float* cb = p.in[I_FCB] + (size_t)layer * 2816;
  (void)TT;
  const int xcd = blockIdx.x & 7;
  const int lt = (int)(blockIdx.x >> 3) * 512 + (int)threadIdx.x;
  const int ngrp = (int)((gridDim.x >> 3) * 512) / 44;
  if (lt >= ngrp * 44) return;
  const int j = (xcd * 44 + lt % 44) * 8, tl = lt / 44;
  float w[9][8], bias[8];
#pragma unroll
  for (int k = 0; k < 9; ++k) load8f(cw + k * 2816 + j, w[k]);
  load8f(cb + j, bias);
  const u32x4 z4 = {0u, 0u, 0u, 0u};
#pragma unroll 1
  for (int m0 = r0 + tl; m0 < NTOK; m0 += 2 * ngrp) {
    u32x4 g[2][9]; u32x4 vq[2];
#pragma unroll
    for (int q = 0; q < 2; ++q) {
      const int m = (m0 + q * ngrp < NTOK) ? m0 + q * ngrp : m0;
      const bool isctx = m < NCTX;
      const int t = isctx ? (m & 255) : ((m - NCTX) & 8191);
      const int rr = t >> 6, cc = t & 63;
#pragma unroll
      for (int dy = -1; dy <= 1; ++dy)
#pragma unroll
        for (int dx = -1; dx <= 1; ++dx) {
          const int k = (dy + 1) * 3 + dx + 1;
          const bool valid = isctx ? (dy == 0 && t + dx >= 0 && t + dx < 256)
                                   : (rr + dy >= 0 && rr + dy < 128 && cc + dx >= 0 && cc + dx < 64);
          const int mm = valid ? m + dy * 64 + dx : m;
          u32x4 qv = *(const u32x4*)(GV + (size_t)mm * 5632 + j);
          g[q][k] = valid ? qv : z4;
        }
      vq[q] = *(const u32x4*)(GV + (size_t)m * 5632 + 2816 + j);
    }
    asm volatile("" ::: "memory");
#pragma unroll
    for (int q = 0; q < 2; ++q) {
      const int m = m0 + q * ngrp;
      if (m < NTOK) {
        float acc[8];
#pragma unroll
        for (int i = 0; i < 8; ++i) acc[i] = bias[i];
#pragma unroll
        for (int k = 0; k < 9; ++k)
#pragma unroll
          for (int e = 0; e < 4; ++e) {
            acc[2 * e] += w[k][2 * e] * XLO(g[q][k][e]);
            acc[2 * e + 1] += w[k][2 * e + 1] * XHI(g[q][k][e]);
          }
        float o[8];
#pragma unroll
        for (int e = 0; e < 4; ++e) {
          o[2 * e] = geluf_(acc[2 * e]) * XLO(vq[q][e]);
          o[2 * e + 1] = geluf_(acc[2 * e + 1]) * XHI(vq[q][e]);
        }
        *(u32x4*)(GV + (size_t)m * 5632 + 2816 + j) = pack8(o);
      }
    }
  }
}

__device__ __forceinline__ void phase_rope(const Params& p) {
  const int TT = opaque_tid();
  u16* QKV = (u16*)(p.ws + O_QKV);
  const float* rope = (const float*)(p.ws + O_ROPE);
  const int total = NLAT * 128;
  const int nthr = VGRID * 256;
  for (int idx0 = VBID * 256 + LTID; idx0 < total; idx0 += nthr * 4) {
    u32x4 a[4], bq[4];
#pragma unroll
    for (int u = 0; u < 4; ++u) {
      const int idx = idx0 + u * nthr;
      if (idx >= total) continue;
      const int t = idx >> 7, r = idx & 127;
      const int jg = r & 7, hh = (r >> 3) & 7, qk = r >> 6;
      const u16* base = QKV + (size_t)(NCTX + t) * 4096 + qk * 1024 + hh * 128 + jg * 8;
      a[u] = *(const u32x4*)base; bq[u] = *(const u32x4*)(base + 64);
    }
    asm volatile("" ::: "memory");
#pragma unroll
    for (int u = 0; u < 4; ++u) {
      const int idx = idx0 + u * nthr;
      if (idx >= total) continue;
      const int t = idx >> 7, r = idx & 127;
      const int jg = r & 7, hh = (r >> 3) & 7, qk = r >> 6;
      const int pos = t & 8191, prow = pos >> 6, pcol = pos & 63;
      const int j = jg * 8;
      u16* base = QKV + (size_t)(NCTX + t) * 4096 + qk * 1024 + hh * 128 + j;
      float x1[8], x2[8], o1[8], o2[8];
      unpack8(a[u], x1); unpack8(bq[u], x2);
      const float* ct = j < 32 ? rope + prow * 32 + j : rope + 8192 + pcol * 32 + j - 32;
      const float* stb = j < 32 ? rope + 4096 + prow * 32 + j : rope + 8192 + 2048 + pcol * 32 + j - 32;
      float cs[8], sn[8];
      load8f(ct, cs); load8f(stb, sn);
#pragma unroll
      for (int i = 0; i < 8; ++i) { o1[i] = x1[i] * cs[i] - x2[i] * sn[i]; o2[i] = x2[i] * cs[i] + x1[i] * sn[i]; }
      *(u32x4*)base = pack8(o1);
      *(u32x4*)(base + 64) = pack8(o2);
    }
  }
}

typedef short s16x4 __attribute__((ext_vector_type(4)));
__device__ __forceinline__ bf16x8 ldfrag_tr(const u16* X, int stride, int row0, int k0, int lane) {
  const int li = lane & 15, g = lane >> 4;
  const u16* pp = X + (k0 + g * 8 + (li >> 2)) * stride + row0 + (li & 3) * 4;
  const s16x4 lo = __builtin_amdgcn_ds_read_tr16_b64_v4i16((__attribute__((address_space(3))) s16x4*)pp);
  const s16x4 hi = __builtin_amdgcn_ds_read_tr16_b64_v4i16((__attribute__((address_space(3))) s16x4*)(pp + 4 * stride));
  return (bf16x8){lo[0], lo[1], lo[2], lo[3], hi[0], hi[1], hi[2], hi[3]};
}
__device__ __forceinline__ bf16x8 ldfrag_tr_acc(const u16* X, int stride, int row0, int k0, int lane) {
  const int li = lane & 15, g = lane >> 4;
  const u16* pp = X + (k0 + g * 4 + (li >> 2)) * stride + row0 + (li & 3) * 4;
  const s16x4 lo = __builtin_amdgcn_ds_read_tr16_b64_v4i16((__attribute__((address_space(3))) s16x4*)pp);
  const s16x4 hi = __builtin_amdgcn_ds_read_tr16_b64_v4i16((__attribute__((address_space(3))) s16x4*)(pp + 16 * stride));
  return (bf16x8){lo[0], lo[1], lo[2], lo[3], hi[0], hi[1], hi[2], hi[3]};
}
__device__ __forceinline__ void phase_retention(const Params& p, char* smem) {
  const u16* QKV = (const u16*)(p.ws + O_QKV);
  u16* Y = (u16*)(p.ws + O_Y);
  u16* Qs = (u16*)smem;
  u16* Ks = Qs + 64 * 136;
  u16* Vs = Ks + 64 * 136;
  u16* Vs2 = Vs + 64 * 72;
  u16* Sb = Vs2 + 64 * 72;
  u16* Pm = Sb + 64 * 136;
  const int tid = opaque_tid(), lane = tid & 63, wave = tid >> 6;
  const int quad = lane >> 4, l16 = lane & 15;
  const int rt = wave & 3, chf = wave >> 2;
  for (int vb = blockIdx.x; vb < 256; vb += gridDim.x) {
    const int xq_ = vb >> 3, bh_ = (vb & 7) * 8 + (xq_ >> 2);
    const int b = bh_ >> 3, h = bh_ & 7, sl = xq_ & 3;
#pragma unroll 1
    for (int d = 0; d < 2; ++d) {
      const float l2 = d ? p.in[I_L2B][h] : p.in[I_L2F][h];
      const float lg = log1pf(-exp2f(-l2));
      const float gC = __expf(lg * 64.f);
      f32x4 st[4];
#pragma unroll
      for (int t = 0; t < 4; ++t) st[t] = (f32x4){0, 0, 0, 0};
      u32x4 rqA[2], rkA[2], rvA, rqB[2], rkB[2], rvB;
      auto chunk_m0 = [&](int cs_) { return d ? scan_tok(1, b, cs_ * 64 + 63) : scan_tok(0, b, cs_ * 64); };
      auto gload = [&](int cs_, u32x4 (&rq)[2], u32x4 (&rk)[2], u32x4& rv) {
        int m0 = chunk_m0(cs_);
#pragma unroll
        for (int i = 0; i < 2; ++i) {
          int item = tid + i * 512; int row = item & 63, c8 = (item >> 6) * 8;
          const u16* bp = QKV + (size_t)(m0 + row) * 4096 + h * 128 + c8;
          rq[i] = *(const u32x4*)bp;
          rk[i] = *(const u32x4*)(bp + 1024);
        }
        {
          int row = tid & 63, c8 = (tid >> 6) * 8;
          rv = *(const u32x4*)(QKV + (size_t)(m0 + row) * 4096 + 2048 + h * 256 + sl * 64 + c8);
        }
      };
      auto sstore = [&](const u32x4 (&rq)[2], const u32x4 (&rk)[2], const u32x4& rv) {
#pragma unroll
        for (int i = 0; i < 2; ++i) {
          int item = tid + i * 512; int row = item & 63, c8 = (item >> 6) * 8;
          *(u32x4*)(Qs + row * 136 + c8) = rq[i];
          *(u32x4*)(Ks + row * 136 + c8) = rk[i];
        }
        {
          int row = tid & 63, c8 = (tid >> 6) * 8;
          const float ke = __expf(lg * (float)(d ? row : 63 - row));
          *(u32x4*)(Vs + row * 72 + c8) = rv;
          u32x4 sv_;
#pragma unroll
          for (int e = 0; e < 4; ++e) sv_[e] = pack2(bf2f((u16)(rv[e] & 0xffff)) * ke, bf2f((u16)(rv[e] >> 16)) * ke);
          *(u32x4*)(Vs2 + row * 72 + c8) = sv_;
        }
#pragma unroll
        for (int t = 0; t < 4; ++t)
          *(uint2*)(Sb + (rt * 16 + l16) * 136 + (4 * chf + t) * 16 + quad * 4) = pack4(st[t][0], st[t][1], st[t][2], st[t][3]);
      };
      gload(0, rqA, rkA, rvA);
      gload(1, rqB, rkB, rvB);
      auto body = [&](int cs_, u32x4 (&rq)[2], u32x4 (&rk)[2], u32x4& rv) {
        const int m0 = chunk_m0(cs_);
        __syncthreads();
        sstore(rq, rk, rv);
        __syncthreads();
        u16* const ypb = Y + (size_t)(m0 + rt * 16 + l16 - NCTX) * 2048 + h * 256 + sl * 64 + quad * 4;
        uint2 yprev[2] = {make_uint2(0u, 0u), make_uint2(0u, 0u)};
        if (d && m0 >= NCTX) {
#pragma unroll
          for (int t = 0; t < 2; ++t) yprev[t] = *(const uint2*)(ypb + (2 * chf + t) * 16);
        }
        if (cs_ + 2 < 132) gload(cs_ + 2, rq, rk, rv);
        f32x4 sc[4];
#pragma unroll
        for (int t = 0; t < 4; ++t) sc[t] = (f32x4){0, 0, 0, 0};
#pragma unroll
        for (int kk = 0; kk < 128; kk += 32) {
          bf16x8 af = ldfrag(Qs, 136, rt * 16, kk, lane);
#pragma unroll
          for (int t = 0; t < 4; ++t) sc[t] = mma(af, ldfrag(Ks, 136, t * 16, kk, lane), sc[t]);
        }
        const int l = rt * 16 + l16;
        unsigned pk[4][2];
#pragma unroll
        for (int t = 0; t < 4; ++t) {
          float pv[4];
#pragma unroll
          for (int j = 0; j < 4; ++j) {
            int s_ = t * 16 + quad * 4 + j;
            int dist = d ? s_ - l : l - s_;
            pv[j] = dist >= 0 ? sc[t][j] * __expf(lg * (float)dist) : 0.f;
          }
          pk[t][0] = pack2(pv[0], pv[1]); pk[t][1] = pack2(pv[2], pv[3]);
        }
        f32x4 ya[2], yi[2];
#pragma unroll
        for (int t = 0; t < 2; ++t) { ya[t] = (f32x4){0, 0, 0, 0}; yi[t] = (f32x4){0, 0, 0, 0}; }
#pragma unroll
        for (int ks = 0; ks < 2; ++ks) {
          const u32x4 pw = {pk[2 * ks][0], pk[2 * ks][1], pk[2 * ks + 1][0], pk[2 * ks + 1][1]};
          bf16x8 af = __builtin_bit_cast(bf16x8, pw);
#pragma unroll
          for (int t = 0; t < 2; ++t) ya[t] = mma(af, ldfrag_tr_acc(Vs, 72, (2 * chf + t) * 16, ks * 32, lane), ya[t]);
        }
#pragma unroll
        for (int kk = 0; kk < 128; kk += 32) {
          bf16x8 af = ldfrag(Qs, 136, rt * 16, kk, lane);
#pragma unroll
          for (int t = 0; t < 2; ++t) yi[t] = mma(af, ldfrag(Sb, 136, (2 * chf + t) * 16, kk, lane), yi[t]);
        }
#pragma unroll
        for (int t = 0; t < 4; ++t) { st[t][0] *= gC; st[t][1] *= gC; st[t][2] *= gC; st[t][3] *= gC; }
#pragma unroll
        for (int kk = 0; kk < 64; kk += 32) {
          bf16x8 af = ldfrag_tr(Vs2, 72, rt * 16, kk, lane);
#pragma unroll
          for (int t = 0; t < 4; ++t) st[t] = mma(af, ldfrag_tr(Ks, 136, (4 * chf + t) * 16, kk, lane), st[t]);
        }
        if (m0 >= NCTX) {
          const float qd = __expf(lg * (float)(d ? 64 - l : l + 1));
          u16* yp = Y + (size_t)(m0 + l - NCTX) * 2048 + h * 256 + sl * 64 + quad * 4;
#pragma unroll
          for (int t = 0; t < 2; ++t) {
            float o[4];
#pragma unroll
            for (int j = 0; j < 4; ++j) o[j] = ya[t][j] + qd * yi[t][j];
            u16* yq = yp + (2 * chf + t) * 16;
            if (d) {
              const uint2 prev = yprev[t];
              o[0] += bf2f((u16)(prev.x & 0xffff)); o[1] += bf2f((u16)(prev.x >> 16));
              o[2] += bf2f((u16)(prev.y & 0xffff)); o[3] += bf2f((u16)(prev.y >> 16));
            }
            *(uint2*)yq = pack4(o[0], o[1], o[2], o[3]);
          }
        }
      };
#pragma unroll 1
      for (int cs_ = 0; cs_ < 132; cs_ += 2) {
        body(cs_, rqA, rkA, rvA);
        body(cs_ + 1, rqB, rkB, rvB);
      }
    }
  }
}

__device__ __forceinline__ void phase_ynorm(const Params& p) {
  const int TT = opaque_tid();
  const u16* __restrict__ Y = (const u16*)(p.ws + O_Y);
  float* __restrict__ rstd = (float*)(p.ws + O_RSTD);
  const int lane = LTID & 63, wv = LTID >> 6;
#pragma unroll 2
  for (int m = VBID * 4 + wv; m < NLAT; m += VGRID * 4) {
#pragma unroll
    for (int h = 0; h < 8; ++h) {
      uint2 q = *(const uint2*)(Y + (size_t)m * 2048 + h * 256 + lane * 4);
      float a = bf2f((u16)(q.x & 0xffff)), b2 = bf2f((u16)(q.x >> 16)), c = bf2f((u16)(q.y & 0xffff)), d = bf2f((u16)(q.y >> 16));
      float ss = wave_sum(a * a + b2 * b2 + c * c + d * d);
      if (lane == 0) rstd[m * 8 + h] = rsqrtf(ss * (1.f / 256.f) + 1e-6f);
    }
  }
}

__device__ __forceinline__ void phase_final(const Params& p) {
  const int TT = opaque_tid();
  const float* g = p.in[I_FNG];
  const int lane = LTID & 63, wv = LTID >> 6;
  for (int m = (VBID * 4 + wv) * 2; m < NLAT; m += VGRID * 8) {
    float4 v[2][4]; float ss[2] = {0.f, 0.f};
#pragma unroll
    for (int q = 0; q < 2; ++q)
#pragma unroll
      for (int i = 0; i < 4; ++i) v[q][i] = *(const float4*)(p.out + (size_t)(m + q) * 1024 + i * 256 + lane * 4);
#pragma unroll
    for (int q = 0; q < 2; ++q) {
#pragma unroll
      for (int i = 0; i < 4; ++i) ss[q] += v[q][i].x * v[q][i].x + v[q][i].y * v[q][i].y + v[q][i].z * v[q][i].z + v[q][i].w * v[q][i].w;
      ss[q] = wave_sum(ss[q]);
    }
#pragma unroll
    for (int q = 0; q < 2; ++q) {
      const float rstd = rsqrtf(ss[q] * (1.f / 1024.f) + 1e-6f);
#pragma unroll
      for (int i = 0; i < 4; ++i) {
        int c = i * 256 + lane * 4;
        float4 gg = *(const float4*)(g + c);
        *(float4*)(p.out + (size_t)(m + q) * 1024 + c) = make_float4(v[q][i].x * rstd * gg.x, v[q][i].y * rstd * gg.y, v[q][i].z * rstd * gg.z, v[q][i].w * rstd * gg.w);
      }
    }
  }
}

#define XB_TMO      128
#define XB_XCNT(j)  (256  + 64 * (j))
#define XB_XSUB(j)  (1280 + 64 * (j))
#define XB_XGEN(j)  (2304 + 64 * (j))
#define XB_TOP      3328
#define XB_TOPGEN   3392
#define XCD_BAR_WORDS 3456
#define XB_SPIN_CAP (1u << 22)
#define LAS __attribute__((address_space(3)))
__device__ __forceinline__ unsigned xb_ld(unsigned* p)              { return __hip_atomic_load(p, __ATOMIC_RELAXED, __HIP_MEMORY_SCOPE_AGENT); }
__device__ __forceinline__ unsigned xb_add(unsigned* p, unsigned v) { return __hip_atomic_fetch_add(p, v, __ATOMIC_RELAXED, __HIP_MEMORY_SCOPE_AGENT); }
__device__ __forceinline__ unsigned xb_xcc_id() { return (unsigned)__builtin_amdgcn_s_getreg((3 << 11) | 20) & 0xFu; }
#define XB_SPIN(cond, bar) do { unsigned _sp = 0; while (cond) { __builtin_amdgcn_s_sleep(1); \
    if ((++_sp & 255u) == 0u) { if (xb_ld(&(bar)[XB_TMO])) break; if (_sp > XB_SPIN_CAP) { atomicAdd(&(bar)[XB_TMO], 1u); break; } } } } while (0)
struct XcdBarrier { unsigned* bar; unsigned x; volatile LAS unsigned* st; };
__device__ __forceinline__ XcdBarrier xcd_barrier_post(unsigned* bar, volatile LAS unsigned* st) {
  XcdBarrier b; b.bar = bar; b.x = xb_xcc_id(); b.st = st;
  if (threadIdx.x == 0) (void)xb_add(&bar[XB_XCNT(b.x)], 1u);
  return b;
}
__device__ __forceinline__ void xcd_barrier_complete(unsigned* bar, unsigned x, unsigned& nloc, unsigned& nx) {
  const unsigned G = gridDim.x * gridDim.y * gridDim.z;
  unsigned sum, cnt, mine, sp = 0u;
  for (;;) {
    sum = 0u; cnt = 0u; mine = 0u;
#pragma unroll
    for (unsigned j = 0; j < 16; ++j) { const unsigned c = xb_ld(&bar[XB_XCNT(j)]); sum += c; cnt += (c > 0u) ? 1u : 0u; mine = (j == x) ? c : mine; }
    if (sum == G) break;
    __builtin_amdgcn_s_sleep(1);
    if ((++sp & 255u) == 0u) { if (xb_ld(&bar[XB_TMO])) break; if (sp > XB_SPIN_CAP) { atomicAdd(&bar[XB_TMO], 1u); break; } }
  }
  nloc = mine > 0u ? mine : 1u; nx = cnt > 0u ? cnt : 1u;
}
__device__ __forceinline__ void xcd_barrier(const XcdBarrier& b) {
  asm volatile("s_waitcnt vmcnt(0)" ::: "memory");
  __syncthreads();
  if (threadIdx.x == 0) {
    unsigned* bar = b.bar;
    __builtin_amdgcn_s_waitcnt(0);
    unsigned nloc = b.st[0], nx = b.st[1];
    if (nloc == 0u) { xcd_barrier_complete(bar, b.x, nloc, nx); b.st[0] = nloc; b.st[1] = nx; }
    const unsigned old = xb_add(&bar[XB_XSUB(b.x)], 1u);
    const unsigned gen = old / nloc;
    if (old + 1u == (gen + 1u) * nloc) {
      __builtin_amdgcn_fence(__ATOMIC_RELEASE, "agent");
      asm volatile("s_waitcnt vmcnt(0)" ::: "memory");
      const unsigned og = xb_add(&bar[XB_TOP], 1u);
      const unsigned tg = og / nx;
      if (og + 1u == (tg + 1u) * nx) xb_add(&bar[XB_TOPGEN], 1u);
      else XB_SPIN(xb_ld(&bar[XB_TOPGEN]) == tg, bar);
      __builtin_amdgcn_fence(__ATOMIC_ACQUIRE, "agent");
      xb_add(&bar[XB_XGEN(b.x)], 1u);
      asm volatile("s_waitcnt vmcnt(0)" ::: "memory");
    } else {
      XB_SPIN(xb_ld(&bar[XB_XGEN(b.x)]) == gen, bar);
      __builtin_amdgcn_fence(__ATOMIC_ACQUIRE, "agent");
      asm volatile("s_waitcnt vmcnt(0)" ::: "memory");
    }
  }
  __syncthreads();
}

#ifndef PHMASK
#define PHMASK 0xFFFFFFFFFFFFFFFFull
#endif
#ifndef PHREP
#define PHREP 0ull
#endif
namespace pg8 {
#define PG8_LAS __attribute__((address_space(3)))
constexpr int BM = 256, BK = 64, HALF = 128, HTB = HALF * BK * 2, STAGE_BYTES = 8 * HTB, NXCD = 8, WGM = 4;
__device__ __forceinline__ int lds_byte(int r, int c) { const int st = (r >> 4) * 2 + (c >> 5), rr = r & 15, cc = c & 31, ob = rr * 64 + cc * 2; return st * 1024 + (ob ^ (((ob >> 9) & 1) << 5)); }
__device__ __forceinline__ void stage_rc(int b, int& R, int& C) { const int st = b / 1024, sb = b % 1024, swz = sb ^ (((sb >> 9) & 1) << 5); R = (st >> 1) * 16 + swz / 64; C = (st & 1) * 32 + (swz % 64) / 2; }
__device__ __forceinline__ int perm32(int rho) { const int n = rho >> 4, i = rho & 15; return 8 * (i >> 2) + 4 * n + (i & 3); }
struct Unit { int pm, pn; };
struct Gemm { const u16* A; const u16* Bt; int M, N, K, lda; };
struct StaticOrder {
  int nM, nN, nwg, G, c;
  __device__ void init(int M, int N, int G_, int c_) { nM = M / BM; nN = N / BM; nwg = nM * nN; G = G_; c = c_; }
  __device__ bool next(int i, Unit& u) const {
    const long L = (long)i * G + c; if (L >= nwg) return false;
    int wgid = (int)L; { const int q = nwg / NXCD, r = nwg % NXCD, xcd = wgid % NXCD, off = wgid / NXCD; wgid = (xcd < r ? xcd * (q + 1) : r * (q + 1) + (xcd - r) * q) + off; }
    const int nig = WGM * nN, gid = wgid / nig, fm = gid * WGM, gsz = (nM - fm) < WGM ? (nM - fm) : WGM;
    u.pm = fm + ((wgid % nig) % gsz); u.pn = (wgid % nig) / gsz; return true;
  }
};
template <class Epi>
__device__ __forceinline__ void gemm_phase(PG8_LAS unsigned char* lds, const Gemm g, const StaticOrder& S, const Epi& E) {
  const int tid = opaque_tid(), wid = __builtin_amdgcn_readfirstlane(tid >> 6), lane = tid & 63, wr = wid >> 2, wc = wid & 3, fr = lane & 15, fq = lane >> 4;
  const int K = g.K, nt = K / BK;
  unsigned voffA[2], voffB[2];
#pragma unroll
  for (int i = 0; i < 2; ++i) { int R, C; stage_rc(tid * 16 + i * 8192, R, C);
    const int Rb = Epi::PERM ? ((R & ~31) + perm32(R & 31)) : R;
    voffA[i] = (unsigned)(R * g.lda + C) * 2u; voffB[i] = (unsigned)(Rb * K + C) * 2u; }
  const size_t kstep = (size_t)(BK * 2);
  const size_t hstepA = (size_t)HALF * g.lda * 2, hstepB = (size_t)HALF * K * 2;
  const size_t tstepA = 2 * hstepA, tstepB = 2 * hstepB;
  const unsigned ldsw = (unsigned)wid * 1024u;
  const int aoff = lds_byte(wr * 64 + fr, fq * 8), boff = lds_byte(wc * 32 + fr, fq * 8);
#define PG8_SA(b, h) (((b) * 2 + (h)) * HTB)
#define PG8_SB(b, h) ((4 + (b) * 2 + (h)) * HTB)
#define PG8_STAGE(bufoff, gbase, voff) do { _Pragma("unroll") for (int _i = 0; _i < 2; ++_i) \
        __builtin_amdgcn_global_load_lds((const unsigned*)((const char*)(gbase) + (voff)[_i]), (PG8_LAS unsigned*)(lds + (bufoff) + ldsw + _i * 8192), 16, 0, 0); } while (0)
#define PG8_LDA(dst, b, h) do { _Pragma("unroll") for (int m = 0; m < 4; ++m) _Pragma("unroll") for (int k = 0; k < 2; ++k) dst[m][k] = *(const PG8_LAS bf16x8*)(lds + PG8_SA(b, h) + aoff + m * 2048 + k * 1024); } while (0)
#define PG8_LDB(dst, b, h) do { _Pragma("unroll") for (int n = 0; n < 2; ++n) _Pragma("unroll") for (int k = 0; k < 2; ++k) dst[n][k] = *(const PG8_LAS bf16x8*)(lds + PG8_SB(b, h) + boff + n * 2048 + k * 1024); } while (0)
#define PG8_MMA(ai, bj, At, Bt) do { __builtin_amdgcn_s_setprio(1); _Pragma("unroll") for (int m = 0; m < 4; ++m) _Pragma("unroll") for (int n = 0; n < 2; ++n) _Pragma("unroll") for (int k = 0; k < 2; ++k) \
        acc[ai][bj][m][n] = __builtin_amdgcn_mfma_f32_16x16x32_bf16(Bt[n][k], At[m][k], acc[ai][bj][m][n], 0, 0, 0); __builtin_amdgcn_s_setprio(0); } while (0)
#define PG8_WAIT_V(n) asm volatile("s_waitcnt vmcnt(" #n ")" ::: "memory")
#define PG8_WAIT_L(n) asm volatile("s_waitcnt lgkmcnt(" #n ")" ::: "memory")
#define PG8_BAR __builtin_amdgcn_s_barrier()
#define PG8_SCHED __builtin_amdgcn_sched_barrier(0)
  Unit cur, nxt; int ui = 0;
  if (!S.next(0, cur)) return;
  f32x4 acc[2][2][4][2];
#pragma unroll
  for (int a = 0; a < 2; ++a)
#pragma unroll
    for (int b = 0; b < 2; ++b)
#pragma unroll
      for (int m = 0; m < 4; ++m)
#pragma unroll
        for (int n = 0; n < 2; ++n) acc[a][b][m][n] = (f32x4){0.f, 0.f, 0.f, 0.f};
  bf16x8 At[4][2], B0[2][2], B1[2][2];
  const char* cA = (const char*)g.A + (size_t)cur.pm * tstepA; const char* cB = (const char*)g.Bt + (size_t)cur.pn * tstepB;
  PG8_STAGE(PG8_SB(0, 0), cB, voffB); PG8_STAGE(PG8_SA(0, 0), cA, voffA); PG8_STAGE(PG8_SB(0, 1), cB + hstepB, voffB); PG8_STAGE(PG8_SA(0, 1), cA + hstepA, voffA);
  if (wr == 1) PG8_BAR;
  PG8_WAIT_V(4); PG8_BAR;
  PG8_STAGE(PG8_SB(1, 0), cB + kstep, voffB); PG8_STAGE(PG8_SA(1, 0), cA + kstep, voffA); PG8_STAGE(PG8_SB(1, 1), cB + hstepB + kstep, voffB);
  PG8_WAIT_V(6); PG8_BAR;
  for (;;) {
    const bool has_next = S.next(ui + 1, nxt);
    const char* nA = has_next ? (const char*)g.A + (size_t)nxt.pm * tstepA : cA; const char* nB = has_next ? (const char*)g.Bt + (size_t)nxt.pn * tstepB : cB;
    for (int t = 0; t < nt; t += 2) {
      const bool last = (t == nt - 2);
      const char* a1 = cA + (size_t)(t + 1) * kstep;
      const char* a2 = last ? nA : cA + (size_t)(t + 2) * kstep; const char* b2 = last ? nB : cB + (size_t)(t + 2) * kstep;
      const char* a3 = a2 + kstep; const char* b3 = b2 + kstep;
      PG8_LDB(B0, 0, 0); PG8_SCHED; PG8_LDA(At, 0, 0); PG8_STAGE(PG8_SA(1, 1), a1 + hstepA, voffA);
      PG8_WAIT_L(8); PG8_BAR; PG8_WAIT_L(0); PG8_MMA(0, 0, At, B0); PG8_BAR; PG8_SCHED;
      PG8_LDB(B1, 0, 1); PG8_STAGE(PG8_SB(0, 0), b2, voffB);
      PG8_BAR; PG8_WAIT_L(0); PG8_MMA(0, 1, At, B1); PG8_BAR;
      PG8_LDA(At, 0, 1); PG8_STAGE(PG8_SA(0, 0), a2, voffA);
      PG8_BAR; PG8_WAIT_L(0); PG8_MMA(1, 0, At, B0); PG8_BAR; PG8_SCHED;
      PG8_STAGE(PG8_SB(0, 1), b2 + hstepB, voffB);
      PG8_WAIT_V(6); PG8_BAR; PG8_MMA(1, 1, At, B1); PG8_BAR;
      PG8_LDB(B0, 1, 0); PG8_SCHED; PG8_LDA(At, 1, 0); PG8_STAGE(PG8_SA(0, 1), a2 + hstepA, voffA);
      PG8_WAIT_L(8); PG8_BAR; PG8_WAIT_L(0); PG8_MMA(0, 0, At, B0); PG8_BAR; PG8_SCHED;
      PG8_LDB(B1, 1, 1); PG8_STAGE(PG8_SB(1, 0), b3, voffB);
      PG8_BAR; PG8_WAIT_L(0); PG8_MMA(0, 1, At, B1); PG8_BAR;
      PG8_LDA(At, 1, 1); PG8_STAGE(PG8_SA(1, 0), a3, voffA);
      PG8_BAR; PG8_WAIT_L(0); PG8_MMA(1, 0, At, B0); PG8_BAR; PG8_SCHED;
      PG8_STAGE(PG8_SB(1, 1), b3 + hstepB, voffB);
      PG8_WAIT_V(6); PG8_BAR; PG8_MMA(1, 1, At, B1); PG8_BAR;
    }
    E(acc, cur, wr, wc, fr, fq);
    if (!has_next) break;
#pragma unroll
    for (int a = 0; a < 2; ++a)
#pragma unroll
      for (int b = 0; b < 2; ++b)
#pragma unroll
        for (int m = 0; m < 4; ++m)
#pragma unroll
          for (int n = 0; n < 2; ++n) acc[a][b][m][n] = (f32x4){0.f, 0.f, 0.f, 0.f};
    cur = nxt; cA = nA; cB = nB; ++ui;
  }
  PG8_WAIT_V(0);
  if (wr == 0) PG8_BAR;
  PG8_BAR;
#undef PG8_SA
#undef PG8_SB
#undef PG8_STAGE
#undef PG8_LDA
#undef PG8_LDB
#undef PG8_MMA
#undef PG8_WAIT_V
#undef PG8_WAIT_L
#undef PG8_BAR
#undef PG8_SCHED
}
}

template <class Epi> struct PgEpi {
  static constexpr bool PERM = Epi::PERM;
  Epi e; int nreal;
  __device__ __forceinline__ void operator()(const f32x4 (&acc)[2][2][4][2], const pg8::Unit& u, int wr, int wc, int fr, int fq) const {
#pragma unroll
    for (int ai = 0; ai < 2; ++ai)
#pragma unroll
      for (int m = 0; m < 4; ++m) {
        const int row = u.pm * 256 + ai * 128 + wr * 64 + m * 16 + fr;
#pragma unroll
        for (int bj = 0; bj < 2; ++bj) {
          if constexpr (Epi::PERM) {
            const int col = u.pn * 256 + bj * 128 + wc * 32 + 8 * fq;
            if (col < nreal) e.store8(row, col, acc[ai][bj][m][0], acc[ai][bj][m][1]);
          } else {
#pragma unroll
            for (int n = 0; n < 2; ++n) {
              const int col = u.pn * 256 + bj * 128 + wc * 32 + n * 16 + 4 * fq;
              if (col < nreal) e(row, col, acc[ai][bj][m][n]);
            }
          }
        }
      }
  }
};
template <> struct PgEpi<EpiRes> {
  static constexpr bool PERM = false;
  EpiRes e; int nreal;
  __device__ __forceinline__ void operator()(const f32x4 (&acc)[2][2][4][2], const pg8::Unit& u, int wr, int wc, int fr, int fq) const {
    const int row0 = u.pm * 256 + e.moff;
    const int col0 = u.pn * 256 + wc * 32 + 4 * fq;
    const float* g = e.modv_l + (mod_row(row0) * 6 + e.gi) * 1024 + col0;
    f32x4 gv[2][2];
#pragma unroll
    for (int bj = 0; bj < 2; ++bj)
#pragma unroll
      for (int n = 0; n < 2; ++n) gv[bj][n] = *(const f32x4*)(g + bj * 128 + n * 16);
    const bool isctx = row0 < NCTX;
    const float* sb = isctx ? e.src_c + (size_t)row0 * 1024 : e.src_l + (size_t)(row0 - NCTX) * 1024;
    float* db = isctx ? e.dst_c + (size_t)row0 * 1024 : e.dst_l + (size_t)(row0 - NCTX) * 1024;
#pragma unroll
    for (int ai = 0; ai < 2; ++ai)
#pragma unroll
      for (int mp = 0; mp < 2; ++mp) {
        f32x4 x[2][2][2];
#pragma unroll
        for (int mi = 0; mi < 2; ++mi) {
          const size_t off = (size_t)(ai * 128 + wr * 64 + (mp * 2 + mi) * 16 + fr) * 1024 + col0;
#pragma unroll
          for (int bj = 0; bj < 2; ++bj)
#pragma unroll
            for (int n = 0; n < 2; ++n) x[mi][bj][n] = *(const f32x4*)(sb + off + bj * 128 + n * 16);
        }
        asm volatile("" ::: "memory");
#pragma unroll
        for (int mi = 0; mi < 2; ++mi) {
          const size_t off = (size_t)(ai * 128 + wr * 64 + (mp * 2 + mi) * 16 + fr) * 1024 + col0;
#pragma unroll
          for (int bj = 0; bj < 2; ++bj)
#pragma unroll
            for (int n = 0; n < 2; ++n) *(f32x4*)(db + off + bj * 128 + n * 16) = x[mi][bj][n] + gv[bj][n] * acc[ai][bj][mp * 2 + mi][n];
        }
        asm volatile("" ::: "memory");
      }
  }
};
template <> struct PgEpi<EpiGate> {
  static constexpr bool PERM = true;
  EpiGate e; int nreal;
  __device__ __forceinline__ void operator()(const f32x4 (&acc)[2][2][4][2], const pg8::Unit& u, int wr, int wc, int fr, int fq) const {
    const int col0 = u.pn * 256 + wc * 32 + 8 * fq;
    u32x4 yv[2][4][2]; float rs[2][4];
#pragma unroll
    for (int ai = 0; ai < 2; ++ai)
#pragma unroll
      for (int m = 0; m < 4; ++m) {
        const int row = u.pm * 256 + ai * 128 + wr * 64 + m * 16 + fr;
        rs[ai][m] = e.rstd[row * 8 + u.pn];
#pragma unroll
        for (int bj = 0; bj < 2; ++bj) yv[ai][m][bj] = *(const u32x4*)(e.Y + (size_t)row * 2048 + col0 + bj * 128);
      }
    asm volatile("" ::: "memory");
#pragma unroll
    for (int ai = 0; ai < 2; ++ai)
#pragma unroll
      for (int m = 0; m < 4; ++m) {
        const int row = u.pm * 256 + ai * 128 + wr * 64 + m * 16 + fr;
#pragma unroll
        for (int bj = 0; bj < 2; ++bj) {
          const f32x4 a = acc[ai][bj][m][0], b = acc[ai][bj][m][1];
          const float r = rs[ai][m];
          const u32x4 yy = yv[ai][m][bj];
          float o[8];
          o[0] = siluf_(a[0]) * XLO(yy[0]) * r; o[1] = siluf_(a[1]) * XHI(yy[0]) * r;
          o[2] = siluf_(a[2]) * XLO(yy[1]) * r; o[3] = siluf_(a[3]) * XHI(yy[1]) * r;
          o[4] = siluf_(b[0]) * XLO(yy[2]) * r; o[5] = siluf_(b[1]) * XHI(yy[2]) * r;
          o[6] = siluf_(b[2]) * XLO(yy[3]) * r; o[7] = siluf_(b[3]) * XHI(yy[3]) * r;
          *(u32x4*)(e.Y + (size_t)row * 2048 + col0 + bj * 128) = pack8(o);
        }
      }
  }
};
template <class Epi>
__device__ __forceinline__ void big_gemm(const u16* A, int lda, const u16* Bt, int M, int N, int K, Epi epi, char* smem) {
  const int npad = (N + 255) & ~255;
  pg8::StaticOrder S; S.init(M, npad, gridDim.x, blockIdx.x);
  pg8::Gemm g{A, Bt, M, npad, K, lda};
  PgEpi<Epi> E{epi, N};
  pg8::gemm_phase((PG8_LAS unsigned char*)smem, g, S, E);
  __syncthreads();
}

__global__ void __launch_bounds__(512, 2) mega(Params p) {
  extern __shared__ __attribute__((aligned(16))) char smem0[];
#define HSMEM (smem0 + (opaque_tid() >> 8) * HALF_LDS)
  cg::grid_group grid = cg::this_grid();
  volatile LAS unsigned* xst = (volatile LAS unsigned*)(smem0 + LDS_BYTES);
  if (threadIdx.x == 0) { xst[0] = 0u; xst[1] = 0u; }
  __syncthreads();
  XcdBarrier xb = xcd_barrier_post((unsigned*)(p.ws + O_BAR), xst);
  u16* W = (u16*)p.ws;
  float* modv = (float*)(p.ws + O_MODV);
  float* ctxr = (float*)(p.ws + O_CTXR);
  u16* hx0 = (u16*)((char*)p.out + DO_HX);
  u16* hx = (u16*)(p.ws + O_HX);

  for (int rep_ = 0; rep_ < (int)(((PHMASK >> 0) & 1ull) + ((PHREP >> 0) & 1ull)); ++rep_) {
  phase_prep(p, HSMEM);
  }
  grid.sync();
  for (int rep_ = 0; rep_ < (int)(((PHMASK >> 1) & 1ull) + ((PHREP >> 1) & 1ull)); ++rep_) {
  phase_norm(p.in[I_CTX], p.in[I_X], p.in[I_N1G], modv, 0, 1, hx0, 0, NTOK);
  }
  xcd_barrier(xb);
  for (int rep_ = 0; rep_ < (int)(((PHMASK >> 2) & 1ull) + ((PHREP >> 2) & 1ull)); ++rep_) {
  big_gemm(hx0, 1024, W + W_EVIN, NTOK, PW, 1024, EpiStore{(u16*)(p.ws + O_P), PW}, smem0);
  }
  xcd_barrier(xb);
  for (int rep_ = 0; rep_ < (int)(((PHMASK >> 3) & 1ull) + ((PHREP >> 3) & 1ull)); ++rep_) {
  phase_feat(p);
  phase_xbc(p);
  }
  xcd_barrier(xb);
  {
    const u16* L = (const u16*)((const char*)p.out + DO_L);
    for (int rep_ = 0; rep_ < (int)(((PHMASK >> 4) & 1ull) + ((PHREP >> 4) & 1ull)); ++rep_) {
    gemm_phase(L + 0, 384, W + W_W2F, 64, NTOK, 512, 64, EpiE{(u16*)(p.ws + O_SEF), p.in[I_W0F]}, HSMEM);
    }
    for (int rep_ = 0; rep_ < (int)(((PHMASK >> 5) & 1ull) + ((PHREP >> 5) & 1ull)); ++rep_) {
    gemm_phase(L + 64, 384, W + W_W2B, 64, NTOK, 512, 64, EpiE{(u16*)(p.ws + O_SEB), p.in[I_W0B]}, HSMEM);
    }
    for (int rep_ = 0; rep_ < (int)(((PHMASK >> 6) & 1ull) + ((PHREP >> 6) & 1ull)); ++rep_) {
    gemm_phase(L + 128, 384, W + W_A2F, 64, NTOK, 512, 64, EpiI{(u16*)(p.ws + O_SIF), p.in[I_A0F]}, HSMEM);
    }
    for (int rep_ = 0; rep_ < (int)(((PHMASK >> 7) & 1ull) + ((PHREP >> 7) & 1ull)); ++rep_) {
    gemm_phase(L + 192, 384, W + W_A2B, 64, NTOK, 512, 64, EpiI{(u16*)(p.ws + O_SIB), p.in[I_A0B]}, HSMEM);
    }
    for (int rep_ = 0; rep_ < (int)(((PHMASK >> 8) & 1ull) + ((PHREP >> 8) & 1ull)); ++rep_) {
    gemm_phase(L + 256, 384, W + W_G2, 128, NTOK, 512, 128, EpiStore{(u16*)((char*)p.out + DO_G), 512}, HSMEM);
    }
    for (int rep_ = 0; rep_ < (int)(((PHMASK >> 9) & 1ull) + ((PHREP >> 9) & 1ull)); ++rep_) {
    phase_ssd_prep(p);
    }
  }
  xcd_barrier(xb);
  for (int rep_ = 0; rep_ < (int)(((PHMASK >> 10) & 1ull) + ((PHREP >> 10) & 1ull)); ++rep_) {
  phase_rwkv(p, smem0);
  }
  xcd_barrier(xb);
  for (int rep_ = 0; rep_ < (int)(((PHMASK >> 11) & 1ull) + ((PHREP >> 11) & 1ull)); ++rep_) {
  phase_ssd_states(p, HSMEM);
  }
  xcd_barrier(xb);
  for (int rep_ = 0; rep_ < (int)(((PHMASK >> 12) & 1ull) + ((PHREP >> 12) & 1ull)); ++rep_) {
  phase_ssd_scan(p);
  }
  xcd_barrier(xb);
  for (int rep_ = 0; rep_ < (int)(((PHMASK >> 13) & 1ull) + ((PHREP >> 13) & 1ull)); ++rep_) {
  phase_ssd_out(p, HSMEM);
  }
  xcd_barrier(xb);
  for (int rep_ = 0; rep_ < (int)(((PHMASK >> 14) & 1ull) + ((PHREP >> 14) & 1ull)); ++rep_) {
  phase_finish(p);
  }
  xcd_barrier(xb);
  for (int rep_ = 0; rep_ < (int)(((PHMASK >> 15) & 1ull) + ((PHREP >> 15) & 1ull)); ++rep_) {
  big_gemm((const u16*)(p.ws + O_MIXED), 1024, W + W_EVOUT, NTOK, 1024, 1024,
             EpiRes{p.in[I_CTX], p.in[I_X], ctxr, p.out, modv, 2, 0}, smem0);
  }
  xcd_barrier(xb);
  for (int rep_ = 0; rep_ < (int)(((PHMASK >> 16) & 1ull) + ((PHREP >> 16) & 1ull)); ++rep_) {
  phase_norm(ctxr, p.out, p.in[I_N2G], modv, 3, 4, hx, 0, NTOK);
  }
  xcd_barrier(xb);
  for (int rep_ = 0; rep_ < (int)(((PHMASK >> 17) & 1ull) + ((PHREP >> 17) & 1ull)); ++rep_) {
  big_gemm(hx, 1024, W + W_UP0, NTOK, 5632, 1024, EpiStore{(u16*)(p.ws + O_GV), 5632}, smem0);
  }
  xcd_barrier(xb);
  for (int rep_ = 0; rep_ < (int)(((PHMASK >> 18) & 1ull) + ((PHREP >> 18) & 1ull)); ++rep_) {
  phase_ffnconv(p, 0, 0);
  }
  xcd_barrier(xb);
  for (int rep_ = 0; rep_ < (int)(((PHMASK >> 19) & 1ull) + ((PHREP >> 19) & 1ull)); ++rep_) {
  big_gemm((const u16*)(p.ws + O_GV) + 2816, 5632, W + W_DN0, NTOK, 1024, 2816,
             EpiRes{ctxr, p.out, ctxr, p.out, modv, 5, 0}, smem0);
  }
  xcd_barrier(xb);
  const float* modv1 = modv + 9 * 6144;
  for (int rep_ = 0; rep_ < (int)(((PHMASK >> 20) & 1ull) + ((PHREP >> 20) & 1ull)); ++rep_) {
  phase_norm(ctxr, p.out, p.in[I_N1G] + 1024, modv1, 0, 1, hx, 0, NTOK);
  }
  xcd_barrier(xb);
  for (int rep_ = 0; rep_ < (int)(((PHMASK >> 21) & 1ull) + ((PHREP >> 21) & 1ull)); ++rep_) {
  big_gemm(hx, 1024, W + W_RIN, NTOK, 4096, 1024, EpiQKV{(u16*)(p.ws + O_QKV)}, smem0);
  }
  xcd_barrier(xb);
  for (int rep_ = 0; rep_ < (int)(((PHMASK >> 22) & 1ull) + ((PHREP >> 22) & 1ull)); ++rep_) {
  phase_rope(p);
  }
  xcd_barrier(xb);
  for (int rep_ = 0; rep_ < (int)(((PHMASK >> 23) & 1ull) + ((PHREP >> 23) & 1ull)); ++rep_) {
  phase_retention(p, smem0);
  }
  xcd_barrier(xb);
  for (int rep_ = 0; rep_ < (int)(((PHMASK >> 24) & 1ull) + ((PHREP >> 24) & 1ull)); ++rep_) {
  phase_ynorm(p);
  }
  xcd_barrier(xb);
  for (int rep_ = 0; rep_ < (int)(((PHMASK >> 25) & 1ull) + ((PHREP >> 25) & 1ull)); ++rep_) {
  big_gemm(hx + (size_t)NCTX * 1024, 1024, W + W_RIN + 4096ull * 1024, NLAT, 2048, 1024,
             EpiGate{(u16*)(p.ws + O_Y), (const float*)(p.ws + O_RSTD)}, smem0);
  }
  xcd_barrier(xb);
  for (int rep_ = 0; rep_ < (int)(((PHMASK >> 26) & 1ull) + ((PHREP >> 26) & 1ull)); ++rep_) {
  big_gemm((const u16*)(p.ws + O_Y), 2048, W + W_ROUT, NLAT, 1024, 2048,
             EpiRes{ctxr, p.out, ctxr, p.out, modv1, 2, NCTX}, smem0);
  }
  xcd_barrier(xb);
  for (int rep_ = 0; rep_ < (int)(((PHMASK >> 27) & 1ull) + ((PHREP >> 27) & 1ull)); ++rep_) {
  phase_norm(ctxr, p.out, p.in[I_N2G] + 1024, modv1, 3, 4, hx, NCTX, NTOK);
  }
  xcd_barrier(xb);
  for (int rep_ = 0; rep_ < (int)(((PHMASK >> 28) & 1ull) + ((PHREP >> 28) & 1ull)); ++rep_) {
  big_gemm(hx + (size_t)NCTX * 1024, 1024, W + W_UP1, NLAT, 5632, 1024,
             EpiStore{(u16*)(p.ws + O_GV) + (size_t)NCTX * 5632, 5632}, smem0);
  }
  xcd_barrier(xb);
  for (int rep_ = 0; rep_ < (int)(((PHMASK >> 29) & 1ull) + ((PHREP >> 29) & 1ull)); ++rep_) {
  phase_ffnconv(p, 1, NCTX);
  }
  xcd_barrier(xb);
  for (int rep_ = 0; rep_ < (int)(((PHMASK >> 30) & 1ull) + ((PHREP >> 30) & 1ull)); ++rep_) {
  big_gemm((const u16*)(p.ws + O_GV) + (size_t)NCTX * 5632 + 2816, 5632, W + W_DN1, NLAT, 1024, 2816,
             EpiRes{ctxr, p.out, ctxr, p.out, modv1, 5, NCTX}, smem0);
  }
  xcd_barrier(xb);
  for (int rep_ = 0; rep_ < (int)(((PHMASK >> 31) & 1ull) + ((PHREP >> 31) & 1ull)); ++rep_) {
  phase_final(p);
  }
}

extern "C" void kernel_launch(void* const* d_in, const int* in_sizes, int n_in, void* d_out, int out_size, void* d_ws,
                              size_t ws_size, hipStream_t stream) {
  static int grid_blocks = 0;
  if (!grid_blocks) {
    int dev = 0, cus = 0, per_cu = 0;
    hipGetDevice(&dev);
    hipDeviceGetAttribute(&cus, hipDeviceAttributeMultiprocessorCount, dev);
    hipFuncSetAttribute((const void*)mega, hipFuncAttributeMaxDynamicSharedMemorySize, LDS_BYTES + 16);
    hipOccupancyMaxActiveBlocksPerMultiprocessor(&per_cu, (const void*)mega, 512, LDS_BYTES + 16);
    if (per_cu < 1) per_cu = 1;
    if (per_cu > 1) per_cu = 1;
    grid_blocks = cus * per_cu;
    fprintf(stderr, "mega: cus=%d per_cu=%d grid=%d ws=%zu\n", cus, per_cu, grid_blocks, ws_size);
  }
  Params p{};
  for (int i = 0; i < N_IN; ++i) p.in[i] = (const float*)d_in[i];
  p.out = (float*)d_out;
  p.ws = (char*)d_ws;
  hipMemsetAsync((char*)d_ws + O_BAR, 0, XCD_BAR_WORDS * 4, stream);
  void* args[] = {&p};
  hipError_t e = hipLaunchCooperativeKernel((const void*)mega, dim3(grid_blocks), dim3(512), args, LDS_BYTES + 16, stream);
  if (e != hipSuccess) fprintf(stderr, "cooperative launch failed: %s (grid %d)\n", hipGetErrorString(e), grid_blocks);
}
```

```cpp
#include <hip/hip_runtime.h>
#include <hip/hip_cooperative_groups.h>
#include <cstdio>
namespace cg = cooperative_groups;

typedef unsigned short u16;
using bf16x8 = __attribute__((ext_vector_type(8))) short;
using f32x4 = __attribute__((ext_vector_type(4))) float;
using u32x4 = __attribute__((ext_vector_type(4))) unsigned int;

#define NTOK 67584
#define NCTX 2048
#define NLAT 65536
#define PW 3472
#define LDS_BYTES 147456
#define HALF_LDS 73728
#define LTID ((int)(TT & 255))
#define VBID ((int)(blockIdx.x * 2 + (TT >> 8)))
__device__ __forceinline__ int opaque_tid() { int t = threadIdx.x; asm volatile("" : "+v"(t)); return t; }
#define VGRID ((int)(gridDim.x * 2))

enum { I_X = 0, I_C, I_CTX, I_CCTX, I_MODW, I_MODB, I_N1G, I_N2G, I_FUP, I_FCW, I_FCB, I_FDN,
       I_EVIN, I_MUP, I_MUN, I_W0F, I_W0B, I_W2F, I_W2B, I_A0F, I_A0B, I_A2F, I_A2B, I_G2, I_KK, I_KA, I_RK,
       I_LNW, I_LNB, I_SCW, I_SCB, I_DTBF, I_DTBB, I_ALF, I_ALB, I_SD, I_SNW, I_EVOUT, I_RIN, I_L2F, I_L2B, I_ROUT, I_FNG, N_IN };

struct Params { const float* in[N_IN]; float* out; char* ws; };

#define MiB (1024ull * 1024ull)
#define W_EVIN   0ull
#define W_EVOUT  (W_EVIN + 3472ull * 1024)
#define W_UP0    (W_EVOUT + 1024ull * 1024)
#define W_UP1    (W_UP0 + 5632ull * 1024)
#define W_DN0    (W_UP1 + 5632ull * 1024)
#define W_DN1    (W_DN0 + 1024ull * 2816)
#define W_RIN    (W_DN1 + 1024ull * 2816)
#define W_ROUT   (W_RIN + 6144ull * 1024)
#define W_W2F    (W_ROUT + 1024ull * 2048)
#define W_W2B    (W_W2F + 512ull * 64)
#define W_A2F    (W_W2B + 512ull * 64)
#define W_A2B    (W_A2F + 512ull * 64)
#define W_G2     (W_A2B + 512ull * 64)
#define O_SMALL  (64 * MiB)
#define O_MODV   (O_SMALL)
#define O_ROPE   (O_MODV + 2ull * 9 * 6144 * 4)
#define O_CTXR   (O_SMALL + 1 * MiB)
#define O_RN     (O_CTXR + 8 * MiB)
#define O_BONUS  (O_RN + 2162688ull)
#define O_DT     (O_BONUS + 2162688ull)
#define O_CS     (O_DT + 2 * 2162688ull)
#define O_RSTD   (O_CS + 2 * 2162688ull)
#define O_BAR    (O_RSTD + 2097152ull)
#define O_BIG    (96 * MiB)
#define SZ_TOK512 (69206016ull)
#define O_P      (O_BIG)
#define O_S      (544 * MiB)
#define O_SR     (O_S)
#define O_SK     (O_S + SZ_TOK512)
#define O_SV     (O_S + 2 * SZ_TOK512)
#define O_SEF    (O_S + 3 * SZ_TOK512)
#define O_SEB    (O_S + 4 * SZ_TOK512)
#define O_SIF    (O_S + 5 * SZ_TOK512)
#define O_SIB    (O_S + 6 * SZ_TOK512)
#define O_STATES (O_SEF)
#define O_MIXED  (O_SR)
#define O_HX     (O_BIG)
#define O_GV     (228 * MiB)
#define O_QKV    (228 * MiB)
#define O_Y      (756 * MiB)
#define DO_HX    0ull
#define DO_L     (138412032ull)
#define DO_G     (DO_L + 51904512ull)

__device__ __forceinline__ unsigned pack2(float a, float b) {
  unsigned r;
  asm("v_cvt_pk_bf16_f32 %0, %1, %2" : "=v"(r) : "v"(a), "v"(b));
  return r;
}
__device__ __forceinline__ u16 f2bf(float f) { return (u16)(pack2(f, f) & 0xffffu); }
__device__ __forceinline__ float bf2f(u16 h) { return __uint_as_float(((unsigned)h) << 16); }
__device__ __forceinline__ uint2 pack4(float a, float b, float c, float d) { return make_uint2(pack2(a, b), pack2(c, d)); }
__device__ __forceinline__ float sigmoidf_(float x) { return __builtin_amdgcn_rcpf(1.f + __expf(-x)); }
__device__ __forceinline__ float siluf_(float x) { return x * __builtin_amdgcn_rcpf(1.f + __expf(-x)); }
__device__ __forceinline__ float tanhf_(float x) { return 1.f - 2.f * __builtin_amdgcn_rcpf(__expf(2.f * x) + 1.f); }
__device__ __forceinline__ float softplusf_(float x) { return x > 20.f ? x : log1pf(__expf(x)); }
__device__ __forceinline__ float geluf_(float x) { return 0.5f * x * (1.f + tanhf_(0.7978845608028654f * (x + 0.044715f * x * x * x))); }
__device__ __forceinline__ float wave_sum(float v) {
#pragma unroll
  for (int o = 32; o; o >>= 1) v += __shfl_xor(v, o);
  return v;
}
template <int C> __device__ __forceinline__ float dppf(float v) {
  return __int_as_float(__builtin_amdgcn_update_dpp(0, __float_as_int(v), C, 0xF, 0xF, true));
}
__device__ __forceinline__ float red16(float v) {
  v += dppf<0xB1>(v);
  v += dppf<0x4E>(v);
  v += dppf<0x141>(v);
  v += dppf<0x140>(v);
  return v;
}
__device__ __forceinline__ bool has_prev(int m) { return m < NCTX ? (m & 255) != 0 : ((m - NCTX) & 8191) != 0; }
__device__ __forceinline__ bool has_next(int m) { return m < NCTX ? (m & 255) != 255 : ((m - NCTX) & 8191) != 8191; }
__device__ __forceinline__ int mod_row(int m) { return m < NCTX ? 8 : ((m - NCTX) >> 13); }
__device__ __forceinline__ int scan_tok(int dir, int b, int s) {
  if (s < 256) return b * 256 + (dir ? 255 - s : s);
  int t = s - 256;
  return NCTX + b * 8192 + (dir ? 8191 - t : t);
}
__device__ __forceinline__ bf16x8 ldfrag(const u16* base, int stride, int row0, int k0, int lane) {
  return *(const bf16x8*)(base + (row0 + (lane & 15)) * stride + k0 + (lane >> 4) * 8);
}
__device__ __forceinline__ f32x4 mma(bf16x8 afrag, bf16x8 bfrag, f32x4 acc) {
  return __builtin_amdgcn_mfma_f32_16x16x32_bf16(bfrag, afrag, acc, 0, 0, 0);
}

template <class Epi> __forceinline__
__device__ __forceinline__ void gemm_phase(const u16* __restrict__ A, int lda, const u16* __restrict__ Bt, int ldb, int M, int N, int K,
                           Epi epi, char* smem_) {
  const int TT = opaque_tid();
  u16* As = (u16*)smem_;
  u16* Bs = As + 128 * 72;
  const int tid = LTID, lane = tid & 63, wave = tid >> 6;
  const int wm = (wave >> 1) * 64, wn = (wave & 1) * 64;
  const int tiles_n = (N + 127) >> 7, tiles_m = (M + 127) >> 7;
  const int ntiles = tiles_m * tiles_n;
  const int lrow = tid >> 3, lkc = (tid & 7) * 8;
  for (int vb = VBID; vb < ntiles; vb += VGRID) {
    const int tm = vb / tiles_n, tn = vb - tm * tiles_n;
    const int m0 = tm * 128, n0 = tn * 128;
    f32x4 acc[4][4];
#pragma unroll
    for (int i = 0; i < 4; ++i)
#pragma unroll
      for (int j = 0; j < 4; ++j) acc[i][j] = (f32x4){0.f, 0.f, 0.f, 0.f};
    u32x4 ra[4], rb[4];
    const u16* ap[4];
    const u16* bp[4];
#pragma unroll
    for (int i = 0; i < 4; ++i) {
      int row = lrow + i * 32;
      int am = min(m0 + row, M - 1), bn = min(n0 + row, N - 1);
      ap[i] = A + (size_t)am * lda + lkc;
      bp[i] = Bt + (size_t)bn * ldb + lkc;
    }
#pragma unroll
    for (int i = 0; i < 4; ++i) { ra[i] = *(const u32x4*)(ap[i]); rb[i] = *(const u32x4*)(bp[i]); }
    for (int k0 = 0; k0 < K; k0 += 64) {
      __syncthreads();
#pragma unroll
      for (int i = 0; i < 4; ++i) {
        *(u32x4*)(As + (lrow + i * 32) * 72 + lkc) = ra[i];
        *(u32x4*)(Bs + (lrow + i * 32) * 72 + lkc) = rb[i];
      }
      __syncthreads();
      if (k0 + 64 < K) {
#pragma unroll
        for (int i = 0; i < 4; ++i) { ra[i] = *(const u32x4*)(ap[i] + k0 + 64); rb[i] = *(const u32x4*)(bp[i] + k0 + 64); }
      }
#pragma unroll
      for (int kk = 0; kk < 64; kk += 32) {
        bf16x8 af[4], bfr[4];
#pragma unroll
        for (int i = 0; i < 4; ++i) af[i] = ldfrag(As, 72, wm + i * 16, kk, lane);
#pragma unroll
        for (int j = 0; j < 4; ++j) bfr[j] = ldfrag(Bs, 72, wn + j * 16, kk, lane);
#pragma unroll
        for (int i = 0; i < 4; ++i)
#pragma unroll
          for (int j = 0; j < 4; ++j) acc[i][j] = mma(af[i], bfr[j], acc[i][j]);
      }
    }
#pragma unroll
    for (int i = 0; i < 4; ++i)
#pragma unroll
      for (int j = 0; j < 4; ++j) {
        int m = m0 + wm + i * 16 + (lane & 15);
        int n = n0 + wn + j * 16 + (lane >> 4) * 4;
        if (m < M && n < N) epi(m, n, acc[i][j]);
      }
  }
}

struct EpiStore { static constexpr bool PERM = true; u16* C; int ldc;
  __device__ void store8(int m, int n, f32x4 a, f32x4 b) const { u32x4 o = {pack2(a[0], a[1]), pack2(a[2], a[3]), pack2(b[0], b[1]), pack2(b[2], b[3])}; *(u32x4*)(C + (size_t)m * ldc + n) = o; }
  __device__ void operator()(int m, int n, f32x4 v) const { *(uint2*)(C + (size_t)m * ldc + n) = pack4(v[0], v[1], v[2], v[3]); } };
struct EpiE { static constexpr bool PERM = false; u16* C; const float* w0;
  __device__ void operator()(int m, int n, f32x4 v) const {
    float4 w = *(const float4*)(w0 + n);
    *(uint2*)(C + (size_t)m * 512 + n) = pack4(sigmoidf_(w.x + v[0]) * 0.6065306597126334f, sigmoidf_(w.y + v[1]) * 0.6065306597126334f,
                                              sigmoidf_(w.z + v[2]) * 0.6065306597126334f, sigmoidf_(w.w + v[3]) * 0.6065306597126334f); } };
struct EpiI { static constexpr bool PERM = false; u16* C; const float* a0;
  __device__ void operator()(int m, int n, f32x4 v) const {
    float4 w = *(const float4*)(a0 + n);
    *(uint2*)(C + (size_t)m * 512 + n) = pack4(sigmoidf_(w.x + v[0]), sigmoidf_(w.y + v[1]), sigmoidf_(w.z + v[2]), sigmoidf_(w.w + v[3])); } };
struct EpiRes { static constexpr bool PERM = false; const float* src_c; const float* src_l; float* dst_c; float* dst_l; const float* modv_l; int gi; int moff;
  __device__ void operator()(int m_, int n, f32x4 v) const {
    int m = m_ + moff;
    const float* g = modv_l + (mod_row(m) * 6 + gi) * 1024 + n;
    float4 gg = *(const float4*)g;
    const float* s; float* d;
    if (m < NCTX) { s = src_c + (size_t)m * 1024 + n; d = dst_c + (size_t)m * 1024 + n; }
    else { s = src_l + (size_t)(m - NCTX) * 1024 + n; d = dst_l + (size_t)(m - NCTX) * 1024 + n; }
    float4 x = *(const float4*)s;
    x.x += gg.x * v[0]; x.y += gg.y * v[1]; x.z += gg.z * v[2]; x.w += gg.w * v[3];
    *(float4*)d = x; } };
struct EpiQKV { static constexpr bool PERM = true; u16* C;
  __device__ void store8(int m, int n, f32x4 a, f32x4 b) const {
    float sc_ = (n >= 1024 && n < 2048) ? 0.08838834764831845f : 1.f;
    u32x4 o = {pack2(a[0] * sc_, a[1] * sc_), pack2(a[2] * sc_, a[3] * sc_), pack2(b[0] * sc_, b[1] * sc_), pack2(b[2] * sc_, b[3] * sc_)};
    *(u32x4*)(C + (size_t)m * 4096 + n) = o; }
  __device__ void operator()(int m, int n, f32x4 v) const {
    float s = (n >= 1024 && n < 2048) ? 0.08838834764831845f : 1.f;
    *(uint2*)(C + (size_t)m * 4096 + n) = pack4(v[0] * s, v[1] * s, v[2] * s, v[3] * s); } };
struct EpiGate { static constexpr bool PERM = true; u16* Y; const float* rstd;
  __device__ void store8(int m, int n, f32x4 a, f32x4 b) const {
    u16* yp = Y + (size_t)m * 2048 + n;
    u32x4 yy = *(const u32x4*)yp;
    float r = rstd[m * 8 + (n >> 8)];
    float g[8] = {a[0], a[1], a[2], a[3], b[0], b[1], b[2], b[3]};
    float o[8];
#pragma unroll
    for (int i = 0; i < 4; ++i) {
      o[2 * i] = siluf_(g[2 * i]) * bf2f((u16)(yy[i] & 0xffff)) * r;
      o[2 * i + 1] = siluf_(g[2 * i + 1]) * bf2f((u16)(yy[i] >> 16)) * r;
    }
    u32x4 ov = {pack2(o[0], o[1]), pack2(o[2], o[3]), pack2(o[4], o[5]), pack2(o[6], o[7])};
    *(u32x4*)yp = ov; }
  __device__ void operator()(int m, int n, f32x4 v) const {
    u16* yp = Y + (size_t)m * 2048 + n;
    uint2 yy = *(const uint2*)yp;
    float r = rstd[m * 8 + (n >> 8)];
    float y0 = bf2f((u16)(yy.x & 0xffff)), y1 = bf2f((u16)(yy.x >> 16)), y2 = bf2f((u16)(yy.y & 0xffff)), y3 = bf2f((u16)(yy.y >> 16));
    *(uint2*)yp = pack4(siluf_(v[0]) * y0 * r, siluf_(v[1]) * y1 * r, siluf_(v[2]) * y2 * r, siluf_(v[3]) * y3 * r); } };

__device__ __forceinline__ void transpose_job(const float* __restrict__ src, u16* __restrict__ dst, int K, int N, char* smem) {
  const int TT = opaque_tid();
  float* tile = (float*)smem;
  const int tid = LTID;
  const int tk = K >> 6, tn = (N + 63) >> 6;
  const int ntiles = tk * tn;
  for (int vb = VBID; vb < ntiles; vb += VGRID) {
    const int k0 = (vb / tn) * 64, n0 = (vb % tn) * 64;
    __syncthreads();
#pragma unroll
    for (int i = 0; i < 4; ++i) {
      int r = (tid >> 4) + i * 16, c4 = (tid & 15) * 4;
      float4 v = make_float4(0.f, 0.f, 0.f, 0.f);
      if (n0 + c4 < N) v = *(const float4*)(src + (size_t)(k0 + r) * N + n0 + c4);
      tile[r * 65 + c4] = v.x; tile[r * 65 + c4 + 1] = v.y; tile[r * 65 + c4 + 2] = v.z; tile[r * 65 + c4 + 3] = v.w;
    }
    __syncthreads();
#pragma unroll
    for (int i = 0; i < 2; ++i) {
      int item = tid + i * 256; int kc = item & 7, n = item >> 3;
      if (n0 + n < N) {
        float v[8];
#pragma unroll
        for (int j = 0; j < 8; ++j) v[j] = tile[(kc * 8 + j) * 65 + n];
        u32x4 o = {pack2(v[0], v[1]), pack2(v[2], v[3]), pack2(v[4], v[5]), pack2(v[6], v[7])};
        *(u32x4*)(dst + (size_t)(n0 + n) * K + k0 + kc * 8) = o;
      }
    }
  }
}

__device__ __forceinline__ void phase_prep(const Params& p, char* smem) {
  const int TT = opaque_tid();
  u16* W = (u16*)p.ws;
  transpose_job(p.in[I_EVIN], W + W_EVIN, 1024, 3472, smem);
  transpose_job(p.in[I_W2F], W + W_W2F, 64, 512, smem);
  transpose_job(p.in[I_W2B], W + W_W2B, 64, 512, smem);
  transpose_job(p.in[I_A2F], W + W_A2F, 64, 512, smem);
  transpose_job(p.in[I_A2B], W + W_A2B, 64, 512, smem);
  transpose_job(p.in[I_G2], W + W_G2, 128, 512, smem);
  {
    float* rope = (float*)(p.ws + O_ROPE);
    for (int idx = VBID * 256 + LTID; idx < (128 + 64) * 32; idx += VGRID * 256) {
      int j = idx & 31, pos = idx >> 5;
      bool isrow = pos < 128;
      int pp = isrow ? pos : pos - 128;
      float inv = powf(10000.f, -(float)j / 32.f);
      float ang = (float)pp * inv;
      double a = (double)ang;
      double kq = rint(a * 0.15915494309189535);
      double r = a - kq * 6.283185307179586476925;
      double r2 = r * r;
      double sn = r, cs = 1.0, ts = r, tc = 1.0;
#pragma unroll 1
      for (int it = 1; it <= 14; ++it) {
        tc = -tc * r2 / (double)((2 * it - 1) * (2 * it));
        ts = -ts * r2 / (double)((2 * it) * (2 * it + 1));
        cs += tc; sn += ts;
      }
      if (isrow) { rope[pp * 32 + j] = (float)cs; rope[4096 + pp * 32 + j] = (float)sn; }
      else { rope[8192 + pp * 32 + j] = (float)cs; rope[8192 + 2048 + pp * 32 + j] = (float)sn; }
    }
  }
  {
    float* sc = (float*)smem;
    float* red = sc + 9 * 1024;
    float* modv = (float*)(p.ws + O_MODV);
    bool loaded = false;
    __syncthreads();
    for (int vb = VBID; vb < 384; vb += VGRID) {
      if (!loaded) {
        for (int i = LTID; i < 9 * 1024; i += 256) {
          int r = i >> 10, k = i & 1023;
          float cv = r < 8 ? p.in[I_C][r * 1024 + k] : p.in[I_CCTX][k];
          sc[i] = cv / (1.f + expf(-cv));
        }
        loaded = true;
        __syncthreads();
      }
      int l = vb / 192, jb = vb % 192;
      int jj = LTID & 31, kc = LTID >> 5;
      int j = jb * 32 + jj;
      const float* w = p.in[I_MODW] + ((size_t)l * 1024 + kc * 128) * 6144 + j;
      float acc[9];
#pragma unroll
      for (int r = 0; r < 9; ++r) acc[r] = 0.f;
#pragma unroll 16
      for (int k = 0; k < 128; ++k) {
        float wv = w[(size_t)k * 6144];
#pragma unroll
        for (int r = 0; r < 9; ++r) acc[r] += sc[r * 1024 + kc * 128 + k] * wv;
      }
      __syncthreads();
#pragma unroll
      for (int r = 0; r < 9; ++r) red[(kc * 9 + r) * 32 + jj] = acc[r];
      __syncthreads();
      if (kc == 0) {
        float mb = p.in[I_MODB][l * 6144 + j];
#pragma unroll
        for (int r = 0; r < 9; ++r) {
          float sum = 0.f;
#pragma unroll
          for (int q = 0; q < 8; ++q) sum += red[(q * 9 + r) * 32 + jj];
          modv[((size_t)l * 9 + r) * 6144 + j] = sum + mb;
        }
      }
    }
    __syncthreads();
  }
}

__device__ __forceinline__ void phase_norm(const float* src_c, const float* src_l, const float* g, const float* modv_l, int si, int sci,
                           u16* hx, int r0, int r1) {
  const int TT = opaque_tid();
  const int lane = LTID & 63, wv = LTID >> 6;
  for (int m = r0 + (VBID * 4 + wv) * 2; m < r1; m += VGRID * 8) {
    float4 v[2][4];
    float ss[2] = {0.f, 0.f};
#pragma unroll
    for (int q = 0; q < 2; ++q) {
      const int mm = m + q;
      const float* src = mm < NCTX ? src_c + (size_t)mm * 1024 : src_l + (size_t)(mm - NCTX) * 1024;
#pragma unroll
      for (int i = 0; i < 4; ++i) v[q][i] = *(const float4*)(src + i * 256 + lane * 4);
    }
#pragma unroll
    for (int q = 0; q < 2; ++q) {
#pragma unroll
      for (int i = 0; i < 4; ++i) ss[q] += v[q][i].x * v[q][i].x + v[q][i].y * v[q][i].y + v[q][i].z * v[q][i].z + v[q][i].w * v[q][i].w;
      ss[q] = wave_sum(ss[q]);
    }
#pragma unroll
    for (int q = 0; q < 2; ++q) {
      const int mm = m + q;
      const int r = mod_row(mm);
      const float* sh = modv_l + (r * 6 + si) * 1024;
      const float* scl = modv_l + (r * 6 + sci) * 1024;
      const float rstd = rsqrtf(ss[q] * (1.f / 1024.f) + 1e-6f);
#pragma unroll
      for (int i = 0; i < 4; ++i) {
        int c = i * 256 + lane * 4;
        float4 gg = *(const float4*)(g + c), s1 = *(const float4*)(scl + c), s0 = *(const float4*)(sh + c);
        float y0 = v[q][i].x * rstd * gg.x * (1.f + s1.x) + s0.x;
        float y1 = v[q][i].y * rstd * gg.y * (1.f + s1.y) + s0.y;
        float y2 = v[q][i].z * rstd * gg.z * (1.f + s1.z) + s0.z;
        float y3 = v[q][i].w * rstd * gg.w * (1.f + s1.w) + s0.w;
        *(uint2*)(hx + (size_t)mm * 1024 + c) = pack4(y0, y1, y2, y3);
      }
    }
  }
}

__device__ __forceinline__ float red8(float v) {
  v += dppf<0xB1>(v);
  v += dppf<0x4E>(v);
  v += dppf<0x141>(v);
  return v;
}
__device__ __forceinline__ void unpack8(u32x4 q, float* o) {
#pragma unroll
  for (int e = 0; e < 4; ++e) { o[2 * e] = bf2f((u16)(q[e] & 0xffff)); o[2 * e + 1] = bf2f((u16)(q[e] >> 16)); }
}
__device__ __forceinline__ u32x4 pack8(const float* o) {
  u32x4 r = {pack2(o[0], o[1]), pack2(o[2], o[3]), pack2(o[4], o[5]), pack2(o[6], o[7])};
  return r;
}
__device__ __forceinline__ void load8f(const float* p, float* o) {
  float4 a = *(const float4*)p, b = *(const float4*)(p + 4);
  o[0] = a.x; o[1] = a.y; o[2] = a.z; o[3] = a.w; o[4] = b.x; o[5] = b.y; o[6] = b.z; o[7] = b.w;
}
__device__ __forceinline__ void shifted8(const u16* row, int col, bool hp, bool hn, const float* mup, const float* mun, float* o) {
  const u32x4 z4 = {0u, 0u, 0u, 0u};
  u32x4 cur = *(const u32x4*)(row + col);
  u32x4 prv = *(const u32x4*)(row + col - (hp ? PW : 0));
  u32x4 nxt = *(const u32x4*)(row + col + (hn ? PW : 0));
  prv = hp ? prv : z4; nxt = hn ? nxt : z4;
  float u[8], pv[8], nx[8], mp[8], mn[8];
  unpack8(cur, u); unpack8(prv, pv); unpack8(nxt, nx);
  load8f(mup + col, mp); load8f(mun + col, mn);
#pragma unroll
  for (int i = 0; i < 8; ++i) o[i] = u[i] + mp[i] * (pv[i] - u[i]) + mn[i] * (nx[i] - u[i]);
}
__device__ __forceinline__ void phase_feat(const Params& p) {
  const int TT = opaque_tid();
  const u16* __restrict__ P = (const u16*)(p.ws + O_P);
  u16* __restrict__ Sr = (u16*)(p.ws + O_SR); u16* __restrict__ Sk = (u16*)(p.ws + O_SK); u16* __restrict__ Sv = (u16*)(p.ws + O_SV);
  float* __restrict__ rn = (float*)(p.ws + O_RN); float* __restrict__ bonus = (float*)(p.ws + O_BONUS);
  u16* __restrict__ L = (u16*)((char*)p.out + DO_L);
  const float* __restrict__ mup = p.in[I_MUP]; const float* __restrict__ mun = p.in[I_MUN];
  const int lane = LTID & 63, wv = LTID >> 6;
  const int h = lane >> 3, c = h * 64 + (lane & 7) * 8;
  float kkw[8], rkw[8];
  load8f(p.in[I_KK] + c, kkw); load8f(p.in[I_RK] + c, rkw);
#pragma unroll 2
  for (int m = VBID * 4 + wv; m < NTOK; m += VGRID * 4) {
    const bool hp = has_prev(m), hn = has_next(m);
    const u16* row = P + (size_t)m * PW;
    float r[8], k[8], v[8];
    shifted8(row, c, hp, hn, mup, mun, r);
    shifted8(row, 512 + c, hp, hn, mup, mun, k);
    shifted8(row, 1024 + c, hp, hn, mup, mun, v);
    *(u32x4*)(Sr + (size_t)m * 512 + c) = pack8(r);
    *(u32x4*)(Sk + (size_t)m * 512 + c) = pack8(k);
    *(u32x4*)(Sv + (size_t)m * 512 + c) = pack8(v);
    float s1 = 0.f, s2 = 0.f;
#pragma unroll
    for (int i = 0; i < 8; ++i) { float kk = k[i] * kkw[i]; s1 += kk * kk; s2 += r[i] * k[i] * rkw[i]; }
    s1 = red8(s1); s2 = red8(s2);
    if ((lane & 7) == 0) {
      rn[m * 8 + h] = 1.f / fmaxf(sqrtf(s1), 1e-12f);
      bonus[m * 8 + h] = s2;
    }
    if (lane < 48) {
      float o[8];
      shifted8(row, 1536 + lane * 8, hp, hn, mup, mun, o);
      const int g = lane >> 3;
#pragma unroll
      for (int i = 0; i < 8; ++i) o[i] = g < 2 ? tanhf_(o[i]) : (g < 4 ? o[i] : sigmoidf_(o[i]));
      *(u32x4*)(L + (size_t)m * 384 + lane * 8) = pack8(o);
    }
  }
}

__device__ __forceinline__ void transpose_item(const float* __restrict__ src, u16* __restrict__ dst, int K, int N, int idx) {
  const int n = idx % N, kb = idx / N;
  const float* sp = src + (size_t)kb * 8 * N + n;
  float v[8];
#pragma unroll
  for (int i = 0; i < 8; ++i) v[i] = sp[(size_t)i * N];
  u32x4 o = {pack2(v[0], v[1]), pack2(v[2], v[3]), pack2(v[4], v[5]), pack2(v[6], v[7])};
  *(u32x4*)(dst + (size_t)n * K + kb * 8) = o;
}
#define LATE_ITEMS 3342336
__device__ __forceinline__ void late_weight_item(const Params& p, int idx) {
  u16* W = (u16*)p.ws;
  if (idx < 131072) { transpose_item(p.in[I_EVOUT], W + W_EVOUT, 1024, 1024, idx); return; }
  idx -= 131072;
  if (idx < 720896) { transpose_item(p.in[I_FUP], W + W_UP0, 1024, 5632, idx); return; }
  idx -= 720896;
  if (idx < 720896) { transpose_item(p.in[I_FUP] + 1024ull * 5632, W + W_UP1, 1024, 5632, idx); return; }
  idx -= 720896;
  if (idx < 360448) { transpose_item(p.in[I_FDN], W + W_DN0, 2816, 1024, idx); return; }
  idx -= 360448;
  if (idx < 360448) { transpose_item(p.in[I_FDN] + 2816ull * 1024, W + W_DN1, 2816, 1024, idx); return; }
  idx -= 360448;
  if (idx < 786432) { transpose_item(p.in[I_RIN], W + W_RIN, 1024, 6144, idx); return; }
  idx -= 786432;
  if (idx < 262144) { transpose_item(p.in[I_ROUT], W + W_ROUT, 2048, 1024, idx); return; }
}

using f32x2 = __attribute__((ext_vector_type(2))) float;
__device__ __forceinline__ void phase_rwkv(const Params& p, char* smem) {
  const u16* Sr = (const u16*)(p.ws + O_SR); const u16* Sk = (const u16*)(p.ws + O_SK); const u16* Sv = (const u16*)(p.ws + O_SV);
  const float* rn = (const float*)(p.ws + O_RN);
  u16* P = (u16*)(p.ws + O_P);
  constexpr int CH = 32;
  constexpr int NCH = 8448 / CH;
  float* buf = (float*)smem;
  float* vbuf = buf + 2 * 5 * CH * 64;
  const int tid = opaque_tid(), lane = tid & 63, wave = tid >> 6;
  const bool producer = tid >= 256;
  const int pt = tid & 255;
  const int ch = pt & 63, st0 = pt >> 6;
  const int rg = lane >> 4, ls = lane & 15;
  const int r0 = (wave & 3) * 8 + rg * 2;
  for (int vb = blockIdx.x; vb < 256; vb += gridDim.x) {
    const int seq = (vb & 7) * 16 + (vb >> 4), hh = (vb >> 3) & 1;
    const int dir = seq >> 6, b = (seq >> 3) & 7, h = seq & 7;
    const u16* Se = (const u16*)(p.ws + (dir ? O_SEB : O_SEF));
    const u16* Si = (const u16*)(p.ws + (dir ? O_SIB : O_SIF));
    const float kkc = p.in[I_KK][h * 64 + ch], kac = p.in[I_KA][h * 64 + ch];
    f32x2 s00 = {0.f, 0.f}, s01 = {0.f, 0.f}, s10 = {0.f, 0.f}, s11 = {0.f, 0.f};
    u16 gr[CH / 4], gk[CH / 4], ge[CH / 4], gi[CH / 4]; float grn[CH / 4]; u16 gv[CH / 8];
    auto gload = [&](int c) {
#pragma unroll
      for (int i = 0; i < CH / 4; ++i) {
        int m = scan_tok(dir, b, c * CH + st0 + i * 4);
        size_t o = (size_t)m * 512 + h * 64 + ch;
        gr[i] = Sr[o]; gk[i] = Sk[o]; ge[i] = Se[o]; gi[i] = Si[o]; grn[i] = rn[m * 8 + h];
      }
#pragma unroll
      for (int i = 0; i < CH / 8; ++i) {
        int item = pt + i * 256;
        int mv = scan_tok(dir, b, c * CH + (item >> 5));
        gv[i] = Sv[(size_t)mv * 512 + h * 64 + hh * 32 + (item & 31)];
      }
    };
    auto sstore = [&](int bi) {
      float* B = buf + bi * (5 * CH * 64);
#pragma unroll
      for (int i = 0; i < CH / 4; ++i) {
        int st = st0 + i * 4;
        float r = bf2f(gr[i]), k = bf2f(gk[i]), e = bf2f(ge[i]), ic = bf2f(gi[i]);
        float kk = k * kkc * grn[i];
        B[(0 * CH + st) * 64 + ch] = -kk;
        B[(1 * CH + st) * 64 + ch] = kk * ic;
        B[(2 * CH + st) * 64 + ch] = k * (1.f + (ic - 1.f) * kac);
        B[(3 * CH + st) * 64 + ch] = __expf(-e);
        B[(4 * CH + st) * 64 + ch] = r;
      }
#pragma unroll
      for (int i = 0; i < CH / 8; ++i) vbuf[bi * (CH * 32) + pt + i * 256] = bf2f(gv[i]);
    };
    __syncthreads();
    if (producer) { gload(0); sstore(0); gload(1); }
    __syncthreads();
    for (int c = 0; c < NCH; ++c) {
      if (producer) {
        if (c + 1 < NCH) { sstore((c + 1) & 1); if (c + 2 < NCH) gload(c + 2); }
        {
          const int li = c * ((int)gridDim.x * 256) + blockIdx.x * 256 + pt;
          if (li < LATE_ITEMS && vb == (int)blockIdx.x) late_weight_item(p, li);
        }
      } else {
        const float* B = buf + (c & 1) * (5 * CH * 64);
        const float* VB = vbuf + (c & 1) * (CH * 32);
        f32x2 ykeep = {0.f, 0.f}, ykeep2 = {0.f, 0.f};
#pragma unroll
        for (int st = 0; st < CH; ++st) {
          f32x4 a = *(const f32x4*)(B + (0 * CH + st) * 64 + ls * 4);
          f32x4 bb = *(const f32x4*)(B + (1 * CH + st) * 64 + ls * 4);
          f32x4 kd = *(const f32x4*)(B + (2 * CH + st) * 64 + ls * 4);
          f32x4 w = *(const f32x4*)(B + (3 * CH + st) * 64 + ls * 4);
          f32x4 r = *(const f32x4*)(B + (4 * CH + st) * 64 + ls * 4);
          f32x2 vv = *(const f32x2*)(VB + st * 32 + r0);
          f32x2 alo = {a[0], a[1]}, ahi = {a[2], a[3]}, blo = {bb[0], bb[1]}, bhi = {bb[2], bb[3]};
          f32x2 klo = {kd[0], kd[1]}, khi = {kd[2], kd[3]}, wlo = {w[0], w[1]}, whi = {w[2], w[3]};
          f32x2 rlo = {r[0], r[1]}, rhi = {r[2], r[3]};
          f32x2 t0 = s00 * alo + s01 * ahi;
          f32x2 t1 = s10 * alo + s11 * ahi;
          float sa0 = red16(t0[0] + t0[1]);
          float sa1 = red16(t1[0] + t1[1]);
          f32x2 sa0v = {sa0, sa0}, sa1v = {sa1, sa1}, v0v = {vv[0], vv[0]}, v1v = {vv[1], vv[1]};
          s00 = s00 * wlo + sa0v * blo + v0v * klo;
          s01 = s01 * whi + sa0v * bhi + v0v * khi;
          s10 = s10 * wlo + sa1v * blo + v1v * klo;
          s11 = s11 * whi + sa1v * bhi + v1v * khi;
          f32x2 u0 = s00 * rlo + s01 * rhi;
          f32x2 u1 = s10 * rlo + s11 * rhi;
          float y0 = red16(u0[0] + u0[1]);
          float y1 = red16(u1[0] + u1[1]);
          if (st < 16) { ykeep[0] = (ls == st) ? y0 : ykeep[0]; ykeep[1] = (ls == st) ? y1 : ykeep[1]; }
          else { ykeep2[0] = (ls == st - 16) ? y0 : ykeep2[0]; ykeep2[1] = (ls == st - 16) ? y1 : ykeep2[1]; }
        }
#pragma unroll
        for (int half_ = 0; half_ < 2; ++half_) {
          const int sidx = c * CH + half_ * 16 + ls;
          const int tt = sidx - 256;
          const int mctx = b * 256 + (dir ? 255 - sidx : sidx);
          const int mlat = NCTX + b * 8192 + (dir ? 8191 - tt : tt);
          const int m = sidx < 256 ? mctx : mlat;
          const f32x2 yk = half_ ? ykeep2 : ykeep;
          *(unsigned*)(P + (size_t)m * PW + dir * 512 + h * 64 + hh * 32 + r0) = pack2(yk[0], yk[1]);
        }
      }
      __syncthreads();
    }
  }
}

__device__ __forceinline__ float xbc_conv(const u16* P, int m, int cx, const float* cw, const float* cb, bool hp, bool hn) {
  const u16* q = P + (size_t)m * PW + 2432 + cx;
  float v = cb[cx] + cw[1024 + cx] * bf2f(q[0]);
  if (hp) v += cw[cx] * bf2f(q[-PW]);
  if (hn) v += cw[2048 + cx] * bf2f(q[PW]);
  return siluf_(v);
}

#define XLO(w) bf2f((u16)((w) & 0xffff))
#define XHI(w) bf2f((u16)((w) >> 16))
__device__ __forceinline__ void phase_xbc(const Params& p) {
  const int TT = opaque_tid();
  const u16* __restrict__ P = (const u16*)(p.ws + O_P);
  u16* __restrict__ X = (u16*)((char*)p.out + DO_HX);
  const float* __restrict__ cw = p.in[I_SCW]; const float* __restrict__ cb = p.in[I_SCB];
  const int total = NTOK * 128;
#pragma unroll 2
  for (int idx = VBID * 256 + LTID; idx < total; idx += VGRID * 256) {
    const int m = idx >> 7, c = (idx & 127) * 8;
    const u16* q = P + (size_t)m * PW + 2432 + c;
    const u32x4 z4 = {0u, 0u, 0u, 0u};
    const bool hp = has_prev(m), hn = has_next(m);
    u32x4 cur = *(const u32x4*)q;
    u32x4 prv = *(const u32x4*)(q - (hp ? PW : 0));
    u32x4 nxt = *(const u32x4*)(q + (hn ? PW : 0));
    prv = hp ? prv : z4; nxt = hn ? nxt : z4;
    float o[8];
#pragma unroll
    for (int e = 0; e < 4; ++e) {
      int c0 = c + 2 * e, c1 = c0 + 1;
      float v0 = cb[c0] + cw[c0] * XLO(prv[e]) + cw[1024 + c0] * XLO(cur[e]) + cw[2048 + c0] * XLO(nxt[e]);
      float v1 = cb[c1] + cw[c1] * XHI(prv[e]) + cw[1024 + c1] * XHI(cur[e]) + cw[2048 + c1] * XHI(nxt[e]);
      o[2 * e] = siluf_(v0); o[2 * e + 1] = siluf_(v1);
    }
    u32x4 ov = {pack2(o[0], o[1]), pack2(o[2], o[3]), pack2(o[4], o[5]), pack2(o[6], o[7])};
    *(u32x4*)(X + (size_t)m * 1024 + c) = ov;
  }
}

__device__ __forceinline__ void phase_ssd_prep(const Params& p) {
  const int TT = opaque_tid();
  const u16* __restrict__ P = (const u16*)(p.ws + O_P);
  float* __restrict__ dtb = (float*)(p.ws + O_DT); float* __restrict__ csb = (float*)(p.ws + O_CS);
  for (int idx = VBID * 256 + LTID; idx < 528 * 16; idx += VGRID * 256) {
    int cidx = idx >> 4, dir = (idx >> 3) & 1, h = idx & 7;
    float bias = dir ? p.in[I_DTBB][h] : p.in[I_DTBF][h];
    float A = -expf(dir ? p.in[I_ALB][h] : p.in[I_ALF][h]);
    float cs = 0.f;
#pragma unroll 16
    for (int i = 0; i < 128; ++i) {
      int l = dir ? 127 - i : i;
      int m = cidx * 128 + l;
      float dtr = bf2f(P[(size_t)m * PW + 3456 + dir * 8 + h]);
      float dt = softplusf_(dtr + bias);
      cs += dt * A;
      dtb[((size_t)dir * NTOK + m) * 8 + h] = dt;
      csb[((size_t)dir * NTOK + m) * 8 + h] = cs;
    }
  }
}

__device__ __forceinline__ void phase_ssd_states(const Params& p, char* smem) {
  const int TT = opaque_tid();
  const u16* P = (const u16*)(p.ws + O_P);
  const float* dtb = (const float*)(p.ws + O_DT); const float* csb = (const float*)(p.ws + O_CS);
  float* states = (float*)(p.ws + O_STATES);
  const float* cw = p.in[I_SCW]; const float* cb = p.in[I_SCB];
  const u16* X = (const u16*)((const char*)p.out + DO_HX);
  u16* XTf = (u16*)smem; u16* XTb = XTf + 64 * 136; u16* BT = XTb + 64 * 136;
  float* wf = (float*)(BT + 128 * 136);
  const int tid = LTID, lane = tid & 63, wave = tid >> 6;
  for (int vb = VBID; vb < 528 * 8; vb += VGRID) {
    const int cidx = vb >> 3, h = vb & 7, g = h >> 2;
    const int mb = cidx * 128;
    __syncthreads();
    {
      int d = tid >> 7, l = tid & 127;
      float tot = csb[((size_t)d * NTOK + mb + (d ? 0 : 127)) * 8 + h];
      size_t o = ((size_t)d * NTOK + mb + l) * 8 + h;
      wf[d * 128 + l] = dtb[o] * __expf(tot - csb[o]);
    }
    __syncthreads();
#pragma unroll
    for (int i = 0; i < 2; ++i) {
      int item = tid + i * 256; int lp = item & 63, cg = item >> 6;
      int l0 = 2 * lp;
      const u16* xp = X + (size_t)(mb + l0) * 1024 + h * 64 + cg * 8;
      u32x4 x0 = *(const u32x4*)xp, x1 = *(const u32x4*)(xp + 1024);
      float f0 = wf[l0], f1 = wf[l0 + 1], b0 = wf[128 + l0], b1 = wf[128 + l0 + 1];
#pragma unroll
      for (int e = 0; e < 4; ++e) {
        float a0 = XLO(x0[e]), a1 = XLO(x1[e]), c0 = XHI(x0[e]), c1 = XHI(x1[e]);
        *(unsigned*)(XTf + (cg * 8 + 2 * e) * 136 + l0) = pack2(a0 * f0, a1 * f1);
        *(unsigned*)(XTf + (cg * 8 + 2 * e + 1) * 136 + l0) = pack2(c0 * f0, c1 * f1);
        *(unsigned*)(XTb + (cg * 8 + 2 * e) * 136 + l0) = pack2(a0 * b0, a1 * b1);
        *(unsigned*)(XTb + (cg * 8 + 2 * e + 1) * 136 + l0) = pack2(c0 * b0, c1 * b1);
      }
    }
#pragma unroll
    for (int i = 0; i < 4; ++i) {
      int item = tid + i * 256; int lp = item & 63, cg = item >> 6;
      int l0 = 2 * lp;
      const u16* xp = X + (size_t)(mb + l0) * 1024 + 512 + g * 128 + cg * 8;
      u32x4 x0 = *(const u32x4*)xp, x1 = *(const u32x4*)(xp + 1024);
#pragma unroll
      for (int e = 0; e < 4; ++e) {
        *(unsigned*)(BT + (cg * 8 + 2 * e) * 136 + l0) = (x0[e] & 0xffffu) | (x1[e] << 16);
        *(unsigned*)(BT + (cg * 8 + 2 * e + 1) * 136 + l0) = (x0[e] >> 16) | (x1[e] & 0xffff0000u);
      }
    }
    __syncthreads();
#pragma unroll
    for (int d = 0; d < 2; ++d) {
      const u16* XT = d ? XTb : XTf;
      f32x4 acc[4][2];
#pragma unroll
      for (int i = 0; i < 4; ++i) { acc[i][0] = (f32x4){0, 0, 0, 0}; acc[i][1] = (f32x4){0, 0, 0, 0}; }
#pragma unroll
      for (int kk = 0; kk < 128; kk += 32) {
        bf16x8 af[4], bfr[2];
#pragma unroll
        for (int i = 0; i < 4; ++i) af[i] = ldfrag(XT, 136, i * 16, kk, lane);
#pragma unroll
        for (int j = 0; j < 2; ++j) bfr[j] = ldfrag(BT, 136, wave * 32 + j * 16, kk, lane);
#pragma unroll
        for (int i = 0; i < 4; ++i)
#pragma unroll
          for (int j = 0; j < 2; ++j) acc[i][j] = mma(af[i], bfr[j], acc[i][j]);
      }
      float* so = states + (((size_t)d * 528 + cidx) * 8 + h) * 8192;
#pragma unroll
      for (int i = 0; i < 4; ++i)
#pragma unroll
        for (int j = 0; j < 2; ++j) {
          int pp = i * 16 + (lane & 15), n = wave * 32 + j * 16 + (lane >> 4) * 4;
          *(float4*)(so + pp * 128 + n) = make_float4(acc[i][j][0], acc[i][j][1], acc[i][j][2], acc[i][j][3]);
        }
    }
  }
}

__device__ __forceinline__ int ssd_chunk_seq(int d, int b, int j) {
  if (j < 2) return 2 * b + (d ? 1 - j : j);
  int t = j - 2;
  return 16 + b * 64 + (d ? 63 - t : t);
}

__device__ __forceinline__ void phase_ssd_scan(const Params& p) {
  const int TT = opaque_tid();
  float* states = (float*)(p.ws + O_STATES);
  const float* csb = (const float*)(p.ws + O_CS);
  for (int idx = VBID * 256 + LTID; idx < 2 * 8 * 8 * 2048; idx += VGRID * 256) {
    const int q = idx & 2047, h = (idx >> 11) & 7, b = (idx >> 14) & 7, d = idx >> 17;
    auto sptr = [&](int j) -> f32x4* {
      int cidx = ssd_chunk_seq(d, b, j);
      return (f32x4*)(states + (((size_t)d * 528 + cidx) * 8 + h) * 8192) + q;
    };
    auto totof = [&](int j) -> float {
      int cidx = ssd_chunk_seq(d, b, j);
      return csb[((size_t)d * NTOK + cidx * 128 + (d ? 0 : 127)) * 8 + h];
    };
    f32x4 hh = {0.f, 0.f, 0.f, 0.f};
    f32x4 sv[4]; float tv[4];
#pragma unroll
    for (int u = 0; u < 4; ++u) { sv[u] = *sptr(u); tv[u] = totof(u); }
#pragma unroll 1
    for (int j0 = 0; j0 < 64; j0 += 4) {
      f32x4 sn[4]; float tn[4];
#pragma unroll
      for (int u = 0; u < 4; ++u) {
        const int jn = j0 + 4 + u;
        const int jc = jn < 66 ? jn : 65;
        sn[u] = *sptr(jc); tn[u] = totof(jc);
      }
#pragma unroll
      for (int u = 0; u < 4; ++u) {
        *sptr(j0 + u) = hh;
        hh = hh * __expf(tv[u]) + sv[u];
      }
#pragma unroll
      for (int u = 0; u < 4; ++u) { sv[u] = sn[u]; tv[u] = tn[u]; }
    }
#pragma unroll
    for (int u = 0; u < 2; ++u) {
      *sptr(64 + u) = hh;
      hh = hh * __expf(tv[u]) + sv[u];
    }
  }
}

__device__ __forceinline__ void phase_ssd_out(const Params& p, char* smem) {
  const int TT = opaque_tid();
  u16* P = (u16*)(p.ws + O_P);
  const float* dtb = (const float*)(p.ws + O_DT); const float* csb = (const float*)(p.ws + O_CS);
  const float* states = (const float*)(p.ws + O_STATES);
  const float* cw = p.in[I_SCW]; const float* cb = p.in[I_SCB];
  const u16* X = (const u16*)((const char*)p.out + DO_HX);
  u16* Cs = (u16*)smem;
  u16* Bs = Cs + 64 * 136;
  u16* Gs = Bs; u16* Hs = Bs + 64 * 136;
  u16* XT = Bs + 128 * 136;
  float* csf = (float*)(XT + 64 * 136);
  float* csbk = csf + 128; float* dtf = csbk + 128; float* dtbk = dtf + 128;
  const int tid = LTID, lane = tid & 63, wave = tid >> 6;
  const int lv_ = (int)(blockIdx.x >> 3) * 2 + (VBID & 1);
  for (int vq = lv_; vq < 66 * 16; vq += (int)(gridDim.x >> 3) * 2) {
    const int vb = (((int)(blockIdx.x & 7) + 8 * (vq >> 4)) << 4) + (vq & 15);
    const int lh = vb & 1, h = (vb >> 1) & 7, cidx = vb >> 4, g = h >> 2;
    const int mb = cidx * 128;
    f32x4 hv[2][8];
#pragma unroll
    for (int d = 0; d < 2; ++d) {
      const float* hp = states + (((size_t)d * 528 + cidx) * 8 + h) * 8192;
#pragma unroll
      for (int i = 0; i < 8; ++i) { int item = tid + i * 256; hv[d][i] = *(const f32x4*)(hp + (item >> 5) * 128 + (item & 31) * 4); }
    }
    __syncthreads();
    if (tid < 128) {
      size_t o0 = ((size_t)0 * NTOK + mb + tid) * 8 + h, o1 = ((size_t)1 * NTOK + mb + tid) * 8 + h;
      csf[tid] = csb[o0]; csbk[tid] = csb[o1]; dtf[tid] = dtb[o0]; dtbk[tid] = dtb[o1];
    }
#pragma unroll
    for (int i = 0; i < 4; ++i) {
      int item = tid + i * 256; int cg = item & 15, l = item >> 4;
      *(u32x4*)(Cs + l * 136 + cg * 8) = *(const u32x4*)(X + (size_t)(mb + lh * 64 + l) * 1024 + 768 + g * 128 + cg * 8);
    }
#pragma unroll
    for (int i = 0; i < 8; ++i) {
      int item = tid + i * 256; int cg = item & 15, sidx = item >> 4;
      *(u32x4*)(Bs + sidx * 136 + cg * 8) = *(const u32x4*)(X + (size_t)(mb + sidx) * 1024 + 512 + g * 128 + cg * 8);
    }
#pragma unroll
    for (int i = 0; i < 2; ++i) {
      int item = tid + i * 256; int lp = item & 63, cg = item >> 6;
      int l0 = 2 * lp;
      const u16* xp = X + (size_t)(mb + l0) * 1024 + h * 64 + cg * 8;
      u32x4 x0 = *(const u32x4*)xp, x1 = *(const u32x4*)(xp + 1024);
#pragma unroll
      for (int e = 0; e < 4; ++e) {
        *(unsigned*)(XT + (cg * 8 + 2 * e) * 136 + l0) = (x0[e] & 0xffffu) | (x1[e] << 16);
        *(unsigned*)(XT + (cg * 8 + 2 * e + 1) * 136 + l0) = (x0[e] >> 16) | (x1[e] & 0xffff0000u);
      }
    }
    __syncthreads();
    f32x4 cbacc[8];
#pragma unroll
    for (int t = 0; t < 8; ++t) cbacc[t] = (f32x4){0, 0, 0, 0};
#pragma unroll 1
    for (int kk = 0; kk < 128; kk += 32) {
      bf16x8 af = ldfrag(Cs, 136, wave * 16, kk, lane);
#pragma unroll
      for (int t = 0; t < 8; ++t) cbacc[t] = mma(af, ldfrag(Bs, 136, t * 16, kk, lane), cbacc[t]);
    }
    __syncthreads();
    const int lloc = wave * 16 + (lane & 15);
    const int l = lh * 64 + lloc;
    const float cfl = csf[l], cbl = csbk[l];
#pragma unroll 2
    for (int t = 0; t < 8; ++t) {
      float gv[4];
#pragma unroll
      for (int j = 0; j < 4; ++j) {
        int s = t * 16 + (lane >> 4) * 4 + j;
        float f = 0.f;
        if (s <= l) f += __expf(cfl - csf[s]) * dtf[s];
        if (s >= l) f += __expf(cbl - csbk[s]) * dtbk[s];
        gv[j] = cbacc[t][j] * f;
      }
      *(uint2*)(Gs + lloc * 136 + t * 16 + (lane >> 4) * 4) = pack4(gv[0], gv[1], gv[2], gv[3]);
    }
    __syncthreads();
    f32x4 yacc[4];
#pragma unroll
    for (int t = 0; t < 4; ++t) yacc[t] = (f32x4){0, 0, 0, 0};
#pragma unroll 1
    for (int kk = 0; kk < 128; kk += 32) {
      bf16x8 af = ldfrag(Gs, 136, wave * 16, kk, lane);
#pragma unroll
      for (int t = 0; t < 4; ++t) yacc[t] = mma(af, ldfrag(XT, 136, t * 16, kk, lane), yacc[t]);
    }
#pragma unroll
    for (int d = 0; d < 2; ++d) {
      __syncthreads();
#pragma unroll
      for (int i = 0; i < 8; ++i) {
        int item = tid + i * 256;
        int pp = item >> 5, n4 = (item & 31) * 4;
        *(uint2*)(Hs + pp * 136 + n4) = pack4(hv[d][i][0], hv[d][i][1], hv[d][i][2], hv[d][i][3]);
      }
      __syncthreads();
      f32x4 ia[4];
#pragma unroll
      for (int t = 0; t < 4; ++t) ia[t] = (f32x4){0, 0, 0, 0};
#pragma unroll 1
      for (int kk = 0; kk < 128; kk += 32) {
        bf16x8 af = ldfrag(Cs, 136, wave * 16, kk, lane);
#pragma unroll
        for (int t = 0; t < 4; ++t) ia[t] = mma(af, ldfrag(Hs, 136, t * 16, kk, lane), ia[t]);
      }
      float sc = __expf(d ? cbl : cfl);
#pragma unroll
      for (int t = 0; t < 4; ++t)
#pragma unroll
        for (int j = 0; j < 4; ++j) yacc[t][j] += sc * ia[t][j];
    }
    const float Dh = p.in[I_SD][h];
    const int m = mb + l;
#pragma unroll
    for (int t = 0; t < 4; ++t) {
      int p0 = t * 16 + (lane >> 4) * 4;
      float o[4];
#pragma unroll
      for (int j = 0; j < 4; ++j) o[j] = yacc[t][j] + Dh * bf2f(XT[(p0 + j) * 136 + l]);
      *(uint2*)(P + (size_t)m * PW + 1024 + h * 64 + p0) = pack4(o[0], o[1], o[2], o[3]);
    }
  }
}

__device__ __forceinline__ void phase_finish(const Params& p) {
  const int TT = opaque_tid();
  const u16* __restrict__ P = (const u16*)(p.ws + O_P);
  const u16* __restrict__ Sv = (const u16*)(p.ws + O_SV);
  const u16* __restrict__ G = (const u16*)((const char*)p.out + DO_G);
  const float* __restrict__ bonus = (const float*)(p.ws + O_BONUS);
  u16* __restrict__ mixed = (u16*)(p.ws + O_MIXED);
  const int lane = LTID & 63, wv = LTID >> 6;
  const int h = lane >> 3, c = h * 64 + (lane & 7) * 8;
  float lnw[8], lnb[8], nw[8];
  load8f(p.in[I_LNW] + c, lnw); load8f(p.in[I_LNB] + c, lnb); load8f(p.in[I_SNW] + c, nw);
#pragma unroll 2
  for (int m = VBID * 4 + wv; m < NTOK; m += VGRID * 4) {
    const u16* row = P + (size_t)m * PW;
    float yf[8], yb[8], sv[8], gg[8], ys[8], z[8];
    unpack8(*(const u32x4*)(row + c), yf);
    unpack8(*(const u32x4*)(row + 512 + c), yb);
    unpack8(*(const u32x4*)(Sv + (size_t)m * 512 + c), sv);
    unpack8(*(const u32x4*)(G + (size_t)m * 512 + c), gg);
    unpack8(*(const u32x4*)(row + 1024 + c), ys);
    unpack8(*(const u32x4*)(row + 1920 + c), z);
    const float bn = bonus[m * 8 + h];
    float sum = 0.f;
#pragma unroll
    for (int i = 0; i < 8; ++i) { yf[i] += yb[i]; sum += yf[i]; }
    const float mean = red8(sum) * (1.f / 64.f);
    float vs = 0.f;
#pragma unroll
    for (int i = 0; i < 8; ++i) { yf[i] -= mean; vs += yf[i] * yf[i]; }
    const float rs = rsqrtf(red8(vs) * (1.f / 64.f) + 64e-5f);
    float o1[8], t[8]; float ss = 0.f;
#pragma unroll
    for (int i = 0; i < 8; ++i) {
      o1[i] = (yf[i] * rs * lnw[i] + lnb[i] + bn * sv[i]) * gg[i];
      t[i] = ys[i] * siluf_(z[i]);
      ss += t[i] * t[i];
    }
    ss = wave_sum(ss);
    const float rstd = rsqrtf(ss * (1.f / 512.f) + 1e-6f);
#pragma unroll
    for (int i = 0; i < 8; ++i) t[i] = t[i] * rstd * nw[i];
    *(u32x4*)(mixed + (size_t)m * 1024 + c) = pack8(o1);
    *(u32x4*)(mixed + (size_t)m * 1024 + 512 + c) = pack8(t);
  }
}

__device__ __forceinline__ void phase_ffnconv(const Params& p, int layer, int r0) {
  const int TT = opaque_tid();
  u16* GV = (u16*)(p.ws + O_GV);
  const float* cw = p.in[I_FCW] + (size_t)layer * 9 * 2816;
  const float* cb = p.in[I_FCB] + (size_t)layer * 2816;
  const int xcd = blockIdx.x & 7;
  const int lt = (int)(blockIdx.x >> 3) * 512 + TT;
  const int ngrp = (int)((gridDim.x >> 3) * 512) / 44;
  if (lt >= ngrp * 44) return;
  const int j = (xcd * 44 + lt % 44) * 8, tl = lt / 44;
  f32x2 w[9][4], bias[4];
#pragma unroll
  for (int k = 0; k < 9; ++k) {
    float t8[8]; load8f(cw + k * 2816 + j, t8);
#pragma unroll
    for (int e = 0; e < 4; ++e) w[k][e] = (f32x2){t8[2 * e], t8[2 * e + 1]};
  }
  { float t8[8]; load8f(cb + j, t8);
#pragma unroll
    for (int e = 0; e < 4; ++e) bias[e] = (f32x2){t8[2 * e], t8[2 * e + 1]}; }
  const u32x4 z4 = {0u, 0u, 0u, 0u};
#pragma unroll 1
  for (int m = r0 + tl; m < NTOK; m += ngrp) {
    u32x4 g[9];
    const bool isctx = m < NCTX;
    const int t = isctx ? (m & 255) : ((m - NCTX) & 8191);
    const int rr = t >> 6, cc = t & 63;
#pragma unroll
    for (int dy = -1; dy <= 1; ++dy)
#pragma unroll
      for (int dx = -1; dx <= 1; ++dx) {
        const int k = (dy + 1) * 3 + dx + 1;
        const bool valid = isctx ? (dy == 0 && t + dx >= 0 && t + dx < 256)
                                 : (rr + dy >= 0 && rr + dy < 128 && cc + dx >= 0 && cc + dx < 64);
        const int mm = valid ? m + dy * 64 + dx : m;
        u32x4 qv = *(const u32x4*)(GV + (size_t)mm * 5632 + j);
        g[k] = valid ? qv : z4;
      }
    const u32x4 vq = *(const u32x4*)(GV + (size_t)m * 5632 + 2816 + j);
    f32x2 acc[4];
#pragma unroll
    for (int e = 0; e < 4; ++e) acc[e] = bias[e];
#pragma unroll
    for (int k = 0; k < 9; ++k)
#pragma unroll
      for (int e = 0; e < 4; ++e) {
        const unsigned u = g[k][e];
        const f32x2 gv = {__uint_as_float(u << 16), __uint_as_float(u & 0xffff0000u)};
        acc[e] = w[k][e] * gv + acc[e];
      }
    float o[8];
#pragma unroll
    for (int e = 0; e < 4; ++e) {
      const f32x2 x = acc[e];
      const f32x2 uu = (x * x * 0.044715f + 1.0f) * x * 1.5957691216057308f;
      const f32x2 rc = {__builtin_amdgcn_rcpf(__expf(uu[0]) + 1.f), __builtin_amdgcn_rcpf(__expf(uu[1]) + 1.f)};
      const f32x2 gl = x * (1.0f - rc);
      const unsigned u = vq[e];
      o[2 * e] = gl[0] * __uint_as_float(u << 16);
      o[2 * e + 1] = gl[1] * __uint_as_float(u & 0xffff0000u);
    }
    *(u32x4*)(GV + (size_t)m * 5632 + 2816 + j) = pack8(o);
  }
}

__device__ __forceinline__ void phase_rope(const Params& p) {
  const int TT = opaque_tid();
  u16* QKV = (u16*)(p.ws + O_QKV);
  const float* rope = (const float*)(p.ws + O_ROPE);
  const int total = NLAT * 128;
  const int nthr = VGRID * 256;
  for (int idx0 = VBID * 256 + LTID; idx0 < total; idx0 += nthr * 4) {
    u32x4 a[4], bq[4];
#pragma unroll
    for (int u = 0; u < 4; ++u) {
      const int idx = idx0 + u * nthr;
      if (idx >= total) continue;
      const int t = idx >> 7, r = idx & 127;
      const int jg = r & 7, hh = (r >> 3) & 7, qk = r >> 6;
      const u16* base = QKV + (size_t)(NCTX + t) * 4096 + qk * 1024 + hh * 128 + jg * 8;
      a[u] = *(const u32x4*)base; bq[u] = *(const u32x4*)(base + 64);
    }
    asm volatile("" ::: "memory");
#pragma unroll
    for (int u = 0; u < 4; ++u) {
      const int idx = idx0 + u * nthr;
      if (idx >= total) continue;
      const int t = idx >> 7, r = idx & 127;
      const int jg = r & 7, hh = (r >> 3) & 7, qk = r >> 6;
      const int pos = t & 8191, prow = pos >> 6, pcol = pos & 63;
      const int j = jg * 8;
      u16* base = QKV + (size_t)(NCTX + t) * 4096 + qk * 1024 + hh * 128 + j;
      float x1[8], x2[8], o1[8], o2[8];
      unpack8(a[u], x1); unpack8(bq[u], x2);
      const float* ct = j < 32 ? rope + prow * 32 + j : rope + 8192 + pcol * 32 + j - 32;
      const float* stb = j < 32 ? rope + 4096 + prow * 32 + j : rope + 8192 + 2048 + pcol * 32 + j - 32;
      float cs[8], sn[8];
      load8f(ct, cs); load8f(stb, sn);
#pragma unroll
      for (int i = 0; i < 8; ++i) { o1[i] = x1[i] * cs[i] - x2[i] * sn[i]; o2[i] = x2[i] * cs[i] + x1[i] * sn[i]; }
      *(u32x4*)base = pack8(o1);
      *(u32x4*)(base + 64) = pack8(o2);
    }
  }
}

typedef short s16x4 __attribute__((ext_vector_type(4)));
__device__ __forceinline__ bf16x8 ldfrag_tr(const u16* X, int stride, int row0, int k0, int lane) {
  const int li = lane & 15, g = lane >> 4;
  const u16* pp = X + (k0 + g * 8 + (li >> 2)) * stride + row0 + (li & 3) * 4;
  const s16x4 lo = __builtin_amdgcn_ds_read_tr16_b64_v4i16((__attribute__((address_space(3))) s16x4*)pp);
  const s16x4 hi = __builtin_amdgcn_ds_read_tr16_b64_v4i16((__attribute__((address_space(3))) s16x4*)(pp + 4 * stride));
  return (bf16x8){lo[0], lo[1], lo[2], lo[3], hi[0], hi[1], hi[2], hi[3]};
}
__device__ __forceinline__ bf16x8 ldfrag_tr_acc(const u16* X, int stride, int row0, int k0, int lane) {
  const int li = lane & 15, g = lane >> 4;
  const u16* pp = X + (k0 + g * 4 + (li >> 2)) * stride + row0 + (li & 3) * 4;
  const s16x4 lo = __builtin_amdgcn_ds_read_tr16_b64_v4i16((__attribute__((address_space(3))) s16x4*)pp);
  const s16x4 hi = __builtin_amdgcn_ds_read_tr16_b64_v4i16((__attribute__((address_space(3))) s16x4*)(pp + 16 * stride));
  return (bf16x8){lo[0], lo[1], lo[2], lo[3], hi[0], hi[1], hi[2], hi[3]};
}
__device__ __forceinline__ void phase_retention(const Params& p, char* smem) {
  const u16* QKV = (const u16*)(p.ws + O_QKV);
  u16* Y = (u16*)(p.ws + O_Y);
  u16* Qs = (u16*)smem;
  u16* Ks = Qs + 64 * 136;
  u16* Vs = Ks + 64 * 136;
  u16* Vs2 = Vs + 64 * 72;
  u16* Sb = Vs2 + 64 * 72;
  u16* Pm = Sb + 64 * 136;
  const int tid = opaque_tid(), lane = tid & 63, wave = tid >> 6;
  const int quad = lane >> 4, l16 = lane & 15;
  const int rt = wave & 3, chf = wave >> 2;
  for (int vb = blockIdx.x; vb < 256; vb += gridDim.x) {
    const int xq_ = vb >> 3, bh_ = (vb & 7) * 8 + (xq_ >> 2);
    const int b = bh_ >> 3, h = bh_ & 7, sl = xq_ & 3;
#pragma unroll 1
    for (int d = 0; d < 2; ++d) {
      const float l2 = d ? p.in[I_L2B][h] : p.in[I_L2F][h];
      const float lg = log1pf(-exp2f(-l2));
      const float gC = __expf(lg * 64.f);
      f32x4 st[4];
#pragma unroll
      for (int t = 0; t < 4; ++t) st[t] = (f32x4){0, 0, 0, 0};
      u32x4 rqA[2], rkA[2], rvA, rqB[2], rkB[2], rvB;
      auto chunk_m0 = [&](int cs_) { return d ? scan_tok(1, b, cs_ * 64 + 63) : scan_tok(0, b, cs_ * 64); };
      auto gload = [&](int cs_, u32x4 (&rq)[2], u32x4 (&rk)[2], u32x4& rv) {
        int m0 = chunk_m0(cs_);
#pragma unroll
        for (int i = 0; i < 2; ++i) {
          int item = tid + i * 512; int row = item & 63, c8 = (item >> 6) * 8;
          const u16* bp = QKV + (size_t)(m0 + row) * 4096 + h * 128 + c8;
          rq[i] = *(const u32x4*)bp;
          rk[i] = *(const u32x4*)(bp + 1024);
        }
        {
          int row = tid & 63, c8 = (tid >> 6) * 8;
          rv = *(const u32x4*)(QKV + (size_t)(m0 + row) * 4096 + 2048 + h * 256 + sl * 64 + c8);
        }
      };
      auto sstore = [&](const u32x4 (&rq)[2], const u32x4 (&rk)[2], const u32x4& rv) {
#pragma unroll
        for (int i = 0; i < 2; ++i) {
          int item = tid + i * 512; int row = item & 63, c8 = (item >> 6) * 8;
          *(u32x4*)(Qs + row * 136 + c8) = rq[i];
          *(u32x4*)(Ks + row * 136 + c8) = rk[i];
        }
        {
          int row = tid & 63, c8 = (tid >> 6) * 8;
          const float ke = __expf(lg * (float)(d ? row : 63 - row));
          *(u32x4*)(Vs + row * 72 + c8) = rv;
          u32x4 sv_;
#pragma unroll
          for (int e = 0; e < 4; ++e) sv_[e] = pack2(bf2f((u16)(rv[e] & 0xffff)) * ke, bf2f((u16)(rv[e] >> 16)) * ke);
          *(u32x4*)(Vs2 + row * 72 + c8) = sv_;
        }
#pragma unroll
        for (int t = 0; t < 4; ++t)
          *(uint2*)(Sb + (rt * 16 + l16) * 136 + (4 * chf + t) * 16 + quad * 4) = pack4(st[t][0], st[t][1], st[t][2], st[t][3]);
      };
      gload(0, rqA, rkA, rvA);
      gload(1, rqB, rkB, rvB);
      auto body = [&](int cs_, u32x4 (&rq)[2], u32x4 (&rk)[2], u32x4& rv) {
        const int m0 = chunk_m0(cs_);
        __syncthreads();
        sstore(rq, rk, rv);
        __syncthreads();
        u16* const ypb = Y + (size_t)(m0 + rt * 16 + l16 - NCTX) * 2048 + h * 256 + sl * 64 + quad * 4;
        uint2 yprev[2] = {make_uint2(0u, 0u), make_uint2(0u, 0u)};
        if (d && m0 >= NCTX) {
#pragma unroll
          for (int t = 0; t < 2; ++t) yprev[t] = *(const uint2*)(ypb + (2 * chf + t) * 16);
        }
        if (cs_ + 2 < 132) gload(cs_ + 2, rq, rk, rv);
        f32x4 sc[4];
#pragma unroll
        for (int t = 0; t < 4; ++t) sc[t] = (f32x4){0, 0, 0, 0};
#pragma unroll
        for (int kk = 0; kk < 128; kk += 32) {
          bf16x8 af = ldfrag(Qs, 136, rt * 16, kk, lane);
#pragma unroll
          for (int t = 0; t < 4; ++t) sc[t] = mma(af, ldfrag(Ks, 136, t * 16, kk, lane), sc[t]);
        }
        const int l = rt * 16 + l16;
        unsigned pk[4][2];
#pragma unroll
        for (int t = 0; t < 4; ++t) {
          float pv[4];
#pragma unroll
          for (int j = 0; j < 4; ++j) {
            int s_ = t * 16 + quad * 4 + j;
            int dist = d ? s_ - l : l - s_;
            pv[j] = dist >= 0 ? sc[t][j] * __expf(lg * (float)dist) : 0.f;
          }
          pk[t][0] = pack2(pv[0], pv[1]); pk[t][1] = pack2(pv[2], pv[3]);
        }
        f32x4 ya[2], yi[2];
#pragma unroll
        for (int t = 0; t < 2; ++t) { ya[t] = (f32x4){0, 0, 0, 0}; yi[t] = (f32x4){0, 0, 0, 0}; }
#pragma unroll
        for (int ks = 0; ks < 2; ++ks) {
          const u32x4 pw = {pk[2 * ks][0], pk[2 * ks][1], pk[2 * ks + 1][0], pk[2 * ks + 1][1]};
          bf16x8 af = __builtin_bit_cast(bf16x8, pw);
#pragma unroll
          for (int t = 0; t < 2; ++t) ya[t] = mma(af, ldfrag_tr_acc(Vs, 72, (2 * chf + t) * 16, ks * 32, lane), ya[t]);
        }
#pragma unroll
        for (int kk = 0; kk < 128; kk += 32) {
          bf16x8 af = ldfrag(Qs, 136, rt * 16, kk, lane);
#pragma unroll
          for (int t = 0; t < 2; ++t) yi[t] = mma(af, ldfrag(Sb, 136, (2 * chf + t) * 16, kk, lane), yi[t]);
        }
#pragma unroll
        for (int t = 0; t < 4; ++t) { st[t][0] *= gC; st[t][1] *= gC; st[t][2] *= gC; st[t][3] *= gC; }
#pragma unroll
        for (int kk = 0; kk < 64; kk += 32) {
          bf16x8 af = ldfrag_tr(Vs2, 72, rt * 16, kk, lane);
#pragma unroll
          for (int t = 0; t < 4; ++t) st[t] = mma(af, ldfrag_tr(Ks, 136, (4 * chf + t) * 16, kk, lane), st[t]);
        }
        if (m0 >= NCTX) {
          const float qd = __expf(lg * (float)(d ? 64 - l : l + 1));
          u16* yp = Y + (size_t)(m0 + l - NCTX) * 2048 + h * 256 + sl * 64 + quad * 4;
#pragma unroll
          for (int t = 0; t < 2; ++t) {
            float o[4];
#pragma unroll
            for (int j = 0; j < 4; ++j) o[j] = ya[t][j] + qd * yi[t][j];
            u16* yq = yp + (2 * chf + t) * 16;
            if (d) {
              const uint2 prev = yprev[t];
              o[0] += bf2f((u16)(prev.x & 0xffff)); o[1] += bf2f((u16)(prev.x >> 16));
              o[2] += bf2f((u16)(prev.y & 0xffff)); o[3] += bf2f((u16)(prev.y >> 16));
            }
            *(uint2*)yq = pack4(o[0], o[1], o[2], o[3]);
          }
        }
      };
#pragma unroll 1
      for (int cs_ = 0; cs_ < 132; cs_ += 2) {
        body(cs_, rqA, rkA, rvA);
        body(cs_ + 1, rqB, rkB, rvB);
      }
    }
  }
}

__device__ __forceinline__ void phase_ynorm(const Params& p) {
  const int TT = opaque_tid();
  const u16* __restrict__ Y = (const u16*)(p.ws + O_Y);
  float* __restrict__ rstd = (float*)(p.ws + O_RSTD);
  const int lane = LTID & 63, wv = LTID >> 6;
#pragma unroll 2
  for (int m = VBID * 4 + wv; m < NLAT; m += VGRID * 4) {
#pragma unroll
    for (int h = 0; h < 8; ++h) {
      uint2 q = *(const uint2*)(Y + (size_t)m * 2048 + h * 256 + lane * 4);
      float a = bf2f((u16)(q.x & 0xffff)), b2 = bf2f((u16)(q.x >> 16)), c = bf2f((u16)(q.y & 0xffff)), d = bf2f((u16)(q.y >> 16));
      float ss = wave_sum(a * a + b2 * b2 + c * c + d * d);
      if (lane == 0) rstd[m * 8 + h] = rsqrtf(ss * (1.f / 256.f) + 1e-6f);
    }
  }
}

__device__ __forceinline__ void phase_final(const Params& p) {
  const int TT = opaque_tid();
  const float* g = p.in[I_FNG];
  const int lane = LTID & 63, wv = LTID >> 6;
  for (int m = (VBID * 4 + wv) * 2; m < NLAT; m += VGRID * 8) {
    float4 v[2][4]; float ss[2] = {0.f, 0.f};
#pragma unroll
    for (int q = 0; q < 2; ++q)
#pragma unroll
      for (int i = 0; i < 4; ++i) v[q][i] = *(const float4*)(p.out + (size_t)(m + q) * 1024 + i * 256 + lane * 4);
#pragma unroll
    for (int q = 0; q < 2; ++q) {
#pragma unroll
      for (int i = 0; i < 4; ++i) ss[q] += v[q][i].x * v[q][i].x + v[q][i].y * v[q][i].y + v[q][i].z * v[q][i].z + v[q][i].w * v[q][i].w;
      ss[q] = wave_sum(ss[q]);
    }
#pragma unroll
    for (int q = 0; q < 2; ++q) {
      const float rstd = rsqrtf(ss[q] * (1.f / 1024.f) + 1e-6f);
#pragma unroll
      for (int i = 0; i < 4; ++i) {
        int c = i * 256 + lane * 4;
        float4 gg = *(const float4*)(g + c);
        *(float4*)(p.out + (size_t)(m + q) * 1024 + c) = make_float4(v[q][i].x * rstd * gg.x, v[q][i].y * rstd * gg.y, v[q][i].z * rstd * gg.z, v[q][i].w * rstd * gg.w);
      }
    }
  }
}

#define XB_TMO      128
#define XB_XCNT(j)  (256  + 64 * (j))
#define XB_XSUB(j)  (1280 + 64 * (j))
#define XB_XGEN(j)  (2304 + 64 * (j))
#define XB_TOP      3328
#define XB_TOPGEN   3392
#define XCD_BAR_WORDS 3456
#define XB_SPIN_CAP (1u << 22)
#define LAS __attribute__((address_space(3)))
__device__ __forceinline__ unsigned xb_ld(unsigned* p)              { return __hip_atomic_load(p, __ATOMIC_RELAXED, __HIP_MEMORY_SCOPE_AGENT); }
__device__ __forceinline__ unsigned xb_add(unsigned* p, unsigned v) { return __hip_atomic_fetch_add(p, v, __ATOMIC_RELAXED, __HIP_MEMORY_SCOPE_AGENT); }
__device__ __forceinline__ unsigned xb_xcc_id() { return (unsigned)__builtin_amdgcn_s_getreg((3 << 11) | 20) & 0xFu; }
#define XB_SPIN(cond, bar) do { unsigned _sp = 0; while (cond) { __builtin_amdgcn_s_sleep(1); \
    if ((++_sp & 255u) == 0u) { if (xb_ld(&(bar)[XB_TMO])) break; if (_sp > XB_SPIN_CAP) { atomicAdd(&(bar)[XB_TMO], 1u); break; } } } } while (0)
struct XcdBarrier { unsigned* bar; unsigned x; volatile LAS unsigned* st; };
__device__ __forceinline__ XcdBarrier xcd_barrier_post(unsigned* bar, volatile LAS unsigned* st) {
  XcdBarrier b; b.bar = bar; b.x = xb_xcc_id(); b.st = st;
  if (threadIdx.x == 0) (void)xb_add(&bar[XB_XCNT(b.x)], 1u);
  return b;
}
__device__ __forceinline__ void xcd_barrier_complete(unsigned* bar, unsigned x, unsigned& nloc, unsigned& nx) {
  const unsigned G = gridDim.x * gridDim.y * gridDim.z;
  unsigned sum, cnt, mine, sp = 0u;
  for (;;) {
    sum = 0u; cnt = 0u; mine = 0u;
#pragma unroll
    for (unsigned j = 0; j < 16; ++j) { const unsigned c = xb_ld(&bar[XB_XCNT(j)]); sum += c; cnt += (c > 0u) ? 1u : 0u; mine = (j == x) ? c : mine; }
    if (sum == G) break;
    __builtin_amdgcn_s_sleep(1);
    if ((++sp & 255u) == 0u) { if (xb_ld(&bar[XB_TMO])) break; if (sp > XB_SPIN_CAP) { atomicAdd(&bar[XB_TMO], 1u); break; } }
  }
  nloc = mine > 0u ? mine : 1u; nx = cnt > 0u ? cnt : 1u;
}
__device__ __forceinline__ void xcd_barrier(const XcdBarrier& b) {
  asm volatile("s_waitcnt vmcnt(0)" ::: "memory");
  __syncthreads();
  if (threadIdx.x == 0) {
    unsigned* bar = b.bar;
    __builtin_amdgcn_s_waitcnt(0);
    unsigned nloc = b.st[0], nx = b.st[1];
    if (nloc == 0u) { xcd_barrier_complete(bar, b.x, nloc, nx); b.st[0] = nloc; b.st[1] = nx; }
    const unsigned old = xb_add(&bar[XB_XSUB(b.x)], 1u);
    const unsigned gen = old / nloc;
    if (old + 1u == (gen + 1u) * nloc) {
      __builtin_amdgcn_fence(__ATOMIC_RELEASE, "agent");
      asm volatile("s_waitcnt vmcnt(0)" ::: "memory");
      const unsigned og = xb_add(&bar[XB_TOP], 1u);
      const unsigned tg = og / nx;
      if (og + 1u == (tg + 1u) * nx) xb_add(&bar[XB_TOPGEN], 1u);
      else XB_SPIN(xb_ld(&bar[XB_TOPGEN]) == tg, bar);
      __builtin_amdgcn_fence(__ATOMIC_ACQUIRE, "agent");
      xb_add(&bar[XB_XGEN(b.x)], 1u);
      asm volatile("s_waitcnt vmcnt(0)" ::: "memory");
    } else {
      XB_SPIN(xb_ld(&bar[XB_XGEN(b.x)]) == gen, bar);
      __builtin_amdgcn_fence(__ATOMIC_ACQUIRE, "agent");
      asm volatile("s_waitcnt vmcnt(0)" ::: "memory");
    }
  }
  __syncthreads();
}

#ifndef PHMASK
#define PHMASK 0xFFFFFFFFFFFFFFFFull
#endif
#ifndef PHREP
#define PHREP 0ull
#endif
namespace pg8 {
#define PG8_LAS __attribute__((address_space(3)))
constexpr int BM = 256, BK = 64, HALF = 128, HTB = HALF * BK * 2, STAGE_BYTES = 8 * HTB, NXCD = 8, WGM = 4;
__device__ __forceinline__ int lds_byte(int r, int c) { const int st = (r >> 4) * 2 + (c >> 5), rr = r & 15, cc = c & 31, ob = rr * 64 + cc * 2; return st * 1024 + (ob ^ (((ob >> 9) & 1) << 5)); }
__device__ __forceinline__ void stage_rc(int b, int& R, int& C) { const int st = b / 1024, sb = b % 1024, swz = sb ^ (((sb >> 9) & 1) << 5); R = (st >> 1) * 16 + swz / 64; C = (st & 1) * 32 + (swz % 64) / 2; }
__device__ __forceinline__ int perm32(int rho) { const int n = rho >> 4, i = rho & 15; return 8 * (i >> 2) + 4 * n + (i & 3); }
struct Unit { int pm, pn; };
struct Gemm { const u16* A; const u16* Bt; int M, N, K, lda; };
struct StaticOrder {
  int nM, nN, nwg, G, c;
  __device__ void init(int M, int N, int G_, int c_) { nM = M / BM; nN = N / BM; nwg = nM * nN; G = G_; c = c_; }
  __device__ bool next(int i, Unit& u) const {
    const long L = (long)i * G + c; if (L >= nwg) return false;
    int wgid = (int)L; { const int q = nwg / NXCD, r = nwg % NXCD, xcd = wgid % NXCD, off = wgid / NXCD; wgid = (xcd < r ? xcd * (q + 1) : r * (q + 1) + (xcd - r) * q) + off; }
    const int nig = WGM * nN, gid = wgid / nig, fm = gid * WGM, gsz = (nM - fm) < WGM ? (nM - fm) : WGM;
    u.pm = fm + ((wgid % nig) % gsz); u.pn = (wgid % nig) / gsz; return true;
  }
};
template <class Epi>
__device__ __forceinline__ void gemm_phase(PG8_LAS unsigned char* lds, const Gemm g, const StaticOrder& S, const Epi& E) {
  const int tid = opaque_tid(), wid = __builtin_amdgcn_readfirstlane(tid >> 6), lane = tid & 63, wr = wid >> 2, wc = wid & 3, fr = lane & 15, fq = lane >> 4;
  const int K = g.K, nt = K / BK;
  unsigned voffA[2], voffB[2];
#pragma unroll
  for (int i = 0; i < 2; ++i) { int R, C; stage_rc(tid * 16 + i * 8192, R, C);
    const int Rb = Epi::PERM ? ((R & ~31) + perm32(R & 31)) : R;
    voffA[i] = (unsigned)(R * g.lda + C) * 2u; voffB[i] = (unsigned)(Rb * K + C) * 2u; }
  const size_t kstep = (size_t)(BK * 2);
  const size_t hstepA = (size_t)HALF * g.lda * 2, hstepB = (size_t)HALF * K * 2;
  const size_t tstepA = 2 * hstepA, tstepB = 2 * hstepB;
  const unsigned ldsw = (unsigned)wid * 1024u;
  const int aoff = lds_byte(wr * 64 + fr, fq * 8), boff = lds_byte(wc * 32 + fr, fq * 8);
#define PG8_SA(b, h) (((b) * 2 + (h)) * HTB)
#define PG8_SB(b, h) ((4 + (b) * 2 + (h)) * HTB)
#define PG8_STAGE(bufoff, gbase, voff) do { _Pragma("unroll") for (int _i = 0; _i < 2; ++_i) \
        __builtin_amdgcn_global_load_lds((const unsigned*)((const char*)(gbase) + (voff)[_i]), (PG8_LAS unsigned*)(lds + (bufoff) + ldsw + _i * 8192), 16, 0, 0); } while (0)
#define PG8_LDA(dst, b, h) do { _Pragma("unroll") for (int m = 0; m < 4; ++m) _Pragma("unroll") for (int k = 0; k < 2; ++k) dst[m][k] = *(const PG8_LAS bf16x8*)(lds + PG8_SA(b, h) + aoff + m * 2048 + k * 1024); } while (0)
#define PG8_LDB(dst, b, h) do { _Pragma("unroll") for (int n = 0; n < 2; ++n) _Pragma("unroll") for (int k = 0; k < 2; ++k) dst[n][k] = *(const PG8_LAS bf16x8*)(lds + PG8_SB(b, h) + boff + n * 2048 + k * 1024); } while (0)
#define PG8_MMA(ai, bj, At, Bt) do { __builtin_amdgcn_s_setprio(1); _Pragma("unroll") for (int m = 0; m < 4; ++m) _Pragma("unroll") for (int n = 0; n < 2; ++n) _Pragma("unroll") for (int k = 0; k < 2; ++k) \
        acc[ai][bj][m][n] = __builtin_amdgcn_mfma_f32_16x16x32_bf16(Bt[n][k], At[m][k], acc[ai][bj][m][n], 0, 0, 0); __builtin_amdgcn_s_setprio(0); } while (0)
#define PG8_WAIT_V(n) asm volatile("s_waitcnt vmcnt(" #n ")" ::: "memory")
#define PG8_WAIT_L(n) asm volatile("s_waitcnt lgkmcnt(" #n ")" ::: "memory")
#define PG8_BAR __builtin_amdgcn_s_barrier()
#define PG8_SCHED __builtin_amdgcn_sched_barrier(0)
  Unit cur, nxt; int ui = 0;
  if (!S.next(0, cur)) return;
  f32x4 acc[2][2][4][2];
#pragma unroll
  for (int a = 0; a < 2; ++a)
#pragma unroll
    for (int b = 0; b < 2; ++b)
#pragma unroll
      for (int m = 0; m < 4; ++m)
#pragma unroll
        for (int n = 0; n < 2; ++n) acc[a][b][m][n] = (f32x4){0.f, 0.f, 0.f, 0.f};
  bf16x8 At[4][2], B0[2][2], B1[2][2];
  const char* cA = (const char*)g.A + (size_t)cur.pm * tstepA; const char* cB = (const char*)g.Bt + (size_t)cur.pn * tstepB;
  PG8_STAGE(PG8_SB(0, 0), cB, voffB); PG8_STAGE(PG8_SA(0, 0), cA, voffA); PG8_STAGE(PG8_SB(0, 1), cB + hstepB, voffB); PG8_STAGE(PG8_SA(0, 1), cA + hstepA, voffA);
  if (wr == 1) PG8_BAR;
  PG8_WAIT_V(4); PG8_BAR;
  PG8_STAGE(PG8_SB(1, 0), cB + kstep, voffB); PG8_STAGE(PG8_SA(1, 0), cA + kstep, voffA); PG8_STAGE(PG8_SB(1, 1), cB + hstepB + kstep, voffB);
  PG8_WAIT_V(6); PG8_BAR;
  for (;;) {
    const bool has_next = S.next(ui + 1, nxt);
    const char* nA = has_next ? (const char*)g.A + (size_t)nxt.pm * tstepA : cA; const char* nB = has_next ? (const char*)g.Bt + (size_t)nxt.pn * tstepB : cB;
    for (int t = 0; t < nt; t += 2) {
      const bool last = (t == nt - 2);
      const char* a1 = cA + (size_t)(t + 1) * kstep;
      const char* a2 = last ? nA : cA + (size_t)(t + 2) * kstep; const char* b2 = last ? nB : cB + (size_t)(t + 2) * kstep;
      const char* a3 = a2 + kstep; const char* b3 = b2 + kstep;
      PG8_LDB(B0, 0, 0); PG8_SCHED; PG8_LDA(At, 0, 0); PG8_STAGE(PG8_SA(1, 1), a1 + hstepA, voffA);
      PG8_WAIT_L(8); PG8_BAR; PG8_WAIT_L(0); PG8_MMA(0, 0, At, B0); PG8_BAR; PG8_SCHED;
      PG8_LDB(B1, 0, 1); PG8_STAGE(PG8_SB(0, 0), b2, voffB);
      PG8_BAR; PG8_WAIT_L(0); PG8_MMA(0, 1, At, B1); PG8_BAR;
      PG8_LDA(At, 0, 1); PG8_STAGE(PG8_SA(0, 0), a2, voffA);
      PG8_BAR; PG8_WAIT_L(0); PG8_MMA(1, 0, At, B0); PG8_BAR; PG8_SCHED;
      PG8_STAGE(PG8_SB(0, 1), b2 + hstepB, voffB);
      PG8_WAIT_V(6); PG8_BAR; PG8_MMA(1, 1, At, B1); PG8_BAR;
      PG8_LDB(B0, 1, 0); PG8_SCHED; PG8_LDA(At, 1, 0); PG8_STAGE(PG8_SA(0, 1), a2 + hstepA, voffA);
      PG8_WAIT_L(8); PG8_BAR; PG8_WAIT_L(0); PG8_MMA(0, 0, At, B0); PG8_BAR; PG8_SCHED;
      PG8_LDB(B1, 1, 1); PG8_STAGE(PG8_SB(1, 0), b3, voffB);
      PG8_BAR; PG8_WAIT_L(0); PG8_MMA(0, 1, At, B1); PG8_BAR;
      PG8_LDA(At, 1, 1); PG8_STAGE(PG8_SA(1, 0), a3, voffA);
      PG8_BAR; PG8_WAIT_L(0); PG8_MMA(1, 0, At, B0); PG8_BAR; PG8_SCHED;
      PG8_STAGE(PG8_SB(1, 1), b3 + hstepB, voffB);
      PG8_WAIT_V(6); PG8_BAR; PG8_MMA(1, 1, At, B1); PG8_BAR;
    }
    E(acc, cur, wr, wc, fr, fq);
    if (!has_next) break;
#pragma unroll
    for (int a = 0; a < 2; ++a)
#pragma unroll
      for (int b = 0; b < 2; ++b)
#pragma unroll
        for (int m = 0; m < 4; ++m)
#pragma unroll
          for (int n = 0; n < 2; ++n) acc[a][b][m][n] = (f32x4){0.f, 0.f, 0.f, 0.f};
    cur = nxt; cA = nA; cB = nB; ++ui;
  }
  PG8_WAIT_V(0);
  if (wr == 0) PG8_BAR;
  PG8_BAR;
#undef PG8_SA
#undef PG8_SB
#undef PG8_STAGE
#undef PG8_LDA
#undef PG8_LDB
#undef PG8_MMA
#undef PG8_WAIT_V
#undef PG8_WAIT_L
#undef PG8_BAR
#undef PG8_SCHED
}
}

template <class Epi> struct PgEpi {
  static constexpr bool PERM = Epi::PERM;
  Epi e; int nreal;
  __device__ __forceinline__ void operator()(const f32x4 (&acc)[2][2][4][2], const pg8::Unit& u, int wr, int wc, int fr, int fq) const {
#pragma unroll
    for (int ai = 0; ai < 2; ++ai)
#pragma unroll
      for (int m = 0; m < 4; ++m) {
        const int row = u.pm * 256 + ai * 128 + wr * 64 + m * 16 + fr;
#pragma unroll
        for (int bj = 0; bj < 2; ++bj) {
          if constexpr (Epi::PERM) {
            const int col = u.pn * 256 + bj * 128 + wc * 32 + 8 * fq;
            if (col < nreal) e.store8(row, col, acc[ai][bj][m][0], acc[ai][bj][m][1]);
          } else {
#pragma unroll
            for (int n = 0; n < 2; ++n) {
              const int col = u.pn * 256 + bj * 128 + wc * 32 + n * 16 + 4 * fq;
              if (col < nreal) e(row, col, acc[ai][bj][m][n]);
            }
          }
        }
      }
  }
};
template <> struct PgEpi<EpiRes> {
  static constexpr bool PERM = false;
  EpiRes e; int nreal;
  __device__ __forceinline__ void operator()(const f32x4 (&acc)[2][2][4][2], const pg8::Unit& u, int wr, int wc, int fr, int fq) const {
    const int row0 = u.pm * 256 + e.moff;
    const int col0 = u.pn * 256 + wc * 32 + 4 * fq;
    const float* g = e.modv_l + (mod_row(row0) * 6 + e.gi) * 1024 + col0;
    f32x4 gv[2][2];
#pragma unroll
    for (int bj = 0; bj < 2; ++bj)
#pragma unroll
      for (int n = 0; n < 2; ++n) gv[bj][n] = *(const f32x4*)(g + bj * 128 + n * 16);
    const bool isctx = row0 < NCTX;
    const float* sb = isctx ? e.src_c + (size_t)row0 * 1024 : e.src_l + (size_t)(row0 - NCTX) * 1024;
    float* db = isctx ? e.dst_c + (size_t)row0 * 1024 : e.dst_l + (size_t)(row0 - NCTX) * 1024;
#pragma unroll
    for (int ai = 0; ai < 2; ++ai)
#pragma unroll
      for (int mp = 0; mp < 2; ++mp) {
        f32x4 x[2][2][2];
#pragma unroll
        for (int mi = 0; mi < 2; ++mi) {
          const size_t off = (size_t)(ai * 128 + wr * 64 + (mp * 2 + mi) * 16 + fr) * 1024 + col0;
#pragma unroll
          for (int bj = 0; bj < 2; ++bj)
#pragma unroll
            for (int n = 0; n < 2; ++n) x[mi][bj][n] = *(const f32x4*)(sb + off + bj * 128 + n * 16);
        }
        asm volatile("" ::: "memory");
#pragma unroll
        for (int mi = 0; mi < 2; ++mi) {
          const size_t off = (size_t)(ai * 128 + wr * 64 + (mp * 2 + mi) * 16 + fr) * 1024 + col0;
#pragma unroll
          for (int bj = 0; bj < 2; ++bj)
#pragma unroll
            for (int n = 0; n < 2; ++n) *(f32x4*)(db + off + bj * 128 + n * 16) = x[mi][bj][n] + gv[bj][n] * acc[ai][bj][mp * 2 + mi][n];
        }
        asm volatile("" ::: "memory");
      }
  }
};
template <> struct PgEpi<EpiGate> {
  static constexpr bool PERM = true;
  EpiGate e; int nreal;
  __device__ __forceinline__ void operator()(const f32x4 (&acc)[2][2][4][2], const pg8::Unit& u, int wr, int wc, int fr, int fq) const {
    const int col0 = u.pn * 256 + wc * 32 + 8 * fq;
    u32x4 yv[2][4][2]; float rs[2][4];
#pragma unroll
    for (int ai = 0; ai < 2; ++ai)
#pragma unroll
      for (int m = 0; m < 4; ++m) {
        const int row = u.pm * 256 + ai * 128 + wr * 64 + m * 16 + fr;
        rs[ai][m] = e.rstd[row * 8 + u.pn];
#pragma unroll
        for (int bj = 0; bj < 2; ++bj) yv[ai][m][bj] = *(const u32x4*)(e.Y + (size_t)row * 2048 + col0 + bj * 128);
      }
    asm volatile("" ::: "memory");
#pragma unroll
    for (int ai = 0; ai < 2; ++ai)
#pragma unroll
      for (int m = 0; m < 4; ++m) {
        const int row = u.pm * 256 + ai * 128 + wr * 64 + m * 16 + fr;
#pragma unroll
        for (int bj = 0; bj < 2; ++bj) {
          const f32x4 a = acc[ai][bj][m][0], b = acc[ai][bj][m][1];
          const float r = rs[ai][m];
          const u32x4 yy = yv[ai][m][bj];
          float o[8];
          o[0] = siluf_(a[0]) * XLO(yy[0]) * r; o[1] = siluf_(a[1]) * XHI(yy[0]) * r;
          o[2] = siluf_(a[2]) * XLO(yy[1]) * r; o[3] = siluf_(a[3]) * XHI(yy[1]) * r;
          o[4] = siluf_(b[0]) * XLO(yy[2]) * r; o[5] = siluf_(b[1]) * XHI(yy[2]) * r;
          o[6] = siluf_(b[2]) * XLO(yy[3]) * r; o[7] = siluf_(b[3]) * XHI(yy[3]) * r;
          *(u32x4*)(e.Y + (size_t)row * 2048 + col0 + bj * 128) = pack8(o);
        }
      }
  }
};
template <class Epi>
__device__ __forceinline__ void big_gemm(const u16* A, int lda, const u16* Bt, int M, int N, int K, Epi epi, char* smem) {
  const int npad = (N + 255) & ~255;
  pg8::StaticOrder S; S.init(M, npad, gridDim.x, blockIdx.x);
  pg8::Gemm g{A, Bt, M, npad, K, lda};
  PgEpi<Epi> E{epi, N};
  pg8::gemm_phase((PG8_LAS unsigned char*)smem, g, S, E);
  __syncthreads();
}

__global__ void __launch_bounds__(512, 2) mega(Params p) {
  extern __shared__ __attribute__((aligned(16))) char smem0[];
#define HSMEM (smem0 + (opaque_tid() >> 8) * HALF_LDS)
  cg::grid_group grid = cg::this_grid();
  volatile LAS unsigned* xst = (volatile LAS unsigned*)(smem0 + LDS_BYTES);
  if (threadIdx.x == 0) { xst[0] = 0u; xst[1] = 0u; }
  __syncthreads();
  XcdBarrier xb = xcd_barrier_post((unsigned*)(p.ws + O_BAR), xst);
  u16* W = (u16*)p.ws;
  float* modv = (float*)(p.ws + O_MODV);
  float* ctxr = (float*)(p.ws + O_CTXR);
  u16* hx0 = (u16*)((char*)p.out + DO_HX);
  u16* hx = (u16*)(p.ws + O_HX);

  for (int rep_ = 0; rep_ < (int)(((PHMASK >> 0) & 1ull) + ((PHREP >> 0) & 1ull)); ++rep_) {
  phase_prep(p, HSMEM);
  }
  grid.sync();
  for (int rep_ = 0; rep_ < (int)(((PHMASK >> 1) & 1ull) + ((PHREP >> 1) & 1ull)); ++rep_) {
  phase_norm(p.in[I_CTX], p.in[I_X], p.in[I_N1G], modv, 0, 1, hx0, 0, NTOK);
  }
  xcd_barrier(xb);
  for (int rep_ = 0; rep_ < (int)(((PHMASK >> 2) & 1ull) + ((PHREP >> 2) & 1ull)); ++rep_) {
  big_gemm(hx0, 1024, W + W_EVIN, NTOK, PW, 1024, EpiStore{(u16*)(p.ws + O_P), PW}, smem0);
  }
  xcd_barrier(xb);
  for (int rep_ = 0; rep_ < (int)(((PHMASK >> 3) & 1ull) + ((PHREP >> 3) & 1ull)); ++rep_) {
  phase_feat(p);
  phase_xbc(p);
  }
  xcd_barrier(xb);
  {
    const u16* L = (const u16*)((const char*)p.out + DO_L);
    for (int rep_ = 0; rep_ < (int)(((PHMASK >> 4) & 1ull) + ((PHREP >> 4) & 1ull)); ++rep_) {
    gemm_phase(L + 0, 384, W + W_W2F, 64, NTOK, 512, 64, EpiE{(u16*)(p.ws + O_SEF), p.in[I_W0F]}, HSMEM);
    }
    for (int rep_ = 0; rep_ < (int)(((PHMASK >> 5) & 1ull) + ((PHREP >> 5) & 1ull)); ++rep_) {
    gemm_phase(L + 64, 384, W + W_W2B, 64, NTOK, 512, 64, EpiE{(u16*)(p.ws + O_SEB), p.in[I_W0B]}, HSMEM);
    }
    for (int rep_ = 0; rep_ < (int)(((PHMASK >> 6) & 1ull) + ((PHREP >> 6) & 1ull)); ++rep_) {
    gemm_phase(L + 128, 384, W + W_A2F, 64, NTOK, 512, 64, EpiI{(u16*)(p.ws + O_SIF), p.in[I_A0F]}, HSMEM);
    }
    for (int rep_ = 0; rep_ < (int)(((PHMASK >> 7) & 1ull) + ((PHREP >> 7) & 1ull)); ++rep_) {
    gemm_phase(L + 192, 384, W + W_A2B, 64, NTOK, 512, 64, EpiI{(u16*)(p.ws + O_SIB), p.in[I_A0B]}, HSMEM);
    }
    for (int rep_ = 0; rep_ < (int)(((PHMASK >> 8) & 1ull) + ((PHREP >> 8) & 1ull)); ++rep_) {
    gemm_phase(L + 256, 384, W + W_G2, 128, NTOK, 512, 128, EpiStore{(u16*)((char*)p.out + DO_G), 512}, HSMEM);
    }
    for (int rep_ = 0; rep_ < (int)(((PHMASK >> 9) & 1ull) + ((PHREP >> 9) & 1ull)); ++rep_) {
    phase_ssd_prep(p);
    }
  }
  xcd_barrier(xb);
  for (int rep_ = 0; rep_ < (int)(((PHMASK >> 10) & 1ull) + ((PHREP >> 10) & 1ull)); ++rep_) {
  phase_rwkv(p, smem0);
  }
  xcd_barrier(xb);
  for (int rep_ = 0; rep_ < (int)(((PHMASK >> 11) & 1ull) + ((PHREP >> 11) & 1ull)); ++rep_) {
  phase_ssd_states(p, HSMEM);
  }
  xcd_barrier(xb);
  for (int rep_ = 0; rep_ < (int)(((PHMASK >> 12) & 1ull) + ((PHREP >> 12) & 1ull)); ++rep_) {
  phase_ssd_scan(p);
  }
  xcd_barrier(xb);
  for (int rep_ = 0; rep_ < (int)(((PHMASK >> 13) & 1ull) + ((PHREP >> 13) & 1ull)); ++rep_) {
  phase_ssd_out(p, HSMEM);
  }
  xcd_barrier(xb);
  for (int rep_ = 0; rep_ < (int)(((PHMASK >> 14) & 1ull) + ((PHREP >> 14) & 1ull)); ++rep_) {
  phase_finish(p);
  }
  xcd_barrier(xb);
  for (int rep_ = 0; rep_ < (int)(((PHMASK >> 15) & 1ull) + ((PHREP >> 15) & 1ull)); ++rep_) {
  big_gemm((const u16*)(p.ws + O_MIXED), 1024, W + W_EVOUT, NTOK, 1024, 1024,
             EpiRes{p.in[I_CTX], p.in[I_X], ctxr, p.out, modv, 2, 0}, smem0);
  }
  xcd_barrier(xb);
  for (int rep_ = 0; rep_ < (int)(((PHMASK >> 16) & 1ull) + ((PHREP >> 16) & 1ull)); ++rep_) {
  phase_norm(ctxr, p.out, p.in[I_N2G], modv, 3, 4, hx, 0, NTOK);
  }
  xcd_barrier(xb);
  for (int rep_ = 0; rep_ < (int)(((PHMASK >> 17) & 1ull) + ((PHREP >> 17) & 1ull)); ++rep_) {
  big_gemm(hx, 1024, W + W_UP0, NTOK, 5632, 1024, EpiStore{(u16*)(p.ws + O_GV), 5632}, smem0);
  }
  xcd_barrier(xb);
  for (int rep_ = 0; rep_ < (int)(((PHMASK >> 18) & 1ull) + ((PHREP >> 18) & 1ull)); ++rep_) {
  phase_ffnconv(p, 0, 0);
  }
  xcd_barrier(xb);
  for (int rep_ = 0; rep_ < (int)(((PHMASK >> 19) & 1ull) + ((PHREP >> 19) & 1ull)); ++rep_) {
  big_gemm((const u16*)(p.ws + O_GV) + 2816, 5632, W + W_DN0, NTOK, 1024, 2816,
             EpiRes{ctxr, p.out, ctxr, p.out, modv, 5, 0}, smem0);
  }
  xcd_barrier(xb);
  const float* modv1 = modv + 9 * 6144;
  for (int rep_ = 0; rep_ < (int)(((PHMASK >> 20) & 1ull) + ((PHREP >> 20) & 1ull)); ++rep_) {
  phase_norm(ctxr, p.out, p.in[I_N1G] + 1024, modv1, 0, 1, hx, 0, NTOK);
  }
  xcd_barrier(xb);
  for (int rep_ = 0; rep_ < (int)(((PHMASK >> 21) & 1ull) + ((PHREP >> 21) & 1ull)); ++rep_) {
  big_gemm(hx, 1024, W + W_RIN, NTOK, 4096, 1024, EpiQKV{(u16*)(p.ws + O_QKV)}, smem0);
  }
  xcd_barrier(xb);
  for (int rep_ = 0; rep_ < (int)(((PHMASK >> 22) & 1ull) + ((PHREP >> 22) & 1ull)); ++rep_) {
  phase_rope(p);
  }
  xcd_barrier(xb);
  for (int rep_ = 0; rep_ < (int)(((PHMASK >> 23) & 1ull) + ((PHREP >> 23) & 1ull)); ++rep_) {
  phase_retention(p, smem0);
  }
  xcd_barrier(xb);
  for (int rep_ = 0; rep_ < (int)(((PHMASK >> 24) & 1ull) + ((PHREP >> 24) & 1ull)); ++rep_) {
  phase_ynorm(p);
  }
  xcd_barrier(xb);
  for (int rep_ = 0; rep_ < (int)(((PHMASK >> 25) & 1ull) + ((PHREP >> 25) & 1ull)); ++rep_) {
  big_gemm(hx + (size_t)NCTX * 1024, 1024, W + W_RIN + 4096ull * 1024, NLAT, 2048, 1024,
             EpiGate{(u16*)(p.ws + O_Y), (const float*)(p.ws + O_RSTD)}, smem0);
  }
  xcd_barrier(xb);
  for (int rep_ = 0; rep_ < (int)(((PHMASK >> 26) & 1ull) + ((PHREP >> 26) & 1ull)); ++rep_) {
  big_gemm((const u16*)(p.ws + O_Y), 2048, W + W_ROUT, NLAT, 1024, 2048,
             EpiRes{ctxr, p.out, ctxr, p.out, modv1, 2, NCTX}, smem0);
  }
  xcd_barrier(xb);
  for (int rep_ = 0; rep_ < (int)(((PHMASK >> 27) & 1ull) + ((PHREP >> 27) & 1ull)); ++rep_) {
  phase_norm(ctxr, p.out, p.in[I_N2G] + 1024, modv1, 3, 4, hx, NCTX, NTOK);
  }
  xcd_barrier(xb);
  for (int rep_ = 0; rep_ < (int)(((PHMASK >> 28) & 1ull) + ((PHREP >> 28) & 1ull)); ++rep_) {
  big_gemm(hx + (size_t)NCTX * 1024, 1024, W + W_UP1, NLAT, 5632, 1024,
             EpiStore{(u16*)(p.ws + O_GV) + (size_t)NCTX * 5632, 5632}, smem0);
  }
  xcd_barrier(xb);
  for (int rep_ = 0; rep_ < (int)(((PHMASK >> 29) & 1ull) + ((PHREP >> 29) & 1ull)); ++rep_) {
  phase_ffnconv(p, 1, NCTX);
  }
  xcd_barrier(xb);
  for (int rep_ = 0; rep_ < (int)(((PHMASK >> 30) & 1ull) + ((PHREP >> 30) & 1ull)); ++rep_) {
  big_gemm((const u16*)(p.ws + O_GV) + (size_t)NCTX * 5632 + 2816, 5632, W + W_DN1, NLAT, 1024, 2816,
             EpiRes{ctxr, p.out, ctxr, p.out, modv1, 5, NCTX}, smem0);
  }
  xcd_barrier(xb);
  for (int rep_ = 0; rep_ < (int)(((PHMASK >> 31) & 1ull) + ((PHREP >> 31) & 1ull)); ++rep_) {
  phase_final(p);
  }
}

extern "C" void kernel_launch(void* const* d_in, const int* in_sizes, int n_in, void* d_out, int out_size, void* d_ws,
                              size_t ws_size, hipStream_t stream) {
  static int grid_blocks = 0;
  if (!grid_blocks) {
    int dev = 0, cus = 0, per_cu = 0;
    hipGetDevice(&dev);
    hipDeviceGetAttribute(&cus, hipDeviceAttributeMultiprocessorCount, dev);
    hipFuncSetAttribute((const void*)mega, hipFuncAttributeMaxDynamicSharedMemorySize, LDS_BYTES + 16);
    hipOccupancyMaxActiveBlocksPerMultiprocessor(&per_cu, (const void*)mega, 512, LDS_BYTES + 16);
    if (per_cu < 1) per_cu = 1;
    if (per_cu > 1) per_cu = 1;
    grid_blocks = cus * per_cu;
    fprintf(stderr, "mega: cus=%d per_cu=%d grid=%d ws=%zu\n", cus, per_cu, grid_blocks, ws_size);
  }
  Params p{};
  for (int i = 0; i < N_IN; ++i) p.in[i] = (const float*)d_in[i];
  p.out = (float*)d_out;
  p.ws = (char*)d_ws;
  hipMemsetAsync((char*)d_ws + O_BAR, 0, XCD_BAR_WORDS * 4, stream);
  void* args[] = {&p};
  hipError_t e = hipLaunchCooperativeKernel((const void*)mega, dim3(grid_blocks), dim3(512), args, LDS_BYTES + 16, stream);
  if (e != hipSuccess) fprintf(stderr, "cooperative launch failed: %s (grid %d)\n", hipGetErrorString(e), grid_blocks);
}
```
